# Optimizing an MI355X kernel written in HIP

```python
import math
import jax
import jax.numpy as jnp
from jax import lax
import numpy as np

D_MODEL = 1024
BATCH = 4
SEQ = 4096
DEPTH = 2

SSD_HEADS = 8
SSD_HEAD_DIM = 64
SSD_INNER = SSD_HEADS * SSD_HEAD_DIM
SSD_GROUPS = 2
SSD_STATE = 128
SSD_CONV = 5
SSD_CHUNK = 256
SSD_CONV_DIM = SSD_INNER + 2 * SSD_GROUPS * SSD_STATE
SWA_HEADS = 4
SWA_KV_HEADS = 2
SWA_HEAD_DIM = 64
SWA_WINDOW = 128
SWA_BLOCK = 128
SWA_WIDTH = SWA_HEADS * SWA_HEAD_DIM
MLA_HEADS = 4
MLA_Q_RANK = 256
MLA_KV_RANK = 128
MLA_NOPE = 64
MLA_ROPE = 32
MLA_QK = MLA_NOPE + MLA_ROPE
MLA_V = 64
MLA_WIDTH = MLA_HEADS * MLA_V
MLA_BLOCK = 128
D_MIX = SSD_INNER + SWA_WIDTH + MLA_WIDTH
IN_SIZES = (SSD_INNER, SSD_CONV_DIM, 2 * SSD_HEADS,
            SWA_HEADS * SWA_HEAD_DIM, 2 * SWA_KV_HEADS * SWA_HEAD_DIM,
            MLA_Q_RANK, MLA_KV_RANK, MLA_ROPE)
D_IN_PROJ = sum(IN_SIZES)
D_FF = 2816
ROPE_THETA = 10000.0
EPS = 1e-6

kernel_name = 'hybrid_ssd_swa_mla_macaron_encoder'


def rms_norm(x, w):
    xf = x.astype(jnp.float32)
    y = xf * lax.rsqrt(jnp.mean(xf * xf, axis=-1, keepdims=True) + EPS)
    return (y * w.astype(jnp.float32)).astype(x.dtype)


def split_columns(t, sizes):
    idx, acc = [], 0
    for sz in sizes[:-1]:
        acc += sz
        idx.append(acc)
    return jnp.split(t, idx, axis=-1)


def rope_tables(n, dim):
    inv = 1.0 / jnp.power(ROPE_THETA, jnp.arange(0, dim, 2, dtype=jnp.float32) / dim)
    ang = jnp.arange(n, dtype=jnp.float32)[:, None] * inv[None, :]
    return jnp.cos(ang), jnp.sin(ang)


def apply_rope(x, cos, sin):
    x1, x2 = jnp.split(x, 2, axis=-1)
    c = cos[None, :, None, :]
    sn = sin[None, :, None, :]
    return jnp.concatenate([x1 * c - x2 * sn, x1 * sn + x2 * c], axis=-1).astype(x.dtype)


def swiglu(x, w_gate, w_up, w_down):
    return (jax.nn.silu(x @ w_gate) * (x @ w_up)) @ w_down


def centred_depthwise_conv(x, w, b):
    k = w.shape[0]
    y = lax.conv_general_dilated(x, w[:, None, :], window_strides=(1,),
                                 padding=[(k // 2, k // 2)],
                                 dimension_numbers=('NWC', 'WIO', 'NWC'),
                                 feature_group_count=x.shape[-1])
    return y + b


def segsum(a):
    t = a.shape[-1]
    a_rep = jnp.broadcast_to(a[..., :, None], a.shape + (t,))
    strict = jnp.tril(jnp.ones((t, t), dtype=bool), -1)
    cs = jnp.cumsum(jnp.where(strict, a_rep, 0.0), axis=-2)
    return jnp.where(jnp.tril(jnp.ones((t, t), dtype=bool)), cs, -jnp.inf)


def ssd_scan(x, dt, a_decay, bm, cm):
    b, l, h, p = x.shape
    g, n = bm.shape[-2:]
    r = h // g
    xdt = x.astype(jnp.float32) * dt[..., None]
    a = dt * a_decay
    bf = bm.astype(jnp.float32)
    cf = cm.astype(jnp.float32)
    pad = (-l) % SSD_CHUNK
    if pad:
        pw = lambda t: jnp.pad(t, [(0, 0), (0, pad)] + [(0, 0)] * (t.ndim - 2))
        xdt, a, bf, cf = pw(xdt), pw(a), pw(bf), pw(cf)
    t = SSD_CHUNK
    nc = (l + pad) // t
    xc = xdt.reshape(b, nc, t, g, r, p)
    ac = a.reshape(b, nc, t, g, r).transpose(0, 3, 4, 1, 2)
    bc = bf.reshape(b, nc, t, g, n)
    cc = cf.reshape(b, nc, t, g, n)
    a_cum = jnp.cumsum(ac, axis=-1)
    l_mat = jnp.exp(segsum(ac))
    cb = jnp.einsum('bclgn,bcsgn->bgcls', cc, bc)
    y_diag = jnp.einsum('bgcls,bgrcls,bcsgrp->bclgrp', cb, l_mat, xc)
    decay_states = jnp.exp(a_cum[..., -1:] - a_cum)
    states = jnp.einsum('bclgn,bgrcl,bclgrp->bcgrpn', bc, decay_states, xc)
    states = jnp.concatenate([jnp.zeros_like(states[:, :1]), states], axis=1)
    chunk_tot = jnp.pad(a_cum[..., -1], [(0, 0), (0, 0), (0, 0), (1, 0)])
    decay_chunk = jnp.exp(segsum(chunk_tot))
    states = jnp.einsum('bgrzc,bcgrpn->bzgrpn', decay_chunk, states)[:, :-1]
    y_off = jnp.einsum('bclgn,bcgrpn,bgrcl->bclgrp', cc, states, jnp.exp(a_cum))
    return (y_diag + y_off).reshape(b, nc * t, h, p)[:, :l]


def ssd_mixer(z, xbc, dt_raw, conv_w, conv_b, dt_bias, a_log, d_skip, norm_w):
    b, s, _ = xbc.shape
    xbc = jax.nn.silu(centred_depthwise_conv(xbc, conv_w, conv_b))
    xs, bm, cm = jnp.split(xbc, [SSD_INNER, SSD_INNER + SSD_GROUPS * SSD_STATE], axis=-1)
    xs = xs.reshape(b, s, SSD_HEADS, SSD_HEAD_DIM)
    bm = bm.reshape(b, s, SSD_GROUPS, SSD_STATE)
    cm = cm.reshape(b, s, SSD_GROUPS, SSD_STATE)
    dt = jax.nn.softplus(dt_raw.astype(jnp.float32).reshape(b, s, 2, SSD_HEADS)
                         + dt_bias.astype(jnp.float32))
    a_decay = -jnp.exp(a_log.astype(jnp.float32))
    flip = lambda t: jnp.flip(t, axis=1)
    y_fwd = ssd_scan(xs, dt[:, :, 0], a_decay[0], bm, cm)
    y_bwd = flip(ssd_scan(flip(xs), flip(dt[:, :, 1]), a_decay[1], flip(bm), flip(cm)))
    y = y_fwd + y_bwd + d_skip.astype(jnp.float32)[:, None] * xs.astype(jnp.float32)
    y = y.reshape(b, s, SSD_INNER) * jax.nn.silu(z.astype(jnp.float32))
    y = y.reshape(b, s, SSD_GROUPS, SSD_INNER // SSD_GROUPS)
    y = y * lax.rsqrt(jnp.mean(y * y, axis=-1, keepdims=True) + EPS)
    return (y.reshape(b, s, SSD_INNER) * norm_w.astype(jnp.float32)).astype(z.dtype)


def swa_mixer(q, kv, cos, sin, q_norm_w, k_norm_w, sink, out_norm_w):
    b, s, _ = q.shape
    hd, kvh, blk = SWA_HEAD_DIM, SWA_KV_HEADS, SWA_BLOCK
    rep = SWA_HEADS // kvh
    q = q.reshape(b, s, SWA_HEADS, hd)
    k, v = jnp.split(kv, 2, axis=-1)
    k = k.reshape(b, s, kvh, hd)
    v = v.reshape(b, s, kvh, hd)
    q = apply_rope(rms_norm(q, q_norm_w), cos, sin)
    k = apply_rope(rms_norm(k, k_norm_w), cos, sin)
    nb = s // blk
    qb = q.reshape(b, nb, blk, kvh, rep, hd)

    def band(t):
        tp = jnp.pad(t, [(0, 0), (blk, blk), (0, 0), (0, 0)]).reshape(b, nb + 2, blk, kvh, hd)
        return jnp.concatenate([tp[:, :-2], tp[:, 1:-1], tp[:, 2:]], axis=2)

    kb, vb = band(k), band(v)
    scores = jnp.einsum('bnqkrd,bnjkd->bnkrqj', qb, kb).astype(jnp.float32) * (hd ** -0.5)
    qpos = jnp.arange(nb)[:, None] * blk + jnp.arange(blk)[None, :]
    kpos = (jnp.arange(nb)[:, None] - 1) * blk + jnp.arange(3 * blk)[None, :]
    rel = kpos[:, None, :] - qpos[:, :, None]
    valid = (jnp.abs(rel) <= SWA_WINDOW) & (kpos[:, None, :] >= 0) & (kpos[:, None, :] < s)
    scores = jnp.where(valid[None, :, None, None], scores, -jnp.inf)
    sink_col = jnp.broadcast_to(sink.astype(jnp.float32).reshape(kvh, rep)[None, None, :, :, None, None],
                                scores.shape[:-1] + (1,))
    probs = jax.nn.softmax(jnp.concatenate([scores, sink_col], axis=-1), axis=-1)[..., :-1]
    out = jnp.einsum('bnkrqj,bnjkd->bnqkrd', probs.astype(vb.dtype), vb)
    return rms_norm(out.reshape(b, s, SWA_WIDTH), out_norm_w)


def mla_mixer(q_lat, c_kv, k_rope, cos_r, sin_r, q_lat_norm_w, w_uq, kv_norm_w, w_ukv,
              q_norm_w, k_norm_w, out_norm_w):
    b, s, _ = q_lat.shape
    h = MLA_HEADS
    q = (rms_norm(q_lat, q_lat_norm_w) @ w_uq).reshape(b, s, h, MLA_QK)
    kv = (rms_norm(c_kv, kv_norm_w) @ w_ukv).reshape(b, s, h, MLA_NOPE + MLA_V)
    k_nope, v = jnp.split(kv, [MLA_NOPE], axis=-1)
    k = jnp.concatenate([k_nope, jnp.broadcast_to(k_rope[:, :, None, :], (b, s, h, MLA_ROPE))], axis=-1)
    q = rms_norm(q, q_norm_w)
    k = rms_norm(k, k_norm_w)
    q = jnp.concatenate([q[..., :MLA_NOPE], apply_rope(q[..., MLA_NOPE:], cos_r, sin_r)], axis=-1)
    k = jnp.concatenate([k[..., :MLA_NOPE], apply_rope(k[..., MLA_NOPE:], cos_r, sin_r)], axis=-1)
    scale = MLA_QK ** -0.5
    nb = s // MLA_BLOCK
    qb = q.reshape(b, nb, MLA_BLOCK, h, MLA_QK).transpose(1, 0, 2, 3, 4)

    def attend(q_blk):
        sc = jnp.einsum('bqhd,bkhd->bhqk', q_blk, k).astype(jnp.float32) * scale
        p = jax.nn.softmax(sc, axis=-1)
        return jnp.einsum('bhqk,bkhd->bqhd', p.astype(v.dtype), v)

    out = lax.map(attend, qb)
    out = out.transpose(1, 0, 2, 3, 4).reshape(b, s, MLA_WIDTH)
    return rms_norm(out, out_norm_w)


def setup_inputs(seed: int = 0) -> dict:
    key = jax.random.key(seed)
    ks = iter(jax.random.split(key, 48))
    L = DEPTH

    def nrm(shape, scale):
        return jax.random.normal(next(ks), shape, jnp.float32) * scale

    def gain(shape):
        return 1.0 + nrm(shape, 0.02)

    x = jax.random.normal(next(ks), (BATCH, SEQ, D_MODEL), jnp.float32)
    ffn1_norm = gain((L, D_MODEL))
    ffn1_gate = nrm((L, D_MODEL, D_FF), D_MODEL ** -0.5)
    ffn1_up = nrm((L, D_MODEL, D_FF), D_MODEL ** -0.5)
    ffn1_down = nrm((L, D_FF, D_MODEL), D_FF ** -0.5)
    mix_norm = gain((L, D_MODEL))
    w_in = nrm((L, D_MODEL, D_IN_PROJ), D_MODEL ** -0.5)
    ssd_conv_w = nrm((L, SSD_CONV, SSD_CONV_DIM), SSD_CONV ** -0.5)
    ssd_conv_b = nrm((L, SSD_CONV_DIM), 0.02)
    dt0 = jnp.exp(jax.random.uniform(next(ks), (L, 2, SSD_HEADS), jnp.float32,
                                     minval=math.log(1e-3), maxval=math.log(1e-1)))
    ssd_dt_bias = dt0 + jnp.log(-jnp.expm1(-dt0))
    ssd_a_log = jnp.log(jax.random.uniform(next(ks), (L, 2, SSD_HEADS), jnp.float32,
                                           minval=1.0, maxval=16.0))
    ssd_d = gain((L, SSD_HEADS))
    ssd_norm = gain((L, SSD_INNER))
    swa_q_norm = gain((L, SWA_HEAD_DIM))
    swa_k_norm = gain((L, SWA_HEAD_DIM))
    swa_sink = nrm((L, SWA_HEADS), 0.5)
    swa_out_norm = gain((L, SWA_WIDTH))
    mla_q_lat_norm = gain((L, MLA_Q_RANK))
    mla_w_uq = nrm((L, MLA_Q_RANK, MLA_HEADS * MLA_QK), MLA_Q_RANK ** -0.5)
    mla_kv_norm = gain((L, MLA_KV_RANK))
    mla_w_ukv = nrm((L, MLA_KV_RANK, MLA_HEADS * (MLA_NOPE + MLA_V)), MLA_KV_RANK ** -0.5)
    mla_q_norm = gain((L, MLA_QK))
    mla_k_norm = gain((L, MLA_QK))
    mla_out_norm = gain((L, MLA_WIDTH))
    w_out = nrm((L, D_MIX, D_MODEL), D_MIX ** -0.5)
    ffn2_norm = gain((L, D_MODEL))
    ffn2_gate = nrm((L, D_MODEL, D_FF), D_MODEL ** -0.5)
    ffn2_up = nrm((L, D_MODEL, D_FF), D_MODEL ** -0.5)
    ffn2_down = nrm((L, D_FF, D_MODEL), D_FF ** -0.5)
    return {'x': x, 'ffn1_norm': ffn1_norm, 'ffn1_gate': ffn1_gate, 'ffn1_up': ffn1_up,
            'ffn1_down': ffn1_down, 'mix_norm': mix_norm, 'w_in': w_in,
            'ssd_conv_w': ssd_conv_w, 'ssd_conv_b': ssd_conv_b, 'ssd_dt_bias': ssd_dt_bias,
            'ssd_a_log': ssd_a_log, 'ssd_d': ssd_d, 'ssd_norm': ssd_norm,
            'swa_q_norm': swa_q_norm, 'swa_k_norm': swa_k_norm, 'swa_sink': swa_sink,
            'swa_out_norm': swa_out_norm, 'mla_q_lat_norm': mla_q_lat_norm,
            'mla_w_uq': mla_w_uq, 'mla_kv_norm': mla_kv_norm, 'mla_w_ukv': mla_w_ukv,
            'mla_q_norm': mla_q_norm, 'mla_k_norm': mla_k_norm, 'mla_out_norm': mla_out_norm,
            'w_out': w_out, 'ffn2_norm': ffn2_norm, 'ffn2_gate': ffn2_gate,
            'ffn2_up': ffn2_up, 'ffn2_down': ffn2_down}


def reference(x, ffn1_norm, ffn1_gate, ffn1_up, ffn1_down, mix_norm, w_in,
              ssd_conv_w, ssd_conv_b, ssd_dt_bias, ssd_a_log, ssd_d, ssd_norm,
              swa_q_norm, swa_k_norm, swa_sink, swa_out_norm,
              mla_q_lat_norm, mla_w_uq, mla_kv_norm, mla_w_ukv, mla_q_norm, mla_k_norm,
              mla_out_norm, w_out, ffn2_norm, ffn2_gate, ffn2_up, ffn2_down):
    s = x.shape[1]
    cos, sin = rope_tables(s, SWA_HEAD_DIM)
    cos_r, sin_r = rope_tables(s, MLA_ROPE)
    for l in range(DEPTH):
        x = x + 0.5 * swiglu(rms_norm(x, ffn1_norm[l]), ffn1_gate[l], ffn1_up[l], ffn1_down[l])
        h = rms_norm(x, mix_norm[l])
        proj = h @ w_in[l]
        z, xbc, dt_raw, swa_q, swa_kv, mla_q, mla_ckv, mla_kr = split_columns(proj, IN_SIZES)
        y_ssd = ssd_mixer(z, xbc, dt_raw, ssd_conv_w[l], ssd_conv_b[l], ssd_dt_bias[l],
                          ssd_a_log[l], ssd_d[l], ssd_norm[l])
        y_swa = swa_mixer(swa_q, swa_kv, cos, sin, swa_q_norm[l], swa_k_norm[l],
                          swa_sink[l], swa_out_norm[l])
        y_mla = mla_mixer(mla_q, mla_ckv, mla_kr, cos_r, sin_r, mla_q_lat_norm[l], mla_w_uq[l],
                          mla_kv_norm[l], mla_w_ukv[l], mla_q_norm[l], mla_k_norm[l],
                          mla_out_norm[l])
        y = jnp.concatenate([y_ssd, y_swa, y_mla], axis=-1)
        x = x + y @ w_out[l]
        x = x + 0.5 * swiglu(rms_norm(x, ffn2_norm[l]), ffn2_gate[l], ffn2_up[l], ffn2_down[l])
    return x
```

```cpp
#include <hip/hip_runtime.h>
#include <cstdio>
#include <cstdint>

namespace pg8 {
#define PG8_LAS __attribute__((address_space(3)))

typedef unsigned short bf16_t;
typedef short bf16x8 __attribute__((ext_vector_type(8)));
typedef float f32x4 __attribute__((ext_vector_type(4)));
typedef unsigned u32x4 __attribute__((ext_vector_type(4)));
constexpr int BM = 256, BK = 64, HALF = 128, HTB = HALF * BK * 2  , STAGE_BYTES = 8 * HTB, NXCD = 8, WGM = 8;

__host__ __device__ __forceinline__ int lds_byte(int r, int c) { const int st = (r >> 4) * 2 + (c >> 5), rr = r & 15, cc = c & 31, ob = rr * 64 + cc * 2; return st * 1024 + (ob ^ (((ob >> 9) & 1) << 5)); }
__host__ __device__ __forceinline__ void stage_rc(int b, int& R, int& C) { const int st = b / 1024, sb = b % 1024, swz = sb ^ (((sb >> 9) & 1) << 5); R = (st >> 1) * 16 + swz / 64; C = (st & 1) * 32 + (swz % 64) / 2; }
__host__ __device__ __forceinline__ int perm32(int rho) { const int n = rho >> 4, i = rho & 15; return 8 * (i >> 2) + 4 * n + (i & 3); }

struct Unit { int pm, pn; };
struct Gemm { const bf16_t* A; const bf16_t* Bt; int M, N, K; };

struct StaticOrder {
    int nM, nN, nwg, G, c;
    __host__ __device__ void init(int M, int N, int G_, int c_) { nM = M / BM; nN = N / BM; nwg = nM * nN; G = G_; c = c_; }
    __host__ __device__ bool next(int i, Unit& u) const {
        const long L = (long)i * G + c; if (L >= nwg) return false;
        int wgid = (int)L; { const int q = nwg / NXCD, r = nwg % NXCD, xcd = wgid % NXCD, off = wgid / NXCD; wgid = (xcd < r ? xcd * (q + 1) : r * (q + 1) + (xcd - r) * q) + off; }
        const int nig = WGM * nN, gid = wgid / nig, fm = gid * WGM, gsz = (nM - fm) < WGM ? (nM - fm) : WGM;
        u.pm = fm + ((wgid % nig) % gsz); u.pn = (wgid % nig) / gsz; return true;
    }
    __device__ __forceinline__ void a_ready(const Unit&) const {}
    __device__ __forceinline__ void done(const Unit&) const {}
};


__device__ __forceinline__ unsigned cvt_pk_bf16(float lo, float hi) { unsigned r; asm volatile("v_cvt_pk_bf16_f32 %0, %1, %2" : "=v"(r) : "v"(lo), "v"(hi)); return r; }

template <class Epi, class Sched, bool ALIGN_EPI = false, bool SP2 = false>
__device__ __forceinline__ void gemm_phase(PG8_LAS unsigned char* lds, const Gemm g, const Sched& S, const Epi& E) {
    int tid_ = threadIdx.x; asm volatile("" : "+v"(tid_)); const int tid = tid_, wid = __builtin_amdgcn_readfirstlane(tid >> 6), lane = tid & 63, wr = wid >> 2, wc = wid & 3, fr = lane & 15, fq = lane >> 4;
    const int K = g.K, nt = K / BK;
    unsigned voffA[2], voffB[2];
#pragma unroll
    for (int i = 0; i < 2; ++i) { int R, C; stage_rc(tid * 16 + i * 8192, R, C); const int Rb = Epi::PERM ? ((R & ~31) + perm32(R & 31)) : R;
        voffA[i] = (unsigned)(R * K + C) * 2u; voffB[i] = (unsigned)(Rb * K + C) * 2u; }
    const size_t kstep = (size_t)(BK * 2);
    const size_t hstep = (size_t)HALF * K * 2;
    const size_t tstep = 2 * hstep;
    const unsigned ldsw = (unsigned)wid * 1024u;
    const int aoff = lds_byte(wr * 64 + fr, fq * 8), boff = lds_byte(wc * 32 + fr, fq * 8);
#define PG8_SA(b, h) (((b) * 2 + (h)) * HTB)
#define PG8_SB(b, h) ((4 + (b) * 2 + (h)) * HTB)
#define PG8_STAGE(bufoff, gbase, voff) do { _Pragma("unroll") for (int _i = 0; _i < 2; ++_i) \
        __builtin_amdgcn_global_load_lds((const unsigned*)((const char*)(gbase) + (voff)[_i]), (PG8_LAS unsigned*)(lds + (bufoff) + ldsw + _i * 8192), 16, 0, 0); } while (0)
#define PG8_LDA(dst, b, h) do { _Pragma("unroll") for (int m = 0; m < 4; ++m) _Pragma("unroll") for (int k = 0; k < 2; ++k) dst[m][k] = *(const PG8_LAS bf16x8*)(lds + PG8_SA(b, h) + aoff + m * 2048 + k * 1024); } while (0)
#define PG8_LDB(dst, b, h) do { _Pragma("unroll") for (int n = 0; n < 2; ++n) _Pragma("unroll") for (int k = 0; k < 2; ++k) dst[n][k] = *(const PG8_LAS bf16x8*)(lds + PG8_SB(b, h) + boff + n * 2048 + k * 1024); } while (0)
#define PG8_MMA(ai, bj, At, Bt) do { __builtin_amdgcn_s_setprio(1); _Pragma("unroll") for (int m = 0; m < 4; ++m) _Pragma("unroll") for (int n = 0; n < 2; ++n) _Pragma("unroll") for (int k = 0; k < 2; ++k) \
        acc[ai][bj][m][n] = __builtin_amdgcn_mfma_f32_16x16x32_bf16(Bt[n][k], At[m][k], acc[ai][bj][m][n], 0, 0, 0); __builtin_amdgcn_s_setprio(0); } while (0)
#define PG8_WAIT_V(n) asm volatile("s_waitcnt vmcnt(" #n ")" ::: "memory")
#define PG8_WAIT_L(n) asm volatile("s_waitcnt lgkmcnt(" #n ")" ::: "memory")
#define PG8_BAR __builtin_amdgcn_s_barrier()
#define PG8_SCHED __builtin_amdgcn_sched_barrier(0)
    Unit cur, nxt; int ui = 0;
    if (!S.next(0, cur)) return;
    f32x4 acc[2][2][4][2];
#pragma unroll
    for (int a = 0; a < 2; ++a)
#pragma unroll
        for (int b = 0; b < 2; ++b)
#pragma unroll
            for (int m = 0; m < 4; ++m)
#pragma unroll
                for (int n = 0; n < 2; ++n) acc[a][b][m][n] = (f32x4){0.f, 0.f, 0.f, 0.f};
    bf16x8 At[4][2], B0[2][2], B1[2][2];
    const char* cA = (const char*)g.A + (size_t)cur.pm * tstep; const char* cB = (const char*)g.Bt + (size_t)cur.pn * tstep;
    S.a_ready(cur);
    if constexpr (SP2) {
        PG8_STAGE(PG8_SB(0, 0), cB, voffB); PG8_STAGE(PG8_SB(0, 1), cB + hstep, voffB); PG8_STAGE(PG8_SA(0, 0), cA, voffA); PG8_STAGE(PG8_SA(0, 1), cA + hstep, voffA);
        if (wr == 1) PG8_BAR;
        PG8_WAIT_V(2); PG8_BAR;
        PG8_STAGE(PG8_SB(1, 0), cB + kstep, voffB); PG8_STAGE(PG8_SA(1, 0), cA + kstep, voffA); PG8_STAGE(PG8_SB(1, 1), cB + hstep + kstep, voffB);
        PG8_WAIT_V(6); PG8_BAR;
    } else {
        PG8_STAGE(PG8_SB(0, 0), cB, voffB); PG8_STAGE(PG8_SA(0, 0), cA, voffA); PG8_STAGE(PG8_SB(0, 1), cB + hstep, voffB); PG8_STAGE(PG8_SA(0, 1), cA + hstep, voffA);
        if (wr == 1) PG8_BAR;
        PG8_WAIT_V(4); PG8_BAR;
        PG8_STAGE(PG8_SB(1, 0), cB + kstep, voffB); PG8_STAGE(PG8_SA(1, 0), cA + kstep, voffA); PG8_STAGE(PG8_SB(1, 1), cB + hstep + kstep, voffB);
        PG8_WAIT_V(6); PG8_BAR;
    }
    for (;;) {
        const bool has_next = S.next(ui + 1, nxt);
        const char* nA = has_next ? (const char*)g.A + (size_t)nxt.pm * tstep : cA; const char* nB = has_next ? (const char*)g.Bt + (size_t)nxt.pn * tstep : cB;
        for (int t = 0; t < nt; t += 2) {
            const bool last = (t == nt - 2);
            const char* a1 = cA + (size_t)(t + 1) * kstep;
            const char* a2 = last ? nA : cA + (size_t)(t + 2) * kstep; const char* b2 = last ? nB : cB + (size_t)(t + 2) * kstep;
            const char* a3 = a2 + kstep; const char* b3 = b2 + kstep;
            if (last && has_next) S.a_ready(nxt);
            if constexpr (SP2) {
            PG8_LDB(B0, 0, 0); PG8_LDB(B1, 0, 1); PG8_SCHED; PG8_LDA(At, 0, 0); PG8_STAGE(PG8_SA(1, 1), a1 + hstep, voffA);
            PG8_WAIT_V(8); PG8_WAIT_L(0); PG8_BAR; PG8_MMA(0, 0, At, B0); PG8_MMA(0, 1, At, B1); PG8_BAR; PG8_SCHED;
            PG8_LDA(At, 0, 1); PG8_STAGE(PG8_SB(0, 0), b2, voffB); PG8_STAGE(PG8_SB(0, 1), b2 + hstep, voffB); PG8_STAGE(PG8_SA(0, 0), a2, voffA);
            PG8_WAIT_V(8); PG8_WAIT_L(0); PG8_BAR; PG8_MMA(1, 0, At, B0); PG8_MMA(1, 1, At, B1); PG8_BAR; PG8_SCHED;
            PG8_LDB(B0, 1, 0); PG8_LDB(B1, 1, 1); PG8_SCHED; PG8_LDA(At, 1, 0); PG8_STAGE(PG8_SA(0, 1), a2 + hstep, voffA);
            PG8_WAIT_V(8); PG8_WAIT_L(0); PG8_BAR; PG8_MMA(0, 0, At, B0); PG8_MMA(0, 1, At, B1); PG8_BAR; PG8_SCHED;
            PG8_LDA(At, 1, 1); PG8_STAGE(PG8_SB(1, 0), b3, voffB); PG8_STAGE(PG8_SB(1, 1), b3 + hstep, voffB); PG8_STAGE(PG8_SA(1, 0), a3, voffA);
            PG8_WAIT_V(8); PG8_WAIT_L(0); PG8_BAR; PG8_MMA(1, 0, At, B0); PG8_MMA(1, 1, At, B1); PG8_BAR; PG8_SCHED;
            } else {
            PG8_LDB(B0, 0, 0); PG8_SCHED; PG8_LDA(At, 0, 0); PG8_STAGE(PG8_SA(1, 1), a1 + hstep, voffA);
            PG8_WAIT_L(8); PG8_BAR; PG8_WAIT_L(0); PG8_MMA(0, 0, At, B0); PG8_BAR; PG8_SCHED;
            PG8_LDB(B1, 0, 1); PG8_STAGE(PG8_SB(0, 0), b2, voffB);
            PG8_BAR; PG8_WAIT_L(0); PG8_MMA(0, 1, At, B1); PG8_BAR;
            PG8_LDA(At, 0, 1); PG8_STAGE(PG8_SA(0, 0), a2, voffA);
            PG8_BAR; PG8_WAIT_L(0); PG8_MMA(1, 0, At, B0); PG8_BAR; PG8_SCHED;
            PG8_STAGE(PG8_SB(0, 1), b2 + hstep, voffB);
            PG8_WAIT_V(6); PG8_BAR; PG8_MMA(1, 1, At, B1); PG8_BAR;
            PG8_LDB(B0, 1, 0); PG8_SCHED; PG8_LDA(At, 1, 0); PG8_STAGE(PG8_SA(0, 1), a2 + hstep, voffA);
            PG8_WAIT_L(8); PG8_BAR; PG8_WAIT_L(0); PG8_MMA(0, 0, At, B0); PG8_BAR; PG8_SCHED;
            PG8_LDB(B1, 1, 1); PG8_STAGE(PG8_SB(1, 0), b3, voffB);
            PG8_BAR; PG8_WAIT_L(0); PG8_MMA(0, 1, At, B1); PG8_BAR;
            PG8_LDA(At, 1, 1); PG8_STAGE(PG8_SA(1, 0), a3, voffA);
            PG8_BAR; PG8_WAIT_L(0); PG8_MMA(1, 0, At, B0); PG8_BAR; PG8_SCHED;
            PG8_STAGE(PG8_SB(1, 1), b3 + hstep, voffB);
            PG8_WAIT_V(6); PG8_BAR; PG8_MMA(1, 1, At, B1); PG8_BAR;
            }
            if constexpr (Epi::KHOOK) { if ((((t + 2) & 3) == 0) && !last) E.khook(acc, (t + 2) / 4 - 1, wr, fr); }
        }
        if constexpr (ALIGN_EPI) { if (wr == 0) PG8_BAR; }
        if constexpr (!Epi::AFTER_DRAIN) { E(acc, cur, wr, wc, fr, fq); S.done(cur); }
        if (!has_next) break;
#pragma unroll
        for (int a = 0; a < 2; ++a)
#pragma unroll
            for (int b = 0; b < 2; ++b)
#pragma unroll
                for (int m = 0; m < 4; ++m)
#pragma unroll
                    for (int n = 0; n < 2; ++n) acc[a][b][m][n] = (f32x4){0.f, 0.f, 0.f, 0.f};
        cur = nxt; cA = nA; cB = nB; ++ui;
        if constexpr (ALIGN_EPI) { if (wr == 1) PG8_BAR; }
    }
    PG8_WAIT_V(0);
    if constexpr (!ALIGN_EPI) { if (wr == 0) PG8_BAR; }
    PG8_BAR;
    if constexpr (Epi::AFTER_DRAIN) { E.fused(acc, cur, wr, wc, fr, fq, lds, wid, lane); S.done(cur); }
#undef PG8_SA
#undef PG8_SB
#undef PG8_STAGE
#undef PG8_LDA
#undef PG8_LDB
#undef PG8_MMA
#undef PG8_WAIT_V
#undef PG8_WAIT_L
#undef PG8_BAR
#undef PG8_SCHED
}
}

#define GAS __attribute__((address_space(1)))
#define LAS __attribute__((address_space(3)))
typedef unsigned short bf16;
typedef unsigned v4u __attribute__((ext_vector_type(4)));
typedef float f32x4 __attribute__((ext_vector_type(4)));
typedef short bf16x8 __attribute__((ext_vector_type(8)));
typedef GAS unsigned gu32;
typedef GAS unsigned long long gu64;
#define RLX_AGENT __ATOMIC_RELAXED, __HIP_MEMORY_SCOPE_AGENT
#define LDS_WAIT() asm volatile("s_waitcnt lgkmcnt(0)" ::: "memory")
#define VM_WAIT() asm volatile("s_waitcnt vmcnt(0)" ::: "memory")
__device__ __forceinline__ unsigned long long rt() { return __builtin_amdgcn_s_memrealtime(); }
__device__ __forceinline__ unsigned f2bf(float f) { unsigned u = __builtin_bit_cast(unsigned, f); return (u + 0x7fffu + ((u >> 16) & 1u)) >> 16; }
__device__ __forceinline__ unsigned pk2(float lo, float hi) { return f2bf(lo) | (f2bf(hi) << 16); }

#define XB_TMO      128
#define XB_XCNT(j)  (256  + 64 * (j))
#define XB_XSUB(j)  (1280 + 64 * (j))
#define XB_XGEN(j)  (2304 + 64 * (j))
#define XB_TOP      3328
#define XB_TOPGEN   3392
#define XCD_BAR_WORDS 3456
#define XB_SPIN_CAP (1u << 18)

__device__ __forceinline__ unsigned xb_ld(unsigned* p)              { return __hip_atomic_load(p, __ATOMIC_RELAXED, __HIP_MEMORY_SCOPE_AGENT); }
__device__ __forceinline__ unsigned xb_add(unsigned* p, unsigned v) { return __hip_atomic_fetch_add(p, v, __ATOMIC_RELAXED, __HIP_MEMORY_SCOPE_AGENT); }
__device__ __forceinline__ unsigned xb_xcc_id() { return (unsigned)__builtin_amdgcn_s_getreg((3 << 11) | 20) & 0xFu; }
#define XB_SPIN(cond, bar) do { unsigned _sp = 0; while (cond) { __builtin_amdgcn_s_sleep(1); \
    if ((++_sp & 255u) == 0u) { if (xb_ld(&(bar)[XB_TMO])) break; if (_sp > XB_SPIN_CAP) { atomicAdd(&(bar)[XB_TMO], 1u); break; } } } } while (0)

struct XcdBarrier {
    unsigned* bar; unsigned x;
    volatile LAS unsigned* st;
};

__device__ __forceinline__ XcdBarrier xcd_barrier_post(unsigned* bar, volatile LAS unsigned* st) {
    XcdBarrier b; b.bar = bar; b.x = xb_xcc_id(); b.st = st;
    if (threadIdx.x == 0) (void)xb_add(&bar[XB_XCNT(b.x)], 1u);
    return b;
}
__device__ __forceinline__ void xcd_barrier_complete(unsigned* bar, unsigned x, unsigned& nloc, unsigned& nx) {
    const unsigned G = gridDim.x * gridDim.y * gridDim.z;
    unsigned sum, cnt, mine, sp = 0u;
    for (;;) {
        sum = 0u; cnt = 0u; mine = 0u;
#pragma unroll
        for (unsigned j = 0; j < 16; ++j) { const unsigned c = xb_ld(&bar[XB_XCNT(j)]); sum += c; cnt += (c > 0u) ? 1u : 0u; mine = (j == x) ? c : mine; }
        if (sum == G) break;
        __builtin_amdgcn_s_sleep(1);
        if ((++sp & 255u) == 0u) { if (xb_ld(&bar[XB_TMO])) break; if (sp > XB_SPIN_CAP) { atomicAdd(&bar[XB_TMO], 1u); break; } }
    }
    nloc = mine > 0u ? mine : 1u; nx = cnt > 0u ? cnt : 1u;
}

__device__ __forceinline__ void xcd_barrier(const XcdBarrier& b) {
    asm volatile("s_waitcnt vmcnt(0)" ::: "memory");
    __syncthreads();
    if (threadIdx.x == 0) {
        unsigned* bar = b.bar;
        __builtin_amdgcn_s_waitcnt(0);
        unsigned nloc = b.st[0], nx = b.st[1];
        if (nloc == 0u) { xcd_barrier_complete(bar, b.x, nloc, nx); b.st[0] = nloc; b.st[1] = nx; }
        const unsigned old = xb_add(&bar[XB_XSUB(b.x)], 1u);
        const unsigned gen = old / nloc;
        if (old + 1u == (gen + 1u) * nloc) {
            __builtin_amdgcn_fence(__ATOMIC_RELEASE, "agent");
            asm volatile("s_waitcnt vmcnt(0)" ::: "memory");
            const unsigned og = xb_add(&bar[XB_TOP], 1u);
            const unsigned tg = og / nx;
            if (og + 1u == (tg + 1u) * nx) xb_add(&bar[XB_TOPGEN], 1u);
            else XB_SPIN(xb_ld(&bar[XB_TOPGEN]) == tg, bar);
            __builtin_amdgcn_fence(__ATOMIC_ACQUIRE, "agent");
            xb_add(&bar[XB_XGEN(b.x)], 1u);
            asm volatile("s_waitcnt vmcnt(0)" ::: "memory");
        } else {
            XB_SPIN(xb_ld(&bar[XB_XGEN(b.x)]) == gen, bar);
            __builtin_amdgcn_fence(__ATOMIC_ACQUIRE, "agent");
            asm volatile("s_waitcnt vmcnt(0)" ::: "memory");
        }
    }
    __syncthreads();
}


constexpr int NWAVES = 8;
constexpr int NB = 4, SEQ = 4096, M = NB * SEQ, D = 1024, FF = 2816, NPROJ = 2480, NPROJP = 2560, DEPTH = 2;
constexpr float EPS = 1e-6f;
constexpr float LOG2_10000 = 13.287712379549449f;

enum { I_X = 0, I_F1N, I_F1G, I_F1U, I_F1D, I_MIXN, I_WIN, I_CONVW, I_CONVB, I_DTB, I_ALOG, I_SSDD, I_SSDN, I_SWAQN, I_SWAKN, I_SINK, I_SWAON,
       I_MQLN, I_WUQ, I_MKVN, I_WUKV, I_MQN, I_MKN, I_MON, I_WOUT, I_F2N, I_F2G, I_F2U, I_F2D, N_IN };

constexpr size_t MiB = 1u << 20;
constexpr size_t WS_CTL = 0, CTL_ZERO_BYTES = 1 * MiB;
constexpr size_t WS_CSSWA = 1 * MiB;
constexpr size_t WS_CSMLA = 2 * MiB;
constexpr size_t WS_SS = 3 * MiB;
constexpr size_t WS_WGU1 = 4 * MiB, WS_WD1 = 15 * MiB, WS_WIN = WS_WD1 + 5 * MiB + MiB / 2, WS_WOUT = WS_WIN + 5 * MiB, WS_WGU2 = WS_WOUT + 2 * MiB, WS_WD2 = WS_WGU2 + 11 * MiB,
                 WS_WUQ = 44 * MiB, WS_WUKV = 44 * MiB + MiB / 4;
static_assert(WS_WD2 + 5 * MiB + MiB / 2 == 44 * MiB, "weights map");
constexpr size_t WS_XB = 45 * MiB;
constexpr size_t WS_OV = 77 * MiB;
constexpr size_t WS_HB = WS_OV;
constexpr size_t WS_PROJ = WS_OV;
constexpr size_t WS_Z = WS_PROJ, WS_XBCR = WS_PROJ + 16 * MiB, WS_SWAQ = WS_PROJ + 48 * MiB, WS_SWAKV = WS_PROJ + 56 * MiB, WS_MLAQR = WS_PROJ + 64 * MiB, WS_MLAM = WS_PROJ + 72 * MiB;
constexpr size_t WS_Y = WS_XBCR;
constexpr size_t WS_DTRAW = WS_OV + 80 * MiB;
constexpr size_t WS_XBCC = WS_OV + 81 * MiB;
constexpr size_t WS_DTC = WS_OV + 113 * MiB;
constexpr size_t WS_SWAVT = WS_OV + 115 * MiB;
constexpr size_t WS_MLAQ = WS_OV + 119 * MiB;
constexpr size_t WS_MLAK = WS_OV + 131 * MiB;
constexpr size_t WS_MLAVT = WS_OV + 143 * MiB;
constexpr size_t WS_SSQ = WS_OV + 151 * MiB;
constexpr size_t WS_END = WS_OV + 152 * MiB;
constexpr size_t WS_YTMP = WS_XB;
static_assert(WS_END <= 256 * MiB, "ws map");

constexpr int CW_BAR = 4096;
constexpr int RING_BYTES = 131072, TAB_OFF = RING_BYTES  , LDSCTL_OFF = TAB_OFF + 4096, MISC_OFF = LDSCTL_OFF + 64, LDS_BYTES = 147456;

struct Args { const float* in[N_IN]; float* out; unsigned char* ws; int ph_lo, ph_hi; };
static_assert(sizeof(Args) == N_IN * 8 + 8 + 8 + 8, "Args has no padding");
__device__ __forceinline__ const float* ain(int i) { asm volatile("" : "+s"(i)); return ((const float* const*)__builtin_amdgcn_kernarg_segment_ptr())[i]; }
__device__ __forceinline__ float* aout() { int i = N_IN; asm volatile("" : "+s"(i)); return ((float* const*)__builtin_amdgcn_kernarg_segment_ptr())[i]; }
__device__ __forceinline__ unsigned char* aws() { int i = N_IN + 1; asm volatile("" : "+s"(i)); return ((unsigned char* const*)__builtin_amdgcn_kernarg_segment_ptr())[i]; }

__device__ __forceinline__ float bf2f(unsigned short b) { return __uint_as_float((unsigned)b << 16); }
__device__ __forceinline__ float bflo(unsigned w) { return __uint_as_float(w << 16); }
__device__ __forceinline__ float bfhi(unsigned w) { return __uint_as_float(w & 0xffff0000u); }
__device__ __forceinline__ float wave_sum(float v) {
#pragma unroll
    for (int o = 1; o < 64; o <<= 1) v += __shfl_xor(v, o);
    return v;
}
__device__ __forceinline__ float silu_f(float g) { return g * __builtin_amdgcn_rcpf(1.0f + __expf(-g)); }
__device__ __forceinline__ float softplus_f(float x) { return fmaxf(x, 0.f) + log1pf(expf(-fabsf(x))); }

typedef pg8::f32x4 f4;
typedef pg8::u32x4 u4;
__device__ __forceinline__ void load_rstd(const float* ss, int row0, int fq, float (&rs)[2][4]) {
#pragma unroll
    for (int ai = 0; ai < 2; ++ai)
#pragma unroll
        for (int m = 0; m < 4; ++m) {
            const f4 v = *(const f4*)(ss + (size_t)(row0 + ai * 128 + m * 16) * 16 + 4 * fq);
            float s = (v[0] + v[1]) + (v[2] + v[3]); s += __shfl_xor(s, 16); s += __shfl_xor(s, 32);
            rs[ai][m] = rsqrtf(s * (1.0f / D) + EPS);
        }
}
struct EpiGU {
    static constexpr bool PERM = false, AFTER_DRAIN = false, KHOOK = false;
    pg8::bf16_t* H; const float* ss;
    __device__ __forceinline__ void operator()(const f4 (&acc)[2][2][4][2], const pg8::Unit& u, int wr, int wc, int fr, int fq) const {
        const int row0 = u.pm * 256 + wr * 64 + fr; float rs[2][4]; load_rstd(ss, row0, fq, rs);
        const int col = u.pn * 128 + wc * 32 + fq * 8;
#pragma unroll
        for (int ai = 0; ai < 2; ++ai)
#pragma unroll
            for (int m = 0; m < 4; ++m) {
                const float r = rs[ai][m]; float h[8];
#pragma unroll
                for (int bj = 0; bj < 2; ++bj)
#pragma unroll
                    for (int e = 0; e < 4; ++e) { const float g = acc[ai][bj][m][0][e] * r, uu = acc[ai][bj][m][1][e] * r; h[bj * 4 + e] = silu_f(g) * uu; }
                u4 w; w.x = pg8::cvt_pk_bf16(h[0], h[1]); w.y = pg8::cvt_pk_bf16(h[2], h[3]); w.z = pg8::cvt_pk_bf16(h[4], h[5]); w.w = pg8::cvt_pk_bf16(h[6], h[7]);
                *(u4*)(H + (size_t)(row0 + ai * 128 + m * 16) * FF + col) = w;
            }
    }
    __device__ __forceinline__ void khook(f4 (&)[2][2][4][2], int, int, int) const {}
};
template <int MODE> struct EpiDown {
    static constexpr bool PERM = false, AFTER_DRAIN = false, KHOOK = (MODE == 1);
    const float* xin; float* xout; pg8::bf16_t* xb; float* ss; float scale; const PG8_LAS float* tab;
    __device__ __forceinline__ void operator()(const f4 (&acc)[2][2][4][2], const pg8::Unit& u, int wr, int wc, int fr, int fq) const {
#pragma unroll
        for (int ai = 0; ai < 2; ++ai)
#pragma unroll
            for (int m = 0; m < 4; ++m) {
                const int lr = ai * 128 + wr * 64 + m * 16 + fr; const size_t row = (size_t)(u.pm * 256 + lr);
                const float sc = MODE == 1 ? tab[lr * 4 + 3] : scale; float sq = 0.f;
#pragma unroll
                for (int bj = 0; bj < 2; ++bj)
#pragma unroll
                    for (int n = 0; n < 2; ++n) {
                        const int col = u.pn * 256 + bj * 128 + wc * 32 + n * 16 + fq * 4;
                        const f4 xi = *(const f4*)(xin + row * D + col); const f4 o = xi + acc[ai][bj][m][n] * sc;
                        *(f4*)(xout + row * D + col) = o; sq += (o[0] * o[0] + o[1] * o[1]) + (o[2] * o[2] + o[3] * o[3]);
                        uint2 w; w.x = pg8::cvt_pk_bf16(o[0], o[1]); w.y = pg8::cvt_pk_bf16(o[2], o[3]); *(uint2*)(xb + row * D + col) = w;
                    }
                sq += __shfl_xor(sq, 16); sq += __shfl_xor(sq, 32);
                if (fq == 0) ss[row * 16 + u.pn * 4 + wc] = sq;
            }
    }
    __device__ __forceinline__ void khook(f4 (&acc)[2][2][4][2], int g, int wr, int fr) const {
#pragma unroll
        for (int ai = 0; ai < 2; ++ai)
#pragma unroll
            for (int m = 0; m < 4; ++m) { const float r = tab[(ai * 128 + wr * 64 + m * 16 + fr) * 4 + g];
#pragma unroll
                for (int bj = 0; bj < 2; ++bj)
#pragma unroll
                    for (int n = 0; n < 2; ++n) acc[ai][bj][m][n] = acc[ai][bj][m][n] * r; }
    }
};
struct EpiProj {
    static constexpr bool PERM = true, AFTER_DRAIN = false, KHOOK = false;
    pg8::bf16_t* proj; float* dtraw; const float* ss;
    __device__ __forceinline__ void operator()(const f4 (&acc)[2][2][4][2], const pg8::Unit& u, int wr, int wc, int fr, int fq) const {
        const int row0 = u.pm * 256 + wr * 64 + fr; float rs[2][4]; load_rstd(ss, row0, fq, rs);
        size_t off; int pitch, c0;
        if (u.pn < 2) { off = 0; pitch = 512; c0 = u.pn * 256; } else if (u.pn < 6) { off = (size_t)M * 512; pitch = 1024; c0 = (u.pn - 2) * 256; } else { off = (size_t)M * 1536 + (size_t)(u.pn - 6) * M * 256; pitch = 256; c0 = 0; }
        pg8::bf16_t* base = proj + off + c0 + wc * 32 + fq * 8;
        const bool dtw = (u.pn == 9) && (wc == 1) && (fq < 2);
#pragma unroll
        for (int ai = 0; ai < 2; ++ai)
#pragma unroll
            for (int m = 0; m < 4; ++m) {
                const float r = rs[ai][m]; const size_t row = (size_t)(row0 + ai * 128 + m * 16);
#pragma unroll
                for (int bj = 0; bj < 2; ++bj) {
                    const f4 v0 = acc[ai][bj][m][0] * r, v1 = acc[ai][bj][m][1] * r;
                    u4 w; w.x = pg8::cvt_pk_bf16(v0[0], v0[1]); w.y = pg8::cvt_pk_bf16(v0[2], v0[3]); w.z = pg8::cvt_pk_bf16(v1[0], v1[1]); w.w = pg8::cvt_pk_bf16(v1[2], v1[3]);
                    *(u4*)(base + row * pitch + bj * 128) = w;
                    if (bj == 1 && dtw) { *(f4*)(dtraw + row * 16 + fq * 8) = v0; *(f4*)(dtraw + row * 16 + fq * 8 + 4) = v1; }
                }
            }
    }
    __device__ __forceinline__ void khook(f4 (&)[2][2][4][2], int, int, int) const {}
};

__device__ __forceinline__ int gu_row(int j, int n01) { const int pn = j >> 7, jj = j & 127; return 256 * pn + 128 * ((jj >> 2) & 1) + 32 * (jj >> 5) + 16 * n01 + 4 * ((jj >> 3) & 3) + (jj & 3); }
__device__ __forceinline__ int win_row(int o) { return o < 1536 ? o : (o < 1552 ? 2464 + (o - 1536) : o - 16); }
__device__ __forceinline__ int map_row(int mode, int n) { return mode == 0 ? n : (mode == 1 ? gu_row(n, 0) : (mode == 2 ? gu_row(n, 1) : win_row(n))); }
__device__ __forceinline__ void tr_item(const float* W, int K, int N, bf16* WT, int mode, const float* ks, LAS float* scr, int item, int lane) {
    const int nblk = (N + 31) / 32, kb = item / nblk, nb = item % nblk, k0 = 64 * kb, n0 = 32 * nb;
    const int nn = n0 + (lane & 31); const bool nok = nn < N;
#pragma unroll 8
    for (int i = 0; i < 32; ++i) { const int kk = 2 * i + (lane >> 5); float v = nok ? W[(size_t)(k0 + kk) * N + nn] : 0.f; if (ks) v *= ks[k0 + kk]; scr[kk * 33 + (lane & 31)] = v; }
    LDS_WAIT(); asm volatile("" ::: "memory");
    const int c = lane & 7;
#pragma unroll
    for (int j = 0; j < 4; ++j) { const int n = (lane >> 3) + 8 * j; const LAS float* s = scr + (8 * c) * 33 + n;
        v4u o; o.x = pk2(s[0 * 33], s[1 * 33]); o.y = pk2(s[2 * 33], s[3 * 33]); o.z = pk2(s[4 * 33], s[5 * 33]); o.w = pk2(s[6 * 33], s[7 * 33]);
        if (n0 + n < N) *(GAS v4u*)(WT + (size_t)map_row(mode, n0 + n) * K + k0 + 8 * c) = o; }
    LDS_WAIT(); asm volatile("" ::: "memory");
}
__device__ __forceinline__ void convert_weights(int l, int part, LAS unsigned char* lds, int gw, int NGW, int wave, int lane) {
    unsigned char* ws = aws(); LAS float* scr = (LAS float*)(lds + wave * 16384);
    constexpr int I_GU = 16 * 88, I_DN = 44 * 32, I_IN = 16 * 78, I_OUT = 16 * 32, I_UQ = 4 * 12, I_UKV = 2 * 16;
    if (part == 0) {
        const float* g = ain(I_F1G) + (size_t)l * D * FF; const float* u = ain(I_F1U) + (size_t)l * D * FF; const float* d = ain(I_F1D) + (size_t)l * FF * D;
        const float* nw = ain(I_F1N) + l * D; const float* win = ain(I_WIN) + (size_t)l * D * NPROJ; const float* mw = ain(I_MIXN) + l * D;
        const float* wuq = ain(I_WUQ) + (size_t)l * 256 * 384; const float* wukv = ain(I_WUKV) + (size_t)l * 128 * 512;
        constexpr int NIT = 3 * I_GU + I_IN + I_UQ + I_UKV + 80; static_assert(I_GU == I_DN, "");
        for (int it = gw; it < NIT; it += NGW) {
            int r = it;
            if (r < I_GU) { tr_item(g, D, FF, (bf16*)(ws + WS_WGU1), 1, nw, scr, r, lane); continue; } r -= I_GU;
            if (r < I_GU) { tr_item(u, D, FF, (bf16*)(ws + WS_WGU1), 2, nw, scr, r, lane); continue; } r -= I_GU;
            if (r < I_DN) { tr_item(d, FF, D, (bf16*)(ws + WS_WD1), 0, nullptr, scr, r, lane); continue; } r -= I_DN;
            if (r < I_IN) { tr_item(win, D, NPROJ, (bf16*)(ws + WS_WIN), 3, mw, scr, r, lane); continue; } r -= I_IN;
            if (r < I_UQ) { tr_item(wuq, 256, 384, (bf16*)(ws + WS_WUQ), 0, ain(I_MQLN) + l * 256, scr, r, lane); continue; } r -= I_UQ;
            if (r < I_UKV) { tr_item(wukv, 128, 512, (bf16*)(ws + WS_WUKV), 0, ain(I_MKVN) + l * 128, scr, r, lane); continue; } r -= I_UKV;
            { GAS v4u* p = (GAS v4u*)((bf16*)(ws + WS_WIN) + (size_t)(NPROJ + r) * D) + lane * 2; p[0] = (v4u){0u, 0u, 0u, 0u}; p[1] = (v4u){0u, 0u, 0u, 0u}; }
        }
    } else {
        const float* g = ain(I_F2G) + (size_t)l * D * FF; const float* u = ain(I_F2U) + (size_t)l * D * FF; const float* d = ain(I_F2D) + (size_t)l * FF * D;
        const float* nw = ain(I_F2N) + l * D; const float* wo = ain(I_WOUT) + (size_t)l * D * D;
        constexpr int NIT = 3 * I_GU + I_OUT;
        for (int it = gw; it < NIT; it += NGW) {
            int r = it;
            if (r < I_GU) { tr_item(g, D, FF, (bf16*)(ws + WS_WGU2), 1, nw, scr, r, lane); continue; } r -= I_GU;
            if (r < I_GU) { tr_item(u, D, FF, (bf16*)(ws + WS_WGU2), 2, nw, scr, r, lane); continue; } r -= I_GU;
            if (r < I_DN) { tr_item(d, FF, D, (bf16*)(ws + WS_WD2), 0, nullptr, scr, r, lane); continue; } r -= I_DN;
            { const int k0 = 64 * (r / 32); const float* ks = k0 < 512 ? ain(I_SSDN) + l * 512 : (k0 < 768 ? ain(I_SWAON) + l * 256 - 512 : ain(I_MON) + l * 256 - 768);
              tr_item(wo, D, D, (bf16*)(ws + WS_WOUT), 0, ks, scr, r, lane); }
        }
    }
}
__device__ __forceinline__ void p0_x_and_tables(int gw, int NGW, int lane, int gtid, int NT) {
    unsigned char* ws = aws(); const float* x = ain(I_X); bf16* xb = (bf16*)(ws + WS_XB); float* ss = (float*)(ws + WS_SS);
    for (int m = gw; m < M; m += NGW) {
        const GAS f32x4* xr = (const GAS f32x4*)(x + (size_t)m * D) + lane; f32x4 v[4]; float s = 0.f;
#pragma unroll
        for (int j = 0; j < 4; ++j) { v[j] = xr[64 * j]; s += (v[j].x * v[j].x + v[j].y * v[j].y) + (v[j].z * v[j].z + v[j].w * v[j].w); }
        s = wave_sum(s);
        GAS unsigned long long* o8 = (GAS unsigned long long*)(xb + (size_t)m * D) + lane;
#pragma unroll
        for (int j = 0; j < 4; ++j) o8[64 * j] = (unsigned long long)pk2(v[j].x, v[j].y) | ((unsigned long long)pk2(v[j].z, v[j].w) << 32);
        if (lane < 16) ss[(size_t)m * 16 + lane] = lane == 0 ? s : 0.f;
    }
    float* cs1 = (float*)(ws + WS_CSSWA); float* cs2 = (float*)(ws + WS_CSMLA);
    for (int idx = gtid; idx < SEQ * 48; idx += NT) {
        const int t = idx / 48, i = idx % 48; float inv; float* dst;
        if (i < 32) { inv = exp2f(-(float)i * (LOG2_10000 / 32.0f)); dst = cs1 + ((size_t)t * 32 + i) * 2; } else { inv = exp2f(-(float)(i - 32) * (LOG2_10000 / 16.0f)); dst = cs2 + ((size_t)t * 16 + (i - 32)) * 2; }
        const float ang = (float)t * inv; const double rev = (double)ang * 0.15915494309189535; const float fr = (float)(rev - rint(rev));
        dst[0] = __builtin_amdgcn_cosf(fr); dst[1] = __builtin_amdgcn_sinf(fr);
    }
}

__device__ __forceinline__ void ld8(const bf16* p, float* x) { const uint4 w = *(const uint4*)p; x[0] = bflo(w.x); x[1] = bfhi(w.x); x[2] = bflo(w.y); x[3] = bfhi(w.y); x[4] = bflo(w.z); x[5] = bfhi(w.z); x[6] = bflo(w.w); x[7] = bfhi(w.w); }
__device__ __forceinline__ void st8(bf16* p, const float* x) { uint4 w; w.x = pk2(x[0], x[1]); w.y = pk2(x[2], x[3]); w.z = pk2(x[4], x[5]); w.w = pk2(x[6], x[7]); *(uint4*)p = w; }

__device__ __forceinline__ void naive_prep(int l, int gtid, int NT) {
    unsigned char* ws = aws();
    const bf16* xbcr = (const bf16*)(ws + WS_XBCR); bf16* xbcc = (bf16*)(ws + WS_XBCC);
    const float* cw = ain(I_CONVW) + l * 5 * 1024; const float* cb = ain(I_CONVB) + l * 1024;
    for (int idx = gtid; idx < M * 512; idx += NT) {
        const int m = idx >> 9, cp = idx & 511, t = m & (SEQ - 1); float a0 = cb[2 * cp], a1 = cb[2 * cp + 1];
#pragma unroll
        for (int k = 0; k < 5; ++k) { const int tt = t + k - 2; if (tt >= 0 && tt < SEQ) { const unsigned w = *(const unsigned*)(xbcr + (size_t)(m + k - 2) * 1024 + 2 * cp); a0 += bflo(w) * cw[k * 1024 + 2 * cp]; a1 += bfhi(w) * cw[k * 1024 + 2 * cp + 1]; } }
        *(unsigned*)(xbcc + (size_t)m * 1024 + 2 * cp) = pk2(silu_f(a0), silu_f(a1));
    }
    { const float* dtraw = (const float*)(ws + WS_DTRAW); float* dtc = (float*)(ws + WS_DTC); const float* bias = ain(I_DTB) + l * 16;
      for (int idx = gtid; idx < M * 16; idx += NT) { const int m = idx >> 4, d = idx & 15, dir = d >> 3, h = d & 7; dtc[((size_t)m * 8 + h) * 4 + dir] = softplus_f(dtraw[idx] + bias[d]); } }
    { bf16* swaq = (bf16*)(ws + WS_SWAQ); bf16* swakv = (bf16*)(ws + WS_SWAKV); const float* cs = (const float*)(ws + WS_CSSWA);
      for (int idx = gtid; idx < M * 6; idx += NT) {
          const int m = idx / 6, hh = idx % 6, t = m & (SEQ - 1); bf16* p = hh < 4 ? swaq + (size_t)m * 256 + hh * 64 : swakv + (size_t)m * 256 + (hh - 4) * 64;
          const float* w = (hh < 4 ? ain(I_SWAQN) : ain(I_SWAKN)) + l * 64; float x[64]; float s = 0.f;
#pragma unroll
          for (int j = 0; j < 8; ++j) ld8(p + 8 * j, x + 8 * j);
#pragma unroll
          for (int i = 0; i < 64; ++i) s += x[i] * x[i];
          const float r = rsqrtf(s * (1.0f / 64.0f) + EPS);
#pragma unroll
          for (int i = 0; i < 64; ++i) x[i] = x[i] * r * w[i];
#pragma unroll
          for (int i = 0; i < 32; ++i) { const float c = cs[((size_t)t * 32 + i) * 2], sn = cs[((size_t)t * 32 + i) * 2 + 1]; const float x1 = x[i], x2 = x[i + 32]; x[i] = x1 * c - x2 * sn; x[i + 32] = x1 * sn + x2 * c; }
#pragma unroll
          for (int j = 0; j < 8; ++j) st8(p + 8 * j, x + 8 * j);
      }
      bf16* vt = (bf16*)(ws + WS_SWAVT);
      for (int idx = gtid; idx < NB * 2 * 64 * SEQ; idx += NT) { const int t = idx & (SEQ - 1), dv = (idx >> 12) & 63, kvh = (idx >> 18) & 1, b = idx >> 19; vt[idx] = swakv[(size_t)(b * SEQ + t) * 256 + 128 + kvh * 64 + dv]; }
    }
    { const bf16* qr = (const bf16*)(ws + WS_MLAQR); const bf16* mm = (const bf16*)(ws + WS_MLAM); const float* cs = (const float*)(ws + WS_CSMLA);
      bf16* mq = (bf16*)(ws + WS_MLAQ); bf16* mk = (bf16*)(ws + WS_MLAK); bf16* mvt = (bf16*)(ws + WS_MLAVT);
      const float* wuq = ain(I_WUQ) + (size_t)l * 256 * 384; const float* wukv = ain(I_WUKV) + (size_t)l * 128 * 512;
      const float* wl = ain(I_MQLN) + l * 256; const float* wkv = ain(I_MKVN) + l * 128; const float* wq = ain(I_MQN) + l * 96; const float* wk = ain(I_MKN) + l * 96;
      for (int idx = gtid; idx < M * 12; idx += NT) {
          const int j = idx / M, m = idx % M, t = m & (SEQ - 1), b = m >> 12;
          if (j < 4) {
              const bf16* src = qr + (size_t)m * 256; float s = 0.f;
#pragma unroll 4
              for (int k = 0; k < 256; ++k) { const float v = bf2f(src[k]); s += v * v; }
              const float r = rsqrtf(s * (1.0f / 256.0f) + EPS); float acc[96];
#pragma unroll
              for (int o = 0; o < 96; ++o) acc[o] = 0.f;
#pragma unroll 1
              for (int k = 0; k < 256; ++k) { const float xk = bf2f(src[k]) * r * wl[k]; const float* wrow = wuq + (size_t)k * 384 + j * 96;
#pragma unroll
                  for (int oc = 0; oc < 3; ++oc) {
#pragma unroll
                      for (int o = 0; o < 32; ++o) acc[oc * 32 + o] += xk * wrow[oc * 32 + o];
                      asm volatile("" ::: "memory"); } }
              float s2 = 0.f;
#pragma unroll
              for (int o = 0; o < 96; ++o) s2 += acc[o] * acc[o];
              const float r2 = rsqrtf(s2 * (1.0f / 96.0f) + EPS);
#pragma unroll
              for (int o = 0; o < 96; ++o) acc[o] = acc[o] * r2 * wq[o];
#pragma unroll
              for (int i = 0; i < 16; ++i) { const float c = cs[((size_t)t * 16 + i) * 2], sn = cs[((size_t)t * 16 + i) * 2 + 1]; const float x1 = acc[64 + i], x2 = acc[80 + i]; acc[64 + i] = x1 * c - x2 * sn; acc[80 + i] = x1 * sn + x2 * c; }
#pragma unroll
              for (int o = 0; o < 12; ++o) st8(mq + (size_t)m * 384 + j * 96 + 8 * o, acc + 8 * o);
          } else {
              const int hh = (j - 4) & 3; const bool isv = j >= 8; const bf16* src = mm + (size_t)m * 256; float s = 0.f;
#pragma unroll 4
              for (int k = 0; k < 128; ++k) { const float v = bf2f(src[k]); s += v * v; }
              const float r = rsqrtf(s * (1.0f / 128.0f) + EPS); float acc[64];
#pragma unroll
              for (int o = 0; o < 64; ++o) acc[o] = 0.f;
#pragma unroll 1
              for (int k = 0; k < 128; ++k) { const float xk = bf2f(src[k]) * r * wkv[k]; const float* wrow = wukv + (size_t)k * 512 + hh * 128 + (isv ? 64 : 0);
#pragma unroll
                  for (int oc = 0; oc < 2; ++oc) {
#pragma unroll
                      for (int o = 0; o < 32; ++o) acc[oc * 32 + o] += xk * wrow[oc * 32 + o];
                      asm volatile("" ::: "memory"); } }
              if (isv) {
#pragma unroll
                  for (int dv = 0; dv < 64; ++dv) mvt[((size_t)(b * 4 + hh) * 64 + dv) * SEQ + t] = (bf16)f2bf(acc[dv]);
              } else {
                  float kr[32];
#pragma unroll
                  for (int o = 0; o < 4; ++o) ld8(src + 128 + 8 * o, kr + 8 * o);
                  float s2 = 0.f;
#pragma unroll
                  for (int o = 0; o < 64; ++o) s2 += acc[o] * acc[o];
#pragma unroll
                  for (int o = 0; o < 32; ++o) s2 += kr[o] * kr[o];
                  const float r2 = rsqrtf(s2 * (1.0f / 96.0f) + EPS);
#pragma unroll
                  for (int o = 0; o < 64; ++o) acc[o] = acc[o] * r2 * wk[o];
#pragma unroll
                  for (int o = 0; o < 32; ++o) kr[o] = kr[o] * r2 * wk[64 + o];
#pragma unroll
                  for (int i = 0; i < 16; ++i) { const float c = cs[((size_t)t * 16 + i) * 2], sn = cs[((size_t)t * 16 + i) * 2 + 1]; const float x1 = kr[i], x2 = kr[16 + i]; kr[i] = x1 * c - x2 * sn; kr[16 + i] = x1 * sn + x2 * c; }
#pragma unroll
                  for (int o = 0; o < 8; ++o) st8(mk + (size_t)m * 384 + hh * 96 + 8 * o, acc + 8 * o);
#pragma unroll
                  for (int o = 0; o < 4; ++o) st8(mk + (size_t)m * 384 + hh * 96 + 64 + 8 * o, kr + 8 * o);
              }
          }
      }
    }
}

__device__ __forceinline__ void naive_mixers(int l, int gtid, int NT, int wave, int lane) {
    unsigned char* ws = aws(); bf16* y = (bf16*)(ws + WS_Y);
    { const int unit = wave * (int)gridDim.x + (int)blockIdx.x;
      if (unit < 64) {
          const int tid = unit * 64 + lane, nh = tid & 1, p = (tid >> 1) & 63, h = (tid >> 7) & 7, b = tid >> 10, g = h >> 2;
          const bf16* xbcc = (const bf16*)(ws + WS_XBCC); const float* dtc = (const float*)(ws + WS_DTC); float* ytmp = (float*)(ws + WS_YTMP); const bf16* z = (const bf16*)(ws + WS_Z);
          const float Af = -expf(ain(I_ALOG)[l * 16 + h]), Ab = -expf(ain(I_ALOG)[l * 16 + 8 + h]), Dh = ain(I_SSDD)[l * 8 + h];
          float st[64];
          for (int dir = 0; dir < 2; ++dir) {
#pragma unroll
              for (int n = 0; n < 64; ++n) st[n] = 0.f;
              for (int s = 0; s < SEQ; ++s) {
                  const int t = dir == 0 ? s : SEQ - 1 - s; const size_t m = (size_t)b * SEQ + t;
                  const float dt = dtc[(m * 8 + h) * 4 + dir]; const float dA = __expf(dt * (dir == 0 ? Af : Ab));
                  const float xv = bf2f(xbcc[m * 1024 + h * 64 + p]); const float coef = dt * xv;
                  const bf16* Bp = xbcc + m * 1024 + 512 + g * 128 + nh * 64; const bf16* Cp = xbcc + m * 1024 + 768 + g * 128 + nh * 64; float yv = 0.f;
#pragma unroll
                  for (int q = 0; q < 8; ++q) { float Bv[8], Cv[8]; ld8(Bp + 8 * q, Bv); ld8(Cp + 8 * q, Cv);
#pragma unroll
                      for (int e = 0; e < 8; ++e) { st[8 * q + e] = st[8 * q + e] * dA + coef * Bv[e]; yv += Cv[e] * st[8 * q + e]; } }
                  yv += __shfl_xor(yv, 1);
                  if (dir == 0) { if (nh == 0) ytmp[m * 512 + h * 64 + p] = yv; }
                  else if (nh == 0) { const float tot = ytmp[m * 512 + h * 64 + p] + yv + Dh * xv; const float zz = bf2f(z[m * 512 + h * 64 + p]); y[m * 1024 + h * 64 + p] = (bf16)f2bf(tot * silu_f(zz)); }
              }
          }
      }
    }
    { const bf16* swaq = (const bf16*)(ws + WS_SWAQ); const bf16* swakv = (const bf16*)(ws + WS_SWAKV);
      for (int idx = gtid; idx < NB * 4 * SEQ; idx += NT) {
          const int t = idx & (SEQ - 1), h = (idx >> 12) & 3, b = idx >> 14, kvh = h >> 1; const size_t m = (size_t)b * SEQ + t;
          float q[64], o[64];
#pragma unroll
          for (int j = 0; j < 8; ++j) ld8(swaq + m * 256 + h * 64 + 8 * j, q + 8 * j);
#pragma unroll
          for (int i = 0; i < 64; ++i) o[i] = 0.f;
          float mx = ain(I_SINK)[l * 4 + h], den = 1.f;
          const int j0 = t - 128 < 0 ? 0 : t - 128, j1 = t + 128 > SEQ - 1 ? SEQ - 1 : t + 128;
          for (int jt = j0; jt <= j1; ++jt) {
              const bf16* kp = swakv + ((size_t)b * SEQ + jt) * 256 + kvh * 64; float s = 0.f;
#pragma unroll
              for (int j = 0; j < 8; ++j) { float kv[8]; ld8(kp + 8 * j, kv);
#pragma unroll
                  for (int e = 0; e < 8; ++e) s += q[8 * j + e] * kv[e]; }
              s *= 0.125f; const float mn = fmaxf(mx, s), al = __expf(mx - mn), pe = __expf(s - mn); den = den * al + pe; mx = mn;
              const bf16* vp = kp + 128;
#pragma unroll
              for (int j = 0; j < 8; ++j) { float vv[8]; ld8(vp + 8 * j, vv);
#pragma unroll
                  for (int e = 0; e < 8; ++e) o[8 * j + e] = o[8 * j + e] * al + pe * vv[e]; }
          }
          const float inv = 1.0f / den;
#pragma unroll
          for (int i = 0; i < 64; ++i) o[i] *= inv;
#pragma unroll
          for (int j = 0; j < 8; ++j) st8(y + m * 1024 + 512 + h * 64 + 8 * j, o + 8 * j);
      }
    }
    { const bf16* mq = (const bf16*)(ws + WS_MLAQ); const bf16* mk = (const bf16*)(ws + WS_MLAK); const bf16* mvt = (const bf16*)(ws + WS_MLAVT);
      const float sc = 0.10206207261596577f;
      for (int idx = gtid; idx < NB * 4 * SEQ; idx += NT) {
          const int t = idx & (SEQ - 1), h = (idx >> 12) & 3, b = idx >> 14; const size_t m = (size_t)b * SEQ + t;
          float q[96], o[64];
#pragma unroll
          for (int j = 0; j < 12; ++j) ld8(mq + m * 384 + h * 96 + 8 * j, q + 8 * j);
#pragma unroll
          for (int i = 0; i < 64; ++i) o[i] = 0.f;
          float mx = -1e30f, den = 0.f; const bf16* vt = mvt + (size_t)(b * 4 + h) * 64 * SEQ;
          for (int jt = 0; jt < SEQ; ++jt) {
              const bf16* kp = mk + ((size_t)b * SEQ + jt) * 384 + h * 96; float s = 0.f;
#pragma unroll
              for (int j = 0; j < 12; ++j) { float kv[8]; ld8(kp + 8 * j, kv);
#pragma unroll
                  for (int e = 0; e < 8; ++e) s += q[8 * j + e] * kv[e]; }
              s *= sc; const float mn = fmaxf(mx, s), al = __expf(mx - mn), pe = __expf(s - mn); den = den * al + pe; mx = mn;
#pragma unroll
              for (int dv = 0; dv < 64; ++dv) o[dv] = o[dv] * al + pe * bf2f(vt[(size_t)dv * SEQ + jt]);
          }
          const float inv = 1.0f / den;
#pragma unroll
          for (int i = 0; i < 64; ++i) o[i] *= inv;
#pragma unroll
          for (int j = 0; j < 8; ++j) st8(y + m * 1024 + 768 + h * 64 + 8 * j, o + 8 * j);
      }
    }
}
__device__ __forceinline__ void naive_normalize(int gtid, int NT) {
    bf16* y = (bf16*)(aws() + WS_Y);
    for (int idx = gtid; idx < M * 4; idx += NT) {
        bf16* p = y + (size_t)idx * 256; float s = 0.f;
#pragma unroll 2
        for (int j = 0; j < 32; ++j) { float v[8]; ld8(p + 8 * j, v);
#pragma unroll
            for (int e = 0; e < 8; ++e) s += v[e] * v[e]; }
        const float r = rsqrtf(s * (1.0f / 256.0f) + EPS);
#pragma unroll 2
        for (int j = 0; j < 32; ++j) { float v[8]; ld8(p + 8 * j, v);
#pragma unroll
            for (int e = 0; e < 8; ++e) v[e] *= r;
            st8(p + 8 * j, v); }
    }
}

constexpr int NPHASES = 1 + 9 * DEPTH;
#define PHASE_IDS \
    int zero = 0; asm volatile("" : "+s"(zero)); \
    const int wave = __builtin_amdgcn_readfirstlane((int)threadIdx.x >> 6) + zero; \
    const int G = (int)gridDim.x + zero, bx = (int)blockIdx.x + zero; \
    const int vcu = (G % 8 == 0) ? (bx % 8) * (G / 8) + bx / 8 : bx; \
    const int gw = vcu * NWAVES + wave, NGW = G * NWAVES, NT = G * NWAVES * 64; \
    int tid = threadIdx.x; asm volatile("" : "+v"(tid)); const int lane = tid & 63, gtid = bx * (NWAVES * 64) + tid; \
    unsigned char* ws = aws(); (void)lane; (void)gtid; (void)gw; (void)NGW; (void)NT; (void)wave; (void)ws;
#define GRID_BAR() do { XcdBarrier bar; bar.bar = (unsigned*)(aws() + WS_CTL) + CW_BAR; bar.x = xb_xcc_id(); bar.st = (volatile LAS unsigned*)(lds + MISC_OFF) + 8; xcd_barrier(bar); } while (0)
#define IN(k) (lo <= (k) && (k) < hi)
#define SEAM(k) do { if ((k) + 1 < hi) GRID_BAR(); } while (0)

template <int L> __device__ __forceinline__ void layer_phases(LAS unsigned char* lds, int lo, int hi) {
    constexpr int P = 1 + 9 * L;
    if (IN(P + 0)) {
        PHASE_IDS
        pg8::Gemm g{(const bf16*)(ws + WS_XB), (const bf16*)(ws + WS_WGU1), M, 2 * FF, D}; pg8::StaticOrder S; S.init(M, 2 * FF, G, bx);
        EpiGU E{(bf16*)(ws + WS_HB), (const float*)(ws + WS_SS)};
        pg8::gemm_phase<EpiGU, pg8::StaticOrder, true, true>(lds, g, S, E);
        SEAM(P + 0);
    }
    if (IN(P + 1)) {
        PHASE_IDS
        pg8::Gemm g{(const bf16*)(ws + WS_HB), (const bf16*)(ws + WS_WD1), M, D, FF}; pg8::StaticOrder S; S.init(M, D, G, bx);
        EpiDown<0> E{L == 0 ? ain(I_X) : aout(), aout(), (bf16*)(ws + WS_XB), (float*)(ws + WS_SS), 0.5f, nullptr};
        pg8::gemm_phase<EpiDown<0>, pg8::StaticOrder, false, true>(lds, g, S, E);
        SEAM(P + 1);
    }
    if (IN(P + 2)) {
        PHASE_IDS
        pg8::Gemm g{(const bf16*)(ws + WS_XB), (const bf16*)(ws + WS_WIN), M, NPROJP, D}; pg8::StaticOrder S; S.init(M, NPROJP, G, bx);
        EpiProj E{(bf16*)(ws + WS_PROJ), (float*)(ws + WS_DTRAW), (const float*)(ws + WS_SS)};
        pg8::gemm_phase<EpiProj, pg8::StaticOrder, true, true>(lds, g, S, E);
        SEAM(P + 2);
    }
    if (IN(P + 3)) {
        PHASE_IDS
#ifndef NO_P0
        if (L == 0) convert_weights(1, 0, lds, gw, NGW, wave, lane);
        else convert_weights(1, 1, lds, gw, NGW, wave, lane);
#endif
        SEAM(P + 3);
    }
    if (IN(P + 4)) {
        PHASE_IDS
        SEAM(P + 4);
    }
    if (IN(P + 5)) {
        PHASE_IDS
        SEAM(P + 5);
    }
    if (IN(P + 6)) {
        PHASE_IDS
        pg8::Gemm g{(const bf16*)(ws + WS_Y), (const bf16*)(ws + WS_WOUT), M, D, D}; pg8::StaticOrder S; S.init(M, D, G, bx);
        EpiDown<0> E{aout(), aout(), (bf16*)(ws + WS_XB), (float*)(ws + WS_SS), 1.0f, nullptr};
        pg8::gemm_phase<EpiDown<0>, pg8::StaticOrder, false, true>(lds, g, S, E);
        SEAM(P + 6);
    }
    if (IN(P + 7)) {
        PHASE_IDS
        pg8::Gemm g{(const bf16*)(ws + WS_XB), (const bf16*)(ws + WS_WGU2), M, 2 * FF, D}; pg8::StaticOrder S; S.init(M, 2 * FF, G, bx);
        EpiGU E{(bf16*)(ws + WS_HB), (const float*)(ws + WS_SS)};
        pg8::gemm_phase<EpiGU, pg8::StaticOrder, true, true>(lds, g, S, E);
        SEAM(P + 7);
    }
    if (IN(P + 8)) {
        PHASE_IDS
        pg8::Gemm g{(const bf16*)(ws + WS_HB), (const bf16*)(ws + WS_WD2), M, D, FF}; pg8::StaticOrder S; S.init(M, D, G, bx);
        EpiDown<0> E{aout(), aout(), (bf16*)(ws + WS_XB), (float*)(ws + WS_SS), 0.5f, nullptr};
        pg8::gemm_phase<EpiDown<0>, pg8::StaticOrder, false, true>(lds, g, S, E);
        SEAM(P + 8);
    }
}

__global__ void __launch_bounds__(NWAVES * 64, 2) mk_fwd(Args args) {
    extern __shared__ __attribute__((aligned(16))) unsigned char lds_raw[];
    LAS unsigned char* lds = (LAS unsigned char*)lds_raw;
    for (int u = threadIdx.x; u < (LDS_BYTES - LDSCTL_OFF) / 4; u += NWAVES * 64) ((LAS unsigned*)(lds + LDSCTL_OFF))[u] = 0u;
    __syncthreads();
    const int lo = ((const int*)__builtin_amdgcn_kernarg_segment_ptr())[2 * (N_IN + 2)], hi = ((const int*)__builtin_amdgcn_kernarg_segment_ptr())[2 * (N_IN + 2) + 1];
    if (hi - lo > 1) (void)xcd_barrier_post((unsigned*)(aws() + WS_CTL) + CW_BAR, (volatile LAS unsigned*)(lds + MISC_OFF) + 8);
    if (IN(0)) {
        PHASE_IDS
#ifndef NO_P0
        convert_weights(0, 0, lds, gw, NGW, wave, lane);
        convert_weights(0, 1, lds, gw, NGW, wave, lane);
        p0_x_and_tables(gw, NGW, lane, gtid, NT);
#endif
        SEAM(0);
    }
    layer_phases<0>(lds, lo, hi);
    layer_phases<1>(lds, lo, hi);
}


__global__ void __launch_bounds__(256) naive_k(Args args, int what, int l) {
    const int tid = threadIdx.x, lane = tid & 63, wave = tid >> 6; const int gtid = blockIdx.x * 256 + tid, NT = gridDim.x * 256;
    if (what == 3) naive_prep(l, gtid, NT);
    else if (what == 4) naive_mixers(l, gtid, NT, wave, lane);
    else naive_normalize(gtid, NT);
}

extern "C" void kernel_launch(void* const* d_in, const int* in_sizes, int n_in, void* d_out, int out_size, void* d_ws, size_t ws_size, hipStream_t stream) {
    static int grid = 0;
    if (grid == 0) {
        if (n_in != N_IN || out_size != M * D || ws_size < WS_END) { fprintf(stderr, "kernel_launch: unexpected shapes (n_in %d out %d ws %zu)\n", n_in, out_size, ws_size); grid = -1; return; }
        int dev = 0, cus = 0, per_cu = 0;
        if (hipGetDevice(&dev) != hipSuccess || hipDeviceGetAttribute(&cus, hipDeviceAttributeMultiprocessorCount, dev) != hipSuccess) { grid = -1; return; }
        if (hipFuncSetAttribute((const void*)mk_fwd, hipFuncAttributeMaxDynamicSharedMemorySize, LDS_BYTES) != hipSuccess) { fprintf(stderr, "kernel_launch: hipFuncSetAttribute failed\n"); grid = -1; return; }
        if (hipOccupancyMaxActiveBlocksPerMultiprocessor(&per_cu, (const void*)mk_fwd, NWAVES * 64, LDS_BYTES) != hipSuccess || per_cu < 1) fprintf(stderr, "kernel_launch: occupancy query says %d\n", per_cu);
        (void)hipGetLastError();
        grid = cus;
    }
    if (grid < 0) return;
    (void)hipMemsetAsync((char*)d_ws + WS_CTL, 0, CTL_ZERO_BYTES, stream);
    Args a{};
    for (int i = 0; i < N_IN; ++i) a.in[i] = (const float*)d_in[i];
    a.out = (float*)d_out; a.ws = (unsigned char*)d_ws;
#ifndef MK_ONE_LAUNCH
#define MK_ONE_LAUNCH 0
#endif
    if (MK_ONE_LAUNCH) { a.ph_lo = 0; a.ph_hi = NPHASES; hipLaunchKernelGGL(mk_fwd, dim3(grid), dim3(NWAVES * 64), LDS_BYTES, stream, a); }
    else for (int p = 0; p < NPHASES; ++p) {
        const int k = p == 0 ? -1 : (p - 1) % 9, l = p == 0 ? 0 : (p - 1) / 9;
        if (k == 3 || k == 4 || k == 5) hipLaunchKernelGGL(naive_k, dim3(1024), dim3(256), 0, stream, a, k, l);
        if (k == 4 || k == 5) continue;
        a.ph_lo = p; a.ph_hi = p + 1; hipLaunchKernelGGL(mk_fwd, dim3(grid), dim3(NWAVES * 64), LDS_BYTES, stream, a);
    }
}
```

```cpp
#include <hip/hip_runtime.h>
#include <cstdio>
#include <cstdint>

namespace pg8 {
#define PG8_LAS __attribute__((address_space(3)))

typedef unsigned short bf16_t;
typedef short bf16x8 __attribute__((ext_vector_type(8)));
typedef float f32x4 __attribute__((ext_vector_type(4)));
typedef unsigned u32x4 __attribute__((ext_vector_type(4)));
constexpr int BM = 256, BK = 64, HALF = 128, HTB = HALF * BK * 2  , STAGE_BYTES = 8 * HTB, NXCD = 8, WGM = 8;

__host__ __device__ __forceinline__ int lds_byte(int r, int c) { const int st = (r >> 4) * 2 + (c >> 5), rr = r & 15, cc = c & 31, ob = rr * 64 + cc * 2; return st * 1024 + (ob ^ (((ob >> 9) & 1) << 5)); }
__host__ __device__ __forceinline__ void stage_rc(int b, int& R, int& C) { const int st = b / 1024, sb = b % 1024, swz = sb ^ (((sb >> 9) & 1) << 5); R = (st >> 1) * 16 + swz / 64; C = (st & 1) * 32 + (swz % 64) / 2; }
__host__ __device__ __forceinline__ int perm32(int rho) { const int n = rho >> 4, i = rho & 15; return 8 * (i >> 2) + 4 * n + (i & 3); }

struct Unit { int pm, pn; };
struct Gemm { const bf16_t* A; const bf16_t* Bt; int M, N, K; };

struct StaticOrder {
    int nM, nN, nwg, G, c;
    __host__ __device__ __forceinline__ void init(int M, int N, int G_, int c_) { nM = M / BM; nN = N / BM; nwg = nM * nN; G = G_; c = c_; }
    __host__ __device__ __forceinline__ bool next(int i, Unit& u) const {
        const long L = (long)i * G + c; if (L >= nwg) return false;
        int wgid = (int)L; { const int q = nwg / NXCD, r = nwg % NXCD, xcd = wgid % NXCD, off = wgid / NXCD; wgid = (xcd < r ? xcd * (q + 1) : r * (q + 1) + (xcd - r) * q) + off; }
        const int nig = WGM * nN, gid = wgid / nig, fm = gid * WGM, gsz = (nM - fm) < WGM ? (nM - fm) : WGM;
        u.pm = fm + ((wgid % nig) % gsz); u.pn = (wgid % nig) / gsz; return true;
    }
    __device__ __forceinline__ void a_ready(const Unit&) const {}
    __device__ __forceinline__ void done(const Unit&) const {}
};


__device__ __forceinline__ unsigned cvt_pk_bf16(float lo, float hi) { unsigned r; asm volatile("v_cvt_pk_bf16_f32 %0, %1, %2" : "=v"(r) : "v"(lo), "v"(hi)); return r; }

template <class Epi, class Sched, bool ALIGN_EPI = false, bool SP2 = false>
__device__ __forceinline__ void gemm_phase(PG8_LAS unsigned char* lds, const Gemm g, const Sched& S, const Epi& E) {
    int tid_ = threadIdx.x; asm volatile("" : "+v"(tid_)); const int tid = tid_, wid = __builtin_amdgcn_readfirstlane(tid >> 6), lane = tid & 63, wr = wid >> 2, wc = wid & 3, fr = lane & 15, fq = lane >> 4;
    const int K = g.K, nt = K / BK;
    unsigned voffA[2], voffB[2];
#pragma unroll
    for (int i = 0; i < 2; ++i) { int R, C; stage_rc(tid * 16 + i * 8192, R, C); const int Rb = Epi::PERM ? ((R & ~31) + perm32(R & 31)) : R;
        voffA[i] = (unsigned)(R * K + C) * 2u; voffB[i] = (unsigned)(Rb * K + C) * 2u; }
    const size_t kstep = (size_t)(BK * 2);
    const size_t hstep = (size_t)HALF * K * 2;
    const size_t tstep = 2 * hstep;
    const unsigned ldsw = (unsigned)wid * 1024u;
    const int aoff = lds_byte(wr * 64 + fr, fq * 8), boff = lds_byte(wc * 32 + fr, fq * 8);
#define PG8_SA(b, h) (((b) * 2 + (h)) * HTB)
#define PG8_SB(b, h) ((4 + (b) * 2 + (h)) * HTB)
#define PG8_STAGE(bufoff, gbase, voff) do { _Pragma("unroll") for (int _i = 0; _i < 2; ++_i) \
        __builtin_amdgcn_global_load_lds((const unsigned*)((const char*)(gbase) + (voff)[_i]), (PG8_LAS unsigned*)(lds + (bufoff) + ldsw + _i * 8192), 16, 0, 0); } while (0)
#define PG8_STAGE_A(bufoff, gbase, voff) do { _Pragma("unroll") for (int _i = 0; _i < 2; ++_i) \
        __builtin_amdgcn_global_load_lds((const unsigned*)((const char*)(gbase) + (voff)[_i]), (PG8_LAS unsigned*)(lds + (bufoff) + ldsw + _i * 8192), 16, 0, Epi::AUX_A); } while (0)
#define PG8_LDA(dst, b, h) do { _Pragma("unroll") for (int m = 0; m < 4; ++m) _Pragma("unroll") for (int k = 0; k < 2; ++k) dst[m][k] = *(const PG8_LAS bf16x8*)(lds + PG8_SA(b, h) + aoff + m * 2048 + k * 1024); } while (0)
#define PG8_LDB(dst, b, h) do { _Pragma("unroll") for (int n = 0; n < 2; ++n) _Pragma("unroll") for (int k = 0; k < 2; ++k) dst[n][k] = *(const PG8_LAS bf16x8*)(lds + PG8_SB(b, h) + boff + n * 2048 + k * 1024); } while (0)
#define PG8_MMA(ai, bj, At, Bt) do { __builtin_amdgcn_s_setprio(1); _Pragma("unroll") for (int m = 0; m < 4; ++m) _Pragma("unroll") for (int n = 0; n < 2; ++n) _Pragma("unroll") for (int k = 0; k < 2; ++k) \
        acc[ai][bj][m][n] = __builtin_amdgcn_mfma_f32_16x16x32_bf16(Bt[n][k], At[m][k], acc[ai][bj][m][n], 0, 0, 0); __builtin_amdgcn_s_setprio(0); } while (0)
#define PG8_WAIT_V(n) asm volatile("s_waitcnt vmcnt(" #n ")" ::: "memory")
#define PG8_WAIT_L(n) asm volatile("s_waitcnt lgkmcnt(" #n ")" ::: "memory")
#define PG8_BAR __builtin_amdgcn_s_barrier()
#define PG8_SCHED __builtin_amdgcn_sched_barrier(0)
    Unit cur, nxt; int ui = 0;
    if (!S.next(0, cur)) return;
    f32x4 acc[2][2][4][2];
#pragma unroll
    for (int a = 0; a < 2; ++a)
#pragma unroll
        for (int b = 0; b < 2; ++b)
#pragma unroll
            for (int m = 0; m < 4; ++m)
#pragma unroll
                for (int n = 0; n < 2; ++n) acc[a][b][m][n] = (f32x4){0.f, 0.f, 0.f, 0.f};
    bf16x8 At[4][2], B0[2][2], B1[2][2];
    const char* cA = (const char*)g.A + (size_t)cur.pm * tstep; const char* cB = (const char*)g.Bt + (size_t)cur.pn * tstep;
    S.a_ready(cur);
    if constexpr (SP2) {
        PG8_STAGE(PG8_SB(0, 0), cB, voffB); PG8_STAGE(PG8_SB(0, 1), cB + hstep, voffB); PG8_STAGE_A(PG8_SA(0, 0), cA, voffA); PG8_STAGE_A(PG8_SA(0, 1), cA + hstep, voffA);
        if (wr == 1) PG8_BAR;
        PG8_WAIT_V(2); PG8_BAR;
        PG8_STAGE(PG8_SB(1, 0), cB + kstep, voffB); PG8_STAGE_A(PG8_SA(1, 0), cA + kstep, voffA); PG8_STAGE(PG8_SB(1, 1), cB + hstep + kstep, voffB);
        PG8_WAIT_V(6); PG8_BAR;
    } else {
        PG8_STAGE(PG8_SB(0, 0), cB, voffB); PG8_STAGE_A(PG8_SA(0, 0), cA, voffA); PG8_STAGE(PG8_SB(0, 1), cB + hstep, voffB); PG8_STAGE_A(PG8_SA(0, 1), cA + hstep, voffA);
        if (wr == 1) PG8_BAR;
        PG8_WAIT_V(4); PG8_BAR;
        PG8_STAGE(PG8_SB(1, 0), cB + kstep, voffB); PG8_STAGE_A(PG8_SA(1, 0), cA + kstep, voffA); PG8_STAGE(PG8_SB(1, 1), cB + hstep + kstep, voffB);
        PG8_WAIT_V(6); PG8_BAR;
    }
    for (;;) {
        const bool has_next = S.next(ui + 1, nxt);
        const char* nA = has_next ? (const char*)g.A + (size_t)nxt.pm * tstep : cA; const char* nB = has_next ? (const char*)g.Bt + (size_t)nxt.pn * tstep : cB;
        for (int t = 0; t < nt; t += 2) {
            const bool last = (t == nt - 2);
            const char* a1 = cA + (size_t)(t + 1) * kstep;
            const char* a2 = last ? nA : cA + (size_t)(t + 2) * kstep; const char* b2 = last ? nB : cB + (size_t)(t + 2) * kstep;
            const char* a3 = a2 + kstep; const char* b3 = b2 + kstep;
            if (last && has_next) S.a_ready(nxt);
            if constexpr (SP2) {
            PG8_LDB(B0, 0, 0); PG8_LDB(B1, 0, 1); PG8_SCHED; PG8_LDA(At, 0, 0); PG8_STAGE_A(PG8_SA(1, 1), a1 + hstep, voffA);
            PG8_WAIT_V(8); PG8_WAIT_L(0); PG8_BAR; PG8_MMA(0, 0, At, B0); PG8_MMA(0, 1, At, B1); PG8_BAR; PG8_SCHED;
            PG8_LDA(At, 0, 1); PG8_STAGE(PG8_SB(0, 0), b2, voffB); PG8_STAGE(PG8_SB(0, 1), b2 + hstep, voffB); PG8_STAGE_A(PG8_SA(0, 0), a2, voffA);
            PG8_WAIT_V(8); PG8_WAIT_L(0); PG8_BAR; PG8_MMA(1, 0, At, B0); PG8_MMA(1, 1, At, B1); PG8_BAR; PG8_SCHED;
            PG8_LDB(B0, 1, 0); PG8_LDB(B1, 1, 1); PG8_SCHED; PG8_LDA(At, 1, 0); PG8_STAGE_A(PG8_SA(0, 1), a2 + hstep, voffA);
            PG8_WAIT_V(8); PG8_WAIT_L(0); PG8_BAR; PG8_MMA(0, 0, At, B0); PG8_MMA(0, 1, At, B1); PG8_BAR; PG8_SCHED;
            PG8_LDA(At, 1, 1); PG8_STAGE(PG8_SB(1, 0), b3, voffB); PG8_STAGE(PG8_SB(1, 1), b3 + hstep, voffB); PG8_STAGE_A(PG8_SA(1, 0), a3, voffA);
            PG8_WAIT_V(8); PG8_WAIT_L(0); PG8_BAR; PG8_MMA(1, 0, At, B0); PG8_MMA(1, 1, At, B1); PG8_BAR; PG8_SCHED;
            } else {
            PG8_LDB(B0, 0, 0); PG8_SCHED; PG8_LDA(At, 0, 0); PG8_STAGE_A(PG8_SA(1, 1), a1 + hstep, voffA);
            PG8_WAIT_L(8); PG8_BAR; PG8_WAIT_L(0); PG8_MMA(0, 0, At, B0); PG8_BAR; PG8_SCHED;
            PG8_LDB(B1, 0, 1); PG8_STAGE(PG8_SB(0, 0), b2, voffB);
            PG8_BAR; PG8_WAIT_L(0); PG8_MMA(0, 1, At, B1); PG8_BAR;
            PG8_LDA(At, 0, 1); PG8_STAGE_A(PG8_SA(0, 0), a2, voffA);
            PG8_BAR; PG8_WAIT_L(0); PG8_MMA(1, 0, At, B0); PG8_BAR; PG8_SCHED;
            PG8_STAGE(PG8_SB(0, 1), b2 + hstep, voffB);
            PG8_WAIT_V(6); PG8_BAR; PG8_MMA(1, 1, At, B1); PG8_BAR;
            PG8_LDB(B0, 1, 0); PG8_SCHED; PG8_LDA(At, 1, 0); PG8_STAGE_A(PG8_SA(0, 1), a2 + hstep, voffA);
            PG8_WAIT_L(8); PG8_BAR; PG8_WAIT_L(0); PG8_MMA(0, 0, At, B0); PG8_BAR; PG8_SCHED;
            PG8_LDB(B1, 1, 1); PG8_STAGE(PG8_SB(1, 0), b3, voffB);
            PG8_BAR; PG8_WAIT_L(0); PG8_MMA(0, 1, At, B1); PG8_BAR;
            PG8_LDA(At, 1, 1); PG8_STAGE_A(PG8_SA(1, 0), a3, voffA);
            PG8_BAR; PG8_WAIT_L(0); PG8_MMA(1, 0, At, B0); PG8_BAR; PG8_SCHED;
            PG8_STAGE(PG8_SB(1, 1), b3 + hstep, voffB);
            PG8_WAIT_V(6); PG8_BAR; PG8_MMA(1, 1, At, B1); PG8_BAR;
            }
            if constexpr (Epi::KHOOK) { if ((((t + 2) & 3) == 0) && !last) E.khook(acc, (t + 2) / 4 - 1, wr, fr); }
            if constexpr (Epi::PF_T > 0) { if (t == nt - Epi::PF_T) E.prefetch(cur, lds, tid, wid); }
        }
        if constexpr (ALIGN_EPI) { if (wr == 0) PG8_BAR; }
        if constexpr (!Epi::AFTER_DRAIN) { E(acc, cur, wr, wc, fr, fq); S.done(cur); }
        if (!has_next) break;
#pragma unroll
        for (int a = 0; a < 2; ++a)
#pragma unroll
            for (int b = 0; b < 2; ++b)
#pragma unroll
                for (int m = 0; m < 4; ++m)
#pragma unroll
                    for (int n = 0; n < 2; ++n) acc[a][b][m][n] = (f32x4){0.f, 0.f, 0.f, 0.f};
        cur = nxt; cA = nA; cB = nB; ++ui;
        if constexpr (ALIGN_EPI) { if (wr == 1) PG8_BAR; }
    }
    PG8_WAIT_V(0);
    if constexpr (!ALIGN_EPI) { if (wr == 0) PG8_BAR; }
    PG8_BAR;
    if constexpr (Epi::AFTER_DRAIN) { E.fused(acc, cur, wr, wc, fr, fq, lds, wid, lane); S.done(cur); }
#undef PG8_SA
#undef PG8_SB
#undef PG8_STAGE
#undef PG8_STAGE_A
#undef PG8_LDA
#undef PG8_LDB
#undef PG8_MMA
#undef PG8_WAIT_V
#undef PG8_WAIT_L
#undef PG8_BAR
#undef PG8_SCHED
}
}

#define GAS __attribute__((address_space(1)))
#define LAS __attribute__((address_space(3)))
typedef unsigned short bf16;
typedef unsigned v4u __attribute__((ext_vector_type(4)));
typedef float f32x4 __attribute__((ext_vector_type(4)));
typedef short bf16x8 __attribute__((ext_vector_type(8)));
typedef GAS unsigned gu32;
typedef GAS unsigned long long gu64;
#define RLX_AGENT __ATOMIC_RELAXED, __HIP_MEMORY_SCOPE_AGENT
#define LDS_WAIT() asm volatile("s_waitcnt lgkmcnt(0)" ::: "memory")
#define VM_WAIT() asm volatile("s_waitcnt vmcnt(0)" ::: "memory")
__device__ __forceinline__ unsigned long long rt() { return __builtin_amdgcn_s_memrealtime(); }
__device__ __forceinline__ unsigned f2bf(float f) { unsigned u = __builtin_bit_cast(unsigned, f); return (u + 0x7fffu + ((u >> 16) & 1u)) >> 16; }
__device__ __forceinline__ unsigned pk2(float lo, float hi) { return f2bf(lo) | (f2bf(hi) << 16); }

#define XB_TMO      128
#define XB_XCNT(j)  (256  + 64 * (j))
#define XB_XSUB(j)  (1280 + 64 * (j))
#define XB_XGEN(j)  (2304 + 64 * (j))
#define XB_TOP      3328
#define XB_TOPGEN   3392
#define XCD_BAR_WORDS 3456
#define XB_SPIN_CAP (1u << 18)

__device__ __forceinline__ unsigned xb_ld(unsigned* p)              { return __hip_atomic_load(p, __ATOMIC_RELAXED, __HIP_MEMORY_SCOPE_AGENT); }
__device__ __forceinline__ unsigned xb_add(unsigned* p, unsigned v) { return __hip_atomic_fetch_add(p, v, __ATOMIC_RELAXED, __HIP_MEMORY_SCOPE_AGENT); }
__device__ __forceinline__ unsigned xb_xcc_id() { return (unsigned)__builtin_amdgcn_s_getreg((3 << 11) | 20) & 0xFu; }
#define XB_SPIN(cond, bar) do { unsigned _sp = 0; while (cond) { __builtin_amdgcn_s_sleep(1); \
    if ((++_sp & 255u) == 0u) { if (xb_ld(&(bar)[XB_TMO])) break; if (_sp > XB_SPIN_CAP) { atomicAdd(&(bar)[XB_TMO], 1u); break; } } } } while (0)

struct XcdBarrier {
    unsigned* bar; unsigned x;
    volatile LAS unsigned* st;
};

__device__ __forceinline__ XcdBarrier xcd_barrier_post(unsigned* bar, volatile LAS unsigned* st) {
    XcdBarrier b; b.bar = bar; b.x = xb_xcc_id(); b.st = st;
    if (threadIdx.x == 0) (void)xb_add(&bar[XB_XCNT(b.x)], 1u);
    return b;
}
__device__ __forceinline__ void xcd_barrier_complete(unsigned* bar, unsigned x, unsigned& nloc, unsigned& nx) {
    const unsigned G = gridDim.x * gridDim.y * gridDim.z;
    unsigned sum, cnt, mine, sp = 0u;
    for (;;) {
        sum = 0u; cnt = 0u; mine = 0u;
#pragma unroll
        for (unsigned j = 0; j < 16; ++j) { const unsigned c = xb_ld(&bar[XB_XCNT(j)]); sum += c; cnt += (c > 0u) ? 1u : 0u; mine = (j == x) ? c : mine; }
        if (sum == G) break;
        __builtin_amdgcn_s_sleep(1);
        if ((++sp & 255u) == 0u) { if (xb_ld(&bar[XB_TMO])) break; if (sp > XB_SPIN_CAP) { atomicAdd(&bar[XB_TMO], 1u); break; } }
    }
    nloc = mine > 0u ? mine : 1u; nx = cnt > 0u ? cnt : 1u;
}

__device__ __forceinline__ void xcd_barrier(const XcdBarrier& b) {
    asm volatile("s_waitcnt vmcnt(0)" ::: "memory");
    __syncthreads();
    if (threadIdx.x == 0) {
        unsigned* bar = b.bar;
        __builtin_amdgcn_s_waitcnt(0);
        unsigned nloc = b.st[0], nx = b.st[1];
        if (nloc == 0u) { xcd_barrier_complete(bar, b.x, nloc, nx); b.st[0] = nloc; b.st[1] = nx; }
        const unsigned old = xb_add(&bar[XB_XSUB(b.x)], 1u);
        const unsigned gen = old / nloc;
        if (old + 1u == (gen + 1u) * nloc) {
            __builtin_amdgcn_fence(__ATOMIC_RELEASE, "agent");
            asm volatile("s_waitcnt vmcnt(0)" ::: "memory");
            const unsigned og = xb_add(&bar[XB_TOP], 1u);
            const unsigned tg = og / nx;
            if (og + 1u == (tg + 1u) * nx) xb_add(&bar[XB_TOPGEN], 1u);
            else XB_SPIN(xb_ld(&bar[XB_TOPGEN]) == tg, bar);
            __builtin_amdgcn_fence(__ATOMIC_ACQUIRE, "agent");
            xb_add(&bar[XB_XGEN(b.x)], 1u);
            asm volatile("s_waitcnt vmcnt(0)" ::: "memory");
        } else {
            XB_SPIN(xb_ld(&bar[XB_XGEN(b.x)]) == gen, bar);
            __builtin_amdgcn_fence(__ATOMIC_ACQUIRE, "agent");
            asm volatile("s_waitcnt vmcnt(0)" ::: "memory");
        }
    }
    __syncthreads();
}


#ifndef REP_MASK
#define REP_MASK 0
#endif
#define REPB(bit) (((REP_MASK) >> (bit)) & 1)
#ifndef REP_N
#define REP_N 2
#endif
constexpr int NWAVES = 8;
constexpr int NB = 4, SEQ = 4096, M = NB * SEQ, D = 1024, FF = 2816, NPROJ = 2480, NPROJP = 2560, DEPTH = 2;
constexpr float EPS = 1e-6f;
constexpr float LOG2_10000 = 13.287712379549449f;

enum { I_X = 0, I_F1N, I_F1G, I_F1U, I_F1D, I_MIXN, I_WIN, I_CONVW, I_CONVB, I_DTB, I_ALOG, I_SSDD, I_SSDN, I_SWAQN, I_SWAKN, I_SINK, I_SWAON,
       I_MQLN, I_WUQ, I_MKVN, I_WUKV, I_MQN, I_MKN, I_MON, I_WOUT, I_F2N, I_F2G, I_F2U, I_F2D, N_IN };

constexpr size_t MiB = 1u << 20;
constexpr size_t WS_CTL = 0, CTL_ZERO_BYTES = 64 * 1024;
constexpr size_t WS_CSSWA = 1 * MiB;
constexpr size_t WS_CSMLA = 2 * MiB;
constexpr size_t WS_SS = 3 * MiB;
constexpr size_t WS_WGU1 = 4 * MiB, WS_WD1 = 15 * MiB, WS_WIN = WS_WD1 + 5 * MiB + MiB / 2, WS_WOUT = WS_WIN + 5 * MiB, WS_WGU2 = WS_WOUT + 2 * MiB, WS_WD2 = WS_WGU2 + 11 * MiB,
                 WS_WUQ = 44 * MiB, WS_WUKV = 44 * MiB + MiB / 4;
static_assert(WS_WD2 + 5 * MiB + MiB / 2 == 44 * MiB, "weights map");
constexpr size_t WS_XB = 45 * MiB;
constexpr size_t WS_OV = 77 * MiB;
constexpr size_t WS_HB = WS_OV;
constexpr size_t WS_PROJ = WS_OV;
constexpr size_t WS_Z = WS_PROJ, WS_XBCR = WS_PROJ + 16 * MiB, WS_SWAQ = WS_PROJ + 48 * MiB, WS_SWAKV = WS_PROJ + 56 * MiB, WS_MLAQR = WS_PROJ + 64 * MiB, WS_MLAM = WS_PROJ + 72 * MiB;
constexpr size_t WS_Y = WS_XBCR;
constexpr size_t WS_DTRAW = WS_OV + 80 * MiB;
constexpr size_t WS_XBCC = WS_OV + 81 * MiB;
constexpr size_t WS_DTC = WS_OV + 113 * MiB;
constexpr size_t WS_SWAVT = WS_OV + 115 * MiB;
constexpr size_t WS_MLAQ = WS_OV + 119 * MiB;
constexpr size_t WS_MLAK = WS_OV + 131 * MiB;
constexpr size_t WS_MLAVT = WS_OV + 143 * MiB;
constexpr size_t WS_SSQ = WS_OV + 151 * MiB;
constexpr size_t WS_SIN = WS_OV + 152 * MiB;
constexpr size_t WS_END = WS_OV + 168 * MiB;
constexpr size_t WS_YTMP = WS_XB;
static_assert(WS_END <= 256 * MiB, "ws map");

constexpr int CW_BAR = 4096, CW_SP = 8192  ;
constexpr int RING_BYTES = 131072, LDS_BYTES = 163840, LDSCTL_OFF = LDS_BYTES - 1024, MISC_OFF = LDSCTL_OFF + 64, WTAB_OFF = LDSCTL_OFF - 256  ,
              TAB_OFF = WTAB_OFF - 4096  , RTAB_OFF = TAB_OFF - 8192  ;
static_assert(RTAB_OFF >= RING_BYTES, "LDS map");

struct Args { const float* in[N_IN]; float* out; unsigned char* ws; int ph_lo, ph_hi; };
static_assert(sizeof(Args) == N_IN * 8 + 8 + 8 + 8, "Args has no padding");
__device__ __forceinline__ const float* ain(int i) { asm volatile("" : "+s"(i)); return ((const float* const*)__builtin_amdgcn_kernarg_segment_ptr())[i]; }
__device__ __forceinline__ float* aout() { int i = N_IN; asm volatile("" : "+s"(i)); return ((float* const*)__builtin_amdgcn_kernarg_segment_ptr())[i]; }
__device__ __forceinline__ unsigned char* aws() { int i = N_IN + 1; asm volatile("" : "+s"(i)); return ((unsigned char* const*)__builtin_amdgcn_kernarg_segment_ptr())[i]; }

__device__ __forceinline__ float bf2f(unsigned short b) { return __uint_as_float((unsigned)b << 16); }
__device__ __forceinline__ float bflo(unsigned w) { return __uint_as_float(w << 16); }
__device__ __forceinline__ float bfhi(unsigned w) { return __uint_as_float(w & 0xffff0000u); }
__device__ __forceinline__ float wave_sum(float v) {
#pragma unroll
    for (int o = 1; o < 64; o <<= 1) v += __shfl_xor(v, o);
    return v;
}
__device__ __forceinline__ float silu_f(float g) { return g * __builtin_amdgcn_rcpf(1.0f + __expf(-g)); }
__device__ __forceinline__ float softplus_f(float x) { return fmaxf(x, 0.f) + log1pf(expf(-fabsf(x))); }

typedef pg8::f32x4 f4;
typedef pg8::u32x4 u4;
typedef short v4i16 __attribute__((ext_vector_type(4)));
typedef unsigned v2u __attribute__((ext_vector_type(2)));
typedef __amdgpu_buffer_rsrc_t rsrc_t;
__device__ __forceinline__ rsrc_t mk_rsrc(const void* base, unsigned bytes) { return __builtin_amdgcn_make_buffer_rsrc(const_cast<void*>(base), 0, (int)bytes, 0x00020000); }
__device__ __forceinline__ void st16_wt(rsrc_t r, size_t byte_off, v4u v) { __builtin_amdgcn_raw_buffer_store_b128(v, r, (int)byte_off, 0, 16); }
__device__ __forceinline__ void st8_wt(rsrc_t r, size_t byte_off, v2u v) { __builtin_amdgcn_raw_buffer_store_b64(v, r, (int)byte_off, 0, 16); }
__device__ __forceinline__ void load_rstd(const float* ss, int row0, int fq, float (&rs)[2][4]) {
#pragma unroll
    for (int ai = 0; ai < 2; ++ai)
#pragma unroll
        for (int m = 0; m < 4; ++m) {
            const f4 v = *(const f4*)(ss + (size_t)(row0 + ai * 128 + m * 16) * 16 + 4 * fq);
            float s = (v[0] + v[1]) + (v[2] + v[3]); s += __shfl_xor(s, 16); s += __shfl_xor(s, 32);
            rs[ai][m] = rsqrtf(s * (1.0f / D) + EPS);
        }
}
template <class Sched> __device__ __forceinline__ bool fill_rstd_tab(PG8_LAS float* rt, const Sched& S, const float* ss, int tid) {
    pg8::Unit u; bool ok = true; int grp = -1;
    for (int i = 0; S.next(i, u); ++i) { if (grp < 0) grp = u.pm >> 3; ok = ok && ((u.pm >> 3) == grp); }
    if (ok) for (int i = 0; S.next(i, u); ++i) if (tid < 256) {
        const float* p = ss + ((size_t)u.pm * 256 + tid) * 16; const f4 a = *(const f4*)p, b = *(const f4*)(p + 4), c = *(const f4*)(p + 8), d = *(const f4*)(p + 12);
        const float s = ((a[0] + a[1]) + (a[2] + a[3])) + ((b[0] + b[1]) + (b[2] + b[3])) + ((c[0] + c[1]) + (c[2] + c[3])) + ((d[0] + d[1]) + (d[2] + d[3]));
        rt[(u.pm & 7) * 256 + tid] = rsqrtf(s * (1.0f / D) + EPS); }
    __syncthreads();
    return ok;
}
__device__ __forceinline__ void get_rstd(const PG8_LAS float* rt, bool use_tab, const float* ss, const pg8::Unit& u, int wr, int fr, int fq, float (&rs)[2][4]) {
    if (use_tab) {
#pragma unroll
        for (int ai = 0; ai < 2; ++ai)
#pragma unroll
            for (int m = 0; m < 4; ++m) rs[ai][m] = rt[(u.pm & 7) * 256 + ai * 128 + wr * 64 + m * 16 + fr];
    } else load_rstd(ss, u.pm * 256 + wr * 64 + fr, fq, rs);
}
struct EpiGU {
    static constexpr bool PERM = false, AFTER_DRAIN = false, KHOOK = false; static constexpr int PF_T = 0; static constexpr int AUX_A = 0;
    pg8::bf16_t* H; const float* ss; const PG8_LAS float* rt; bool use_tab;
    __device__ __forceinline__ void operator()(const f4 (&acc)[2][2][4][2], const pg8::Unit& u, int wr, int wc, int fr, int fq) const {
        const int row0 = u.pm * 256 + wr * 64 + fr; float rs[2][4]; get_rstd(rt, use_tab, ss, u, wr, fr, fq, rs);
        const int col = u.pn * 128 + wc * 32 + fq * 8; const rsrc_t rH = mk_rsrc(H, (unsigned)((size_t)M * FF * 2));
#pragma unroll
        for (int ai = 0; ai < 2; ++ai)
#pragma unroll
            for (int m = 0; m < 4; ++m) {
                const float r = rs[ai][m], rl = r * -1.4426950408889634f, r2 = r * r; float h[8];
#pragma unroll
                for (int bj = 0; bj < 2; ++bj) {
                    const f4 g = acc[ai][bj][m][0], gu = g * acc[ai][bj][m][1], ex = g * rl;
                    f4 t; t[0] = __builtin_amdgcn_exp2f(ex[0]); t[1] = __builtin_amdgcn_exp2f(ex[1]); t[2] = __builtin_amdgcn_exp2f(ex[2]); t[3] = __builtin_amdgcn_exp2f(ex[3]);
                    t = t + 1.0f;
                    f4 d; d[0] = __builtin_amdgcn_rcpf(t[0]); d[1] = __builtin_amdgcn_rcpf(t[1]); d[2] = __builtin_amdgcn_rcpf(t[2]); d[3] = __builtin_amdgcn_rcpf(t[3]);
                    const f4 hv = gu * (d * r2);
                    h[bj * 4 + 0] = hv[0]; h[bj * 4 + 1] = hv[1]; h[bj * 4 + 2] = hv[2]; h[bj * 4 + 3] = hv[3];
                }
                u4 w; w.x = pg8::cvt_pk_bf16(h[0], h[1]); w.y = pg8::cvt_pk_bf16(h[2], h[3]); w.z = pg8::cvt_pk_bf16(h[4], h[5]); w.w = pg8::cvt_pk_bf16(h[6], h[7]);
                st16_wt(rH, ((size_t)(row0 + ai * 128 + m * 16) * FF + col) * 2, (v4u){w.x, w.y, w.z, w.w});
            }
    }
    __device__ __forceinline__ void khook(f4 (&)[2][2][4][2], int, int, int) const {}
};
#ifndef XB_WT
#define XB_WT 0
#endif
#ifndef DOWN_AUX_A
#define DOWN_AUX_A 0
#endif
template <int MODE, bool FINAL> struct EpiDown {
    static constexpr bool PERM = true, AFTER_DRAIN = false, KHOOK = (MODE == 1);
#ifndef DOWN_PF_T
#define DOWN_PF_T 4
#endif
    static constexpr int PF_T = DOWN_PF_T;
    static constexpr int AUX_A = DOWN_AUX_A;
    float* xout; pg8::bf16_t* xb; float* ss; float scale; const PG8_LAS float* tab;
    __device__ __forceinline__ void operator()(const f4 (&acc)[2][2][4][2], const pg8::Unit& u, int wr, int wc, int fr, int fq) const {
        v4u xa[2][4][2];
#pragma unroll
        for (int ai = 0; ai < 2; ++ai)
#pragma unroll
            for (int m = 0; m < 4; ++m)
#pragma unroll
                for (int bj = 0; bj < 2; ++bj) xa[ai][m][bj] = *(const v4u*)(xb + (size_t)(u.pm * 256 + ai * 128 + wr * 64 + m * 16 + fr) * D + u.pn * 256 + bj * 128 + wc * 32 + fq * 8);
#pragma unroll
        for (int ai = 0; ai < 2; ++ai) {
            const v4u (&xi)[4][2] = xa[ai];
#pragma unroll
            for (int m = 0; m < 4; ++m) {
                const int lr = ai * 128 + wr * 64 + m * 16 + fr; const size_t row = (size_t)(u.pm * 256 + lr);
                const float sc = MODE == 1 ? tab[lr * 4 + 3] : scale; float sq = 0.f;
#pragma unroll
                for (int bj = 0; bj < 2; ++bj) {
                    const int col = u.pn * 256 + bj * 128 + wc * 32 + fq * 8; const v4u r = xi[m][bj];
                    const f4 r0 = (f4){bflo(r[0]), bfhi(r[0]), bflo(r[1]), bfhi(r[1])}, r1 = (f4){bflo(r[2]), bfhi(r[2]), bflo(r[3]), bfhi(r[3])};
                    const f4 o0 = r0 + acc[ai][bj][m][0] * sc, o1 = r1 + acc[ai][bj][m][1] * sc;
                    if (FINAL) { *(f4*)(xout + row * D + col) = o0; *(f4*)(xout + row * D + col + 4) = o1; }
                    else {
                        const v4u w = (v4u){pg8::cvt_pk_bf16(o0[0], o0[1]), pg8::cvt_pk_bf16(o0[2], o0[3]), pg8::cvt_pk_bf16(o1[0], o1[1]), pg8::cvt_pk_bf16(o1[2], o1[3])};
                        *(v4u*)(xb + row * D + col) = w;
                        const f4 q0 = (f4){bflo(w[0]), bfhi(w[0]), bflo(w[1]), bfhi(w[1])}, q1 = (f4){bflo(w[2]), bfhi(w[2]), bflo(w[3]), bfhi(w[3])};
                        sq += ((q0[0] * q0[0] + q0[1] * q0[1]) + (q0[2] * q0[2] + q0[3] * q0[3])) + ((q1[0] * q1[0] + q1[1] * q1[1]) + (q1[2] * q1[2] + q1[3] * q1[3]));
                    }
                }
                if (!FINAL) { sq += __shfl_xor(sq, 16); sq += __shfl_xor(sq, 32);
                    if (fq == 0) ss[row * 16 + u.pn * 4 + wc] = sq; }
            }
        }
    }
    __device__ __forceinline__ void prefetch(const pg8::Unit& u, PG8_LAS unsigned char* lds, int tid, int wid) const {
#pragma unroll
        for (int i = 0; i < 2; ++i) { const int l = tid + 512 * i; const char* p = (const char*)(xb + (size_t)(u.pm * 256 + (l >> 2)) * D + u.pn * 256) + (l & 3) * 128;
            __builtin_amdgcn_global_load_lds((const unsigned*)p, (PG8_LAS unsigned*)(lds + RTAB_OFF + wid * 256), 4, 0, 0); }
    }
    __device__ __forceinline__ void khook(f4 (&acc)[2][2][4][2], int g, int wr, int fr) const {
#pragma unroll
        for (int ai = 0; ai < 2; ++ai)
#pragma unroll
            for (int m = 0; m < 4; ++m) { const float r = tab[(ai * 128 + wr * 64 + m * 16 + fr) * 4 + g];
#pragma unroll
                for (int bj = 0; bj < 2; ++bj)
#pragma unroll
                    for (int n = 0; n < 2; ++n) acc[ai][bj][m][n] = acc[ai][bj][m][n] * r; }
    }
};
struct EpiDry {
    static constexpr bool PERM = false, AFTER_DRAIN = false, KHOOK = false; static constexpr int PF_T = 0; static constexpr int AUX_A = 0;
    __device__ __forceinline__ void operator()(const f4 (&acc)[2][2][4][2], const pg8::Unit&, int, int, int, int) const {
#pragma unroll
        for (int ai = 0; ai < 2; ++ai)
#pragma unroll
            for (int bj = 0; bj < 2; ++bj)
#pragma unroll
                for (int m = 0; m < 4; ++m)
#pragma unroll
                    for (int n = 0; n < 2; ++n) asm volatile("" :: "v"(acc[ai][bj][m][n]));
    }
    __device__ __forceinline__ void khook(f4 (&)[2][2][4][2], int, int, int) const {}
};
struct EpiProj {
    static constexpr bool PERM = true, AFTER_DRAIN = false, KHOOK = false; static constexpr int PF_T = 0; static constexpr int AUX_A = 0;
    pg8::bf16_t* proj; float* dtraw; const float* ss; const PG8_LAS float* rt; bool use_tab;
    __device__ __forceinline__ void operator()(const f4 (&acc)[2][2][4][2], const pg8::Unit& u, int wr, int wc, int fr, int fq) const {
        const int row0 = u.pm * 256 + wr * 64 + fr; float rs[2][4]; get_rstd(rt, use_tab, ss, u, wr, fr, fq, rs);
        size_t off; int pitch, c0;
        if (u.pn < 2) { off = 0; pitch = 512; c0 = u.pn * 256; } else if (u.pn < 6) { off = (size_t)M * 512; pitch = 1024; c0 = (u.pn - 2) * 256; } else { off = (size_t)M * 1536 + (size_t)(u.pn - 6) * M * 256; pitch = 256; c0 = 0; }
        pg8::bf16_t* base = proj + off + c0 + wc * 32 + fq * 8;
        const bool dtw = (u.pn == 9) && (wc == 1) && (fq < 2);
#pragma unroll
        for (int ai = 0; ai < 2; ++ai)
#pragma unroll
            for (int m = 0; m < 4; ++m) {
                const float r = rs[ai][m]; const size_t row = (size_t)(row0 + ai * 128 + m * 16);
#pragma unroll
                for (int bj = 0; bj < 2; ++bj) {
                    const f4 v0 = acc[ai][bj][m][0] * r, v1 = acc[ai][bj][m][1] * r;
                    u4 w; w.x = pg8::cvt_pk_bf16(v0[0], v0[1]); w.y = pg8::cvt_pk_bf16(v0[2], v0[3]); w.z = pg8::cvt_pk_bf16(v1[0], v1[1]); w.w = pg8::cvt_pk_bf16(v1[2], v1[3]);
                    *(u4*)(base + row * pitch + bj * 128) = w;
                    if (bj == 1 && dtw) { *(f4*)(dtraw + row * 16 + fq * 8) = v0; *(f4*)(dtraw + row * 16 + fq * 8 + 4) = v1; }
                }
            }
    }
    __device__ __forceinline__ void khook(f4 (&)[2][2][4][2], int, int, int) const {}
};

__device__ __forceinline__ int gu_row(int j, int n01) { const int pn = j >> 7, jj = j & 127; return 256 * pn + 128 * ((jj >> 2) & 1) + 32 * (jj >> 5) + 16 * n01 + 4 * ((jj >> 3) & 3) + (jj & 3); }
__device__ __forceinline__ int win_row(int o) { return o < 1536 ? o : (o < 1552 ? 2464 + (o - 1536) : o - 16); }
__device__ __forceinline__ int map_row(int mode, int n) { return mode == 0 ? n : (mode == 1 ? gu_row(n, 0) : (mode == 2 ? gu_row(n, 1) : win_row(n))); }
struct TrItem { const float* W; bf16* WT; const float* ks; int K, N, mode, k0, n0; };
__device__ __forceinline__ TrItem tr_desc(const float* W, int K, int N, bf16* WT, int mode, const float* ks, int item) {
    const int nblk = (N + 63) / 64; TrItem d; d.W = W; d.WT = WT; d.ks = ks; d.K = K; d.N = N; d.mode = mode; d.k0 = 64 * (item / nblk); d.n0 = 64 * (item % nblk); return d;
}
__device__ __forceinline__ void tr_load(const TrItem& d, f32x4 (&v)[16], f32x4 (&sc)[4], int lane) {
    const int r4 = lane >> 4, c4 = lane & 15; const bool nok = d.n0 + 4 * c4 < d.N; const int ncol = nok ? d.n0 + 4 * c4 : 0;
    const float* p = d.W + (size_t)(d.k0 + 16 * r4) * d.N + ncol;
#pragma unroll
    for (int i = 0; i < 16; ++i) { v[i] = __builtin_nontemporal_load((const f32x4*)p); p += d.N; asm volatile("" : "+v"(p)); }
    if (d.ks) {
#pragma unroll
        for (int j = 0; j < 4; ++j) sc[j] = *(const f32x4*)(d.ks + d.k0 + 16 * r4 + 4 * j);
    } else {
#pragma unroll
        for (int j = 0; j < 4; ++j) sc[j] = (f32x4){1.f, 1.f, 1.f, 1.f};
    }
}
__device__ __forceinline__ void tr_finish(const TrItem& d, f32x4 (&v)[16], f32x4 (&sc)[4], LAS unsigned char* scr, int lane) {
    const int r4 = lane >> 4, c4 = lane & 15; const bool nok = d.n0 + 4 * c4 < d.N;
#pragma unroll
    for (int i = 0; i < 16; ++i) { const int k = 16 * r4 + i; f32x4 x = v[i] * sc[i >> 2][i & 3]; if (!nok) x = (f32x4){0.f, 0.f, 0.f, 0.f};
        *(LAS v2u*)(scr + k * 192 + 8 * c4) = (v2u){pg8::cvt_pk_bf16(x.x, x.y), pg8::cvt_pk_bf16(x.z, x.w)}; }
    LDS_WAIT(); asm volatile("" ::: "memory");
    const int hh = lane >> 5, blk = (lane >> 4) & 1, q = (lane & 15) >> 2, p = lane & 3;
#pragma unroll
    for (int c = 0; c < 2; ++c)
#pragma unroll
        for (int k2 = 0; k2 < 4; ++k2) {
            const LAS unsigned char* ad = scr + (16 * k2 + 8 * hh + q) * 192 + (32 * c + 16 * blk + 4 * p) * 2;
            const v4i16 v0 = __builtin_amdgcn_ds_read_tr16_b64_v4i16((LAS v4i16*)ad), v1 = __builtin_amdgcn_ds_read_tr16_b64_v4i16((LAS v4i16*)(ad + 4 * 192));
            const int n = d.n0 + 32 * c + (lane & 31);
            union { v4i16 h[2]; v4u u; } o; o.h[0] = v0; o.h[1] = v1;
            if (n < d.N) *(GAS v4u*)(d.WT + (size_t)map_row(d.mode, n) * d.K + d.k0 + 16 * k2 + 8 * hh) = o.u;
        }
    LDS_WAIT(); asm volatile("" ::: "memory");
}
enum { J_GU1 = 0, J_D1, J_IN, J_UQKV, J_OUT, J_GU2, J_D2 };
#define CONV_LOOP(NITEMS, DESC) do { int it_ = w; if (it_ < (NITEMS)) { TrItem d_ = DESC(it_); f32x4 v_[16], s_[4]; tr_load(d_, v_, s_, lane); \
        for (;;) { const int nx_ = it_ + nw; const bool more_ = nx_ < (NITEMS); TrItem dn_ = d_; f32x4 vn_[16], sn_[4]; if (more_) { dn_ = DESC(nx_); tr_load(dn_, vn_, sn_, lane); } \
            tr_finish(d_, v_, s_, scr, lane); if (!more_) break; d_ = dn_; _Pragma("unroll") for (int i_ = 0; i_ < 16; ++i_) v_[i_] = vn_[i_]; _Pragma("unroll") for (int i_ = 0; i_ < 4; ++i_) s_[i_] = sn_[i_]; it_ = nx_; } } } while (0)
template <int JOB> __device__ __forceinline__ void convert_job(int l, LAS unsigned char* lds, int w_, int nw, int wave, int lane, int off = 0) {
    unsigned char* ws = aws(); LAS unsigned char* scr = lds + wave * 16384; const int w = ((w_ - off) % nw + nw) % nw;
    constexpr int I_GU = 16 * 44, I_DN = 44 * 16, I_IN = 16 * 39, I_OUT = 16 * 16, I_UQ = 4 * 6, I_UKV = 2 * 8;
    if (JOB == J_GU1 || JOB == J_GU2) {
        const float* g = ain(JOB == J_GU1 ? I_F1G : I_F2G) + (size_t)l * D * FF; const float* u = ain(JOB == J_GU1 ? I_F1U : I_F2U) + (size_t)l * D * FF; const float* nrm = ain(JOB == J_GU1 ? I_F1N : I_F2N) + l * D;
        bf16* dst = (bf16*)(ws + (JOB == J_GU1 ? WS_WGU1 : WS_WGU2));
#define DESC_GU(it) ((it) < I_GU ? tr_desc(g, D, FF, dst, 1, nrm, (it)) : tr_desc(u, D, FF, dst, 2, nrm, (it) - I_GU))
        CONV_LOOP(2 * I_GU, DESC_GU);
#undef DESC_GU
    } else if (JOB == J_D1 || JOB == J_D2) {
        const float* d = ain(JOB == J_D1 ? I_F1D : I_F2D) + (size_t)l * FF * D; bf16* dst = (bf16*)(ws + (JOB == J_D1 ? WS_WD1 : WS_WD2));
#define DESC_D(it) tr_desc(d, FF, D, dst, 0, nullptr, (it))
        CONV_LOOP(I_DN, DESC_D);
#undef DESC_D
    } else if (JOB == J_IN) {
        const float* win = ain(I_WIN) + (size_t)l * D * NPROJ; const float* mw = ain(I_MIXN) + l * D;
#define DESC_IN(it) tr_desc(win, D, NPROJ, (bf16*)(ws + WS_WIN), 3, mw, (it))
        CONV_LOOP(I_IN, DESC_IN);
#undef DESC_IN
        for (int it = w; it < 80; it += nw) { GAS v4u* p = (GAS v4u*)((bf16*)(ws + WS_WIN) + (size_t)(NPROJ + it) * D) + lane * 2; p[0] = (v4u){0u, 0u, 0u, 0u}; p[1] = (v4u){0u, 0u, 0u, 0u}; }
    } else if (JOB == J_UQKV) {
        const float* wuq = ain(I_WUQ) + (size_t)l * 256 * 384; const float* wukv = ain(I_WUKV) + (size_t)l * 128 * 512; const float* n1 = ain(I_MQLN) + l * 256; const float* n2 = ain(I_MKVN) + l * 128;
#define DESC_U(it) ((it) < I_UQ ? tr_desc(wuq, 256, 384, (bf16*)(ws + WS_WUQ), 0, n1, (it)) : tr_desc(wukv, 128, 512, (bf16*)(ws + WS_WUKV), 0, n2, (it) - I_UQ))
        CONV_LOOP(I_UQ + I_UKV, DESC_U);
#undef DESC_U
    } else {
        const float* wo = ain(I_WOUT) + (size_t)l * D * D; const float* k0p = ain(I_SSDN) + l * 512; const float* k1p = ain(I_SWAON) + l * 256 - 512; const float* k2p = ain(I_MON) + l * 256 - 768;
#define DESC_O(it) tr_desc(wo, D, D, (bf16*)(ws + WS_WOUT), 0, (64 * ((it) / 16) < 512 ? k0p : (64 * ((it) / 16) < 768 ? k1p : k2p)), (it))
        CONV_LOOP(I_OUT, DESC_O);
#undef DESC_O
    }
}
#define TAIL_WORKER(nwg) const int rem_ = (nwg) % G; const bool tail_ = bx >= rem_; const int tw_ = (bx - rem_) * NWAVES + wave, tnw_ = (G - rem_) * NWAVES;
__device__ __forceinline__ void p0_x_and_tables(int gw, int NGW, int lane, int gtid, int NT) {
    unsigned char* ws = aws(); const float* x = ain(I_X); bf16* xb = (bf16*)(ws + WS_XB); float* ss = (float*)(ws + WS_SS);
    for (int m0 = 4 * gw; m0 < M; m0 += 4 * NGW) {
        f32x4 v[4][4];
#pragma unroll
        for (int r = 0; r < 4; ++r)
#pragma unroll
            for (int j = 0; j < 4; ++j) v[r][j] = ((const GAS f32x4*)(x + (size_t)(m0 + r) * D) + lane)[64 * j];
#pragma unroll
        for (int r = 0; r < 4; ++r) {
            float s = 0.f;
#pragma unroll
            for (int j = 0; j < 4; ++j) s += (v[r][j].x * v[r][j].x + v[r][j].y * v[r][j].y) + (v[r][j].z * v[r][j].z + v[r][j].w * v[r][j].w);
            s = wave_sum(s);
            GAS unsigned long long* o8 = (GAS unsigned long long*)(xb + (size_t)(m0 + r) * D) + lane;
#pragma unroll
            for (int j = 0; j < 4; ++j) o8[64 * j] = (unsigned long long)pk2(v[r][j].x, v[r][j].y) | ((unsigned long long)pk2(v[r][j].z, v[r][j].w) << 32);
            if (lane < 16) ss[(size_t)(m0 + r) * 16 + lane] = lane == 0 ? s : 0.f;
        }
    }
    float* cs1 = (float*)(ws + WS_CSSWA); float* cs2 = (float*)(ws + WS_CSMLA);
    for (int idx = gtid; idx < SEQ * 48; idx += NT) {
        const int t = idx / 48, i = idx % 48; float inv; float* dst;
        if (i < 32) { inv = exp2f(-(float)i * (LOG2_10000 / 32.0f)); dst = cs1 + ((size_t)t * 32 + i) * 2; } else { inv = exp2f(-(float)(i - 32) * (LOG2_10000 / 16.0f)); dst = cs2 + ((size_t)t * 16 + (i - 32)) * 2; }
        const float ang = (float)t * inv; const double rev = (double)ang * 0.15915494309189535; const float fr = (float)(rev - rint(rev));
        dst[0] = __builtin_amdgcn_cosf(fr); dst[1] = __builtin_amdgcn_sinf(fr);
    }
}

__device__ __forceinline__ void ld8(const bf16* p, float* x) { const uint4 w = *(const uint4*)p; x[0] = bflo(w.x); x[1] = bfhi(w.x); x[2] = bflo(w.y); x[3] = bfhi(w.y); x[4] = bflo(w.z); x[5] = bfhi(w.z); x[6] = bflo(w.w); x[7] = bfhi(w.w); }
__device__ __forceinline__ void st8(bf16* p, const float* x) { uint4 w; w.x = pk2(x[0], x[1]); w.y = pk2(x[2], x[3]); w.z = pk2(x[4], x[5]); w.w = pk2(x[6], x[7]); *(uint4*)p = w; }


typedef float f32x16 __attribute__((ext_vector_type(16)));
__device__ __forceinline__ v4i16 tr4(LAS const unsigned char* p) { return __builtin_amdgcn_ds_read_tr16_b64_v4i16((LAS v4i16*)p); }
__device__ __forceinline__ bf16x8 cat4(v4i16 a, v4i16 b) { bf16x8 r; r[0] = a[0]; r[1] = a[1]; r[2] = a[2]; r[3] = a[3]; r[4] = b[0]; r[5] = b[1]; r[6] = b[2]; r[7] = b[3]; return r; }
typedef __bf16 bf16x2_t __attribute__((ext_vector_type(2)));
typedef float f32x2_t __attribute__((ext_vector_type(2)));
__device__ __forceinline__ unsigned cvtpk(float lo, float hi) { f32x2_t v = {lo, hi}; bf16x2_t b = __builtin_convertvector(v, bf16x2_t); return __builtin_bit_cast(unsigned, b); }
__device__ __forceinline__ void lds_st16(LAS unsigned char* p, uint4 v) { *(LAS v4u*)p = (v4u){v.x, v.y, v.z, v.w}; }

constexpr int SX_PITCH = 192, SB_PITCH = 320, S_XS = 0, S_BM = 256 * SX_PITCH;
static_assert(S_BM + 256 * SB_PITCH <= RING_BYTES, "S unit LDS");

__device__ __forceinline__ void ssd_state_unit(LAS unsigned char* lds, int L, int unit, int tid, int wave, int lane) {
    const int h = unit & 7, c = (unit >> 3) & 15, b = unit >> 7, g = h >> 2, hl = h & 3; const size_t m0 = (size_t)b * SEQ + (size_t)c * 256;
    unsigned char* ws = aws();
    LAS float* fsc = (LAS float*)(lds + TAB_OFF);
    if (wave < 2) {
        const int dir = wave; const float A = -expf(ain(I_ALOG)[L * 16 + dir * 8 + h]); const float bias = ain(I_DTB)[L * 16 + dir * 8 + h];
        const float* dtraw = (const float*)(ws + WS_DTRAW); float* dtc = (float*)(ws + WS_DTC);
        float dt[4], cu[4];
#pragma unroll
        for (int j = 0; j < 4; ++j) dt[j] = softplus_f(dtraw[(m0 + 4 * lane + j) * 16 + dir * 8 + h] + bias);
        float tot, v;
        if (dir == 0) {
            cu[0] = dt[0] * A; cu[1] = cu[0] + dt[1] * A; cu[2] = cu[1] + dt[2] * A; cu[3] = cu[2] + dt[3] * A; tot = cu[3]; v = tot;
#pragma unroll
            for (int o = 1; o < 64; o <<= 1) { const float n = __shfl_up(v, o); if (lane >= o) v += n; }
        } else {
            cu[3] = dt[3] * A; cu[2] = cu[3] + dt[2] * A; cu[1] = cu[2] + dt[1] * A; cu[0] = cu[1] + dt[0] * A; tot = cu[0]; v = tot;
#pragma unroll
            for (int o = 1; o < 64; o <<= 1) { const float n = __shfl_down(v, o); if (lane + o < 64) v += n; }
        }
        const float excl = v - tot; const float total = wave_sum(tot);
#pragma unroll
        for (int j = 0; j < 4; ++j) { const float cum = cu[j] + excl; const size_t m = m0 + 4 * lane + j;
            fsc[dir * 256 + 4 * lane + j] = dt[j] * __expf(total - cum); dtc[(m * 8 + h) * 4 + dir] = dt[j]; dtc[(m * 8 + h) * 4 + 2 + dir] = cum; }
    }
    {
        const bf16* xr = (const bf16*)(ws + WS_XBCR); bf16* xc = (bf16*)(ws + WS_XBCC);
        const float* cw = ain(I_CONVW) + L * 5 * 1024; const float* cb = ain(I_CONVB) + L * 1024;
        constexpr int ncg = 28;
        for (int item = tid; item < ncg * 16; item += NWAVES * 64) {
            const int cg = item % ncg, tr = item / ncg;
            const int col = cg < 8 ? h * 64 + 8 * cg : (cg < 24 ? 512 + g * 128 + 8 * (cg - 8) : 768 + g * 128 + 8 * (4 * hl + cg - 24));
            float w[5][8], bb[8];
#pragma unroll
            for (int k = 0; k < 5; ++k) { const f32x4 w0 = *(const f32x4*)(cw + k * 1024 + col), w1 = *(const f32x4*)(cw + k * 1024 + col + 4);
                w[k][0] = w0.x; w[k][1] = w0.y; w[k][2] = w0.z; w[k][3] = w0.w; w[k][4] = w1.x; w[k][5] = w1.y; w[k][6] = w1.z; w[k][7] = w1.w; }
            { const f32x4 b0 = *(const f32x4*)(cb + col), b1 = *(const f32x4*)(cb + col + 4); bb[0] = b0.x; bb[1] = b0.y; bb[2] = b0.z; bb[3] = b0.w; bb[4] = b1.x; bb[5] = b1.y; bb[6] = b1.z; bb[7] = b1.w; }
            const int t0 = 16 * tr, sq0 = c * 256 + t0;
            uint4 rows[20];
#pragma unroll
            for (int i = 0; i < 20; ++i) { const int sq_ = sq0 + i - 2; const int di = (i < 2 || i >= 18) ? (sq_ < 0 ? -sq0 : (sq_ >= SEQ ? SEQ - 1 - sq0 : i - 2)) : i - 2;
                rows[i] = *(const uint4*)(xr + (m0 + t0 + di) * 1024 + col); }
            const float e0 = sq0 - 2 >= 0 ? 1.f : 0.f, e1 = sq0 - 1 >= 0 ? 1.f : 0.f, e18 = sq0 + 16 < SEQ ? 1.f : 0.f, e19 = sq0 + 17 < SEQ ? 1.f : 0.f;
            float win[5][8];
#define UNPK(dst, rw) do { dst[0] = bflo(rw.x); dst[1] = bfhi(rw.x); dst[2] = bflo(rw.y); dst[3] = bfhi(rw.y); dst[4] = bflo(rw.z); dst[5] = bfhi(rw.z); dst[6] = bflo(rw.w); dst[7] = bfhi(rw.w); } while (0)
            UNPK(win[0], rows[0]); UNPK(win[1], rows[1]); UNPK(win[2], rows[2]); UNPK(win[3], rows[3]);
#pragma unroll
            for (int e = 0; e < 8; ++e) { win[0][e] *= e0; win[1][e] *= e1; }
#pragma unroll
            for (int tt = 0; tt < 16; ++tt) {
                UNPK(win[(tt + 4) % 5], rows[tt + 4]);
                if (tt == 14) {
#pragma unroll
                    for (int e = 0; e < 8; ++e) win[(tt + 4) % 5][e] *= e18; }
                if (tt == 15) {
#pragma unroll
                    for (int e = 0; e < 8; ++e) win[(tt + 4) % 5][e] *= e19; }
                float o[8];
#pragma unroll
                for (int e = 0; e < 8; ++e) { o[e] = bb[e];
#pragma unroll
                    for (int k = 0; k < 5; ++k) o[e] += win[(tt + k) % 5][e] * w[k][e]; }
#pragma unroll
                for (int e = 0; e < 8; ++e) o[e] = silu_f(o[e]);
                uint4 pk; pk.x = cvtpk(o[0], o[1]); pk.y = cvtpk(o[2], o[3]); pk.z = cvtpk(o[4], o[5]); pk.w = cvtpk(o[6], o[7]);
                const int t = t0 + tt;
                if (cg < 8) lds_st16(lds + S_XS + t * SX_PITCH + 16 * cg, pk);
                else if (cg < 24) lds_st16(lds + S_BM + t * SB_PITCH + 16 * (cg - 8), pk);
                if (cg < 8 || cg >= 24 || hl == 0) *(uint4*)(xc + (m0 + t) * 1024 + col) = pk;
            }
#undef UNPK
        }
    }
    __syncthreads();
    {
        const int nb = wave & 3, pb = wave >> 2, hh = lane >> 5, blk = (lane >> 4) & 1, q = (lane & 15) >> 2, p = lane & 3;
        f32x16 accf, accb;
#pragma unroll
        for (int i = 0; i < 16; ++i) { accf[i] = 0.f; accb[i] = 0.f; }
        const LAS unsigned char* xa = lds + S_XS + (8 * hh + q) * SX_PITCH + (32 * pb + 16 * blk + 4 * p) * 2;
        const LAS unsigned char* ba = lds + S_BM + (8 * hh + q) * SB_PITCH + (32 * nb + 16 * blk + 4 * p) * 2;
#pragma unroll 2
        for (int ks = 0; ks < 16; ++ks) {
            const v4i16 x0 = tr4(xa + (16 * ks) * SX_PITCH), x1 = tr4(xa + (16 * ks + 4) * SX_PITCH);
            const v4i16 b0 = tr4(ba + (16 * ks) * SB_PITCH), b1 = tr4(ba + (16 * ks + 4) * SB_PITCH);
            const f32x4 ff0 = *(const LAS f32x4*)(fsc + 16 * ks + 8 * hh), ff1 = *(const LAS f32x4*)(fsc + 16 * ks + 8 * hh + 4);
            const f32x4 fb0 = *(const LAS f32x4*)(fsc + 256 + 16 * ks + 8 * hh), fb1 = *(const LAS f32x4*)(fsc + 256 + 16 * ks + 8 * hh + 4);
            float xv[8];
#pragma unroll
            for (int e = 0; e < 4; ++e) { xv[e] = bf2f((unsigned short)x0[e]); xv[4 + e] = bf2f((unsigned short)x1[e]); }
            union { bf16x8 v; unsigned u[4]; } af, ab;
            af.u[0] = cvtpk(xv[0] * ff0[0], xv[1] * ff0[1]); af.u[1] = cvtpk(xv[2] * ff0[2], xv[3] * ff0[3]); af.u[2] = cvtpk(xv[4] * ff1[0], xv[5] * ff1[1]); af.u[3] = cvtpk(xv[6] * ff1[2], xv[7] * ff1[3]);
            ab.u[0] = cvtpk(xv[0] * fb0[0], xv[1] * fb0[1]); ab.u[1] = cvtpk(xv[2] * fb0[2], xv[3] * fb0[3]); ab.u[2] = cvtpk(xv[4] * fb1[0], xv[5] * fb1[1]); ab.u[3] = cvtpk(xv[6] * fb1[2], xv[7] * fb1[3]);
            const bf16x8 bf = cat4(b0, b1);
            accf = __builtin_amdgcn_mfma_f32_32x32x16_bf16(af.v, bf, accf, 0, 0, 0);
            accb = __builtin_amdgcn_mfma_f32_32x32x16_bf16(ab.v, bf, accb, 0, 0, 0);
        }
        float* st = aout() + ((size_t)((b * 16 + c) * 8 + h) * 2) * 8192;
#pragma unroll
        for (int r = 0; r < 16; ++r) { const int pp = 32 * pb + (r & 3) + 8 * (r >> 2) + 4 * hh, n = 32 * nb + (lane & 31);
            st[pp * 128 + n] = accf[r]; st[8192 + pp * 128 + n] = accb[r]; }
    }
    __syncthreads();
}

constexpr int T_QL = 0, T_QL_PITCH = 528, T_CKV = 64 * 528, T_CKV_PITCH = 272, T_VS = T_CKV + 64 * 272, T_VS_PITCH = 272;
__device__ __forceinline__ float red8(float s) { s += __shfl_xor(s, 1); s += __shfl_xor(s, 2); s += __shfl_xor(s, 4); return s; }

__device__ __forceinline__ void token_prep_unit(LAS unsigned char* lds, int L, int unit, int tid, int wave, int lane, bool do_swa = true) {
    unsigned char* ws = aws();
    const size_t m0 = (size_t)unit * 64; const int b = unit >> 6, t0 = (unit & 63) * 64;
    uint4 sv[2], sq[4], sc[2];
    {
        const bf16* swakv = (const bf16*)(ws + WS_SWAKV); const bf16* qr = (const bf16*)(ws + WS_MLAQR); const bf16* mm = (const bf16*)(ws + WS_MLAM);
#pragma unroll
        for (int r = 0; r < 2; ++r) { const int id = tid + 512 * r, tok = id >> 4, c8 = id & 15; sv[r] = *(const uint4*)(swakv + (m0 + tok) * 256 + 128 + 8 * c8); }
#pragma unroll
        for (int r = 0; r < 4; ++r) { const int tok = (tid >> 5) + 16 * r, c8 = tid & 31; sq[r] = *(const uint4*)(qr + (m0 + tok) * 256 + 8 * c8); }
#pragma unroll
        for (int r = 0; r < 2; ++r) { const int tok = (tid >> 4) + 32 * r, c8 = tid & 15; sc[r] = *(const uint4*)(mm + (m0 + tok) * 256 + 8 * c8); }
    }
    if (do_swa) {
        bf16* swaq = (bf16*)(ws + WS_SWAQ); bf16* swakv = (bf16*)(ws + WS_SWAKV); const float* cs = (const float*)(ws + WS_CSSWA);
        const int tok = tid >> 3, sub = tid & 7; const size_t m = m0 + tok; const int t = t0 + tok;
        float cc[8], sn[8];
#pragma unroll
        for (int e2 = 0; e2 < 4; ++e2) { const f32x4 v = *(const f32x4*)(cs + ((size_t)t * 32 + 8 * (sub & 3) + 2 * e2) * 2); cc[2 * e2] = v.x; sn[2 * e2] = v.y; cc[2 * e2 + 1] = v.z; sn[2 * e2 + 1] = v.w; }
        uint4 raw[6];
#pragma unroll
        for (int hh = 0; hh < 6; ++hh) raw[hh] = *(const uint4*)((hh < 4 ? swaq + m * 256 + hh * 64 : swakv + m * 256 + (hh - 4) * 64) + 8 * sub);
        float wq8[8], wk8[8];
        { const f32x4 a0 = *(const f32x4*)(ain(I_SWAQN) + L * 64 + 8 * sub), a1 = *(const f32x4*)(ain(I_SWAQN) + L * 64 + 8 * sub + 4), b0 = *(const f32x4*)(ain(I_SWAKN) + L * 64 + 8 * sub), b1 = *(const f32x4*)(ain(I_SWAKN) + L * 64 + 8 * sub + 4);
          wq8[0] = a0.x; wq8[1] = a0.y; wq8[2] = a0.z; wq8[3] = a0.w; wq8[4] = a1.x; wq8[5] = a1.y; wq8[6] = a1.z; wq8[7] = a1.w; wk8[0] = b0.x; wk8[1] = b0.y; wk8[2] = b0.z; wk8[3] = b0.w; wk8[4] = b1.x; wk8[5] = b1.y; wk8[6] = b1.z; wk8[7] = b1.w; }
#pragma unroll
        for (int hh = 0; hh < 6; ++hh) {
            bf16* p = (hh < 4 ? swaq + m * 256 + hh * 64 : swakv + m * 256 + (hh - 4) * 64) + 8 * sub;
            const uint4 rw = raw[hh]; float x[8] = {bflo(rw.x), bfhi(rw.x), bflo(rw.y), bfhi(rw.y), bflo(rw.z), bfhi(rw.z), bflo(rw.w), bfhi(rw.w)}; float s = 0.f;
#pragma unroll
            for (int e = 0; e < 8; ++e) s += x[e] * x[e];
            s = red8(s); const float r = rsqrtf(s * (1.0f / 64.0f) + EPS);
#pragma unroll
            for (int e = 0; e < 8; ++e) { const float y = x[e] * r * (hh < 4 ? wq8[e] : wk8[e]); const float pe = __shfl_xor(y, 4); x[e] = sub < 4 ? y * cc[e] - pe * sn[e] : pe * sn[e] + y * cc[e]; }
            st8(p, x);
        }
    }
    {
#define UNP8(x, rw) float x[8] = {bflo(rw.x), bfhi(rw.x), bflo(rw.y), bfhi(rw.y), bflo(rw.z), bfhi(rw.z), bflo(rw.w), bfhi(rw.w)}
#pragma unroll
        for (int r = 0; r < 2; ++r) { const int id = tid + 512 * r, tok = id >> 4, c8 = id & 15; lds_st16(lds + T_VS + tok * T_VS_PITCH + 16 * c8, sv[r]); }
#pragma unroll
        for (int r = 0; r < 4; ++r) { const int tok = (tid >> 5) + 16 * r, c8 = tid & 31; UNP8(x, sq[r]); float s = 0.f;
#pragma unroll
            for (int e = 0; e < 8; ++e) s += x[e] * x[e];
            s = red8(s); s += __shfl_xor(s, 8); s += __shfl_xor(s, 16); const float rr = rsqrtf(s * (1.0f / 256.0f) + EPS);
            uint4 pk; pk.x = cvtpk(x[0] * rr, x[1] * rr); pk.y = cvtpk(x[2] * rr, x[3] * rr); pk.z = cvtpk(x[4] * rr, x[5] * rr); pk.w = cvtpk(x[6] * rr, x[7] * rr);
            lds_st16(lds + T_QL + tok * T_QL_PITCH + 16 * c8, pk); }
#pragma unroll
        for (int r = 0; r < 2; ++r) { const int tok = (tid >> 4) + 32 * r, c8 = tid & 15; UNP8(x, sc[r]); float s = 0.f;
#pragma unroll
            for (int e = 0; e < 8; ++e) s += x[e] * x[e];
            s = red8(s); s += __shfl_xor(s, 8); const float rr = rsqrtf(s * (1.0f / 128.0f) + EPS);
            uint4 pk; pk.x = cvtpk(x[0] * rr, x[1] * rr); pk.y = cvtpk(x[2] * rr, x[3] * rr); pk.z = cvtpk(x[4] * rr, x[5] * rr); pk.w = cvtpk(x[6] * rr, x[7] * rr);
            lds_st16(lds + T_CKV + tok * T_CKV_PITCH + 16 * c8, pk); }
#undef UNP8
    }
    __syncthreads();
    {
        bf16* vt = (bf16*)(ws + WS_SWAVT); const int ch = tid >> 2, tq = tid & 3; unsigned pk[8];
#pragma unroll
        for (int i = 0; i < 8; ++i) { const unsigned lo = *(const LAS unsigned short*)(lds + T_VS + (16 * tq + 2 * i) * T_VS_PITCH + 2 * ch), hi = *(const LAS unsigned short*)(lds + T_VS + (16 * tq + 2 * i + 1) * T_VS_PITCH + 2 * ch); pk[i] = lo | (hi << 16); }
        bf16* dst = vt + ((size_t)(b * 2 + (ch >> 6)) * 64 + (ch & 63)) * SEQ + t0 + 16 * tq;
        *(uint4*)dst = make_uint4(pk[0], pk[1], pk[2], pk[3]); *(uint4*)(dst + 8) = make_uint4(pk[4], pk[5], pk[6], pk[7]);
    }
    {
        const int head = wave >> 1, th = wave & 1, fr = lane & 15, fq = lane >> 4;
        const float* csm = (const float*)(ws + WS_CSMLA);
        {
            const bf16* wq_t = (const bf16*)(ws + WS_WUQ); f32x4 acc[2][6];
#pragma unroll
            for (int mt = 0; mt < 2; ++mt)
#pragma unroll
                for (int nt = 0; nt < 6; ++nt) acc[mt][nt] = (f32x4){0.f, 0.f, 0.f, 0.f};
            const bf16* wrow = wq_t + (size_t)(head * 96 + fr) * 256 + 8 * fq;
            bf16x8 bq0[6], bq1[6];
#pragma unroll
            for (int nt = 0; nt < 6; ++nt) { bq0[nt] = *(const bf16x8*)(wrow + (size_t)nt * 16 * 256); bq1[nt] = *(const bf16x8*)(wrow + (size_t)nt * 16 * 256 + 32); }
#pragma unroll
            for (int ks = 0; ks < 8; ++ks) {
                bf16x8 a[2];
#pragma unroll
                for (int mt = 0; mt < 2; ++mt) a[mt] = *(const LAS bf16x8*)(lds + T_QL + (32 * th + 16 * mt + fr) * T_QL_PITCH + (32 * ks + 8 * fq) * 2);
#pragma unroll
                for (int nt = 0; nt < 6; ++nt) { const bf16x8 bq = (ks & 1) ? bq1[nt] : bq0[nt];
#pragma unroll
                    for (int mt = 0; mt < 2; ++mt) acc[mt][nt] = __builtin_amdgcn_mfma_f32_16x16x32_bf16(bq, a[mt], acc[mt][nt], 0, 0, 0); }
                if (ks + 2 < 8) {
#pragma unroll
                    for (int nt = 0; nt < 6; ++nt) { const bf16x8 nb = *(const bf16x8*)(wrow + (size_t)nt * 16 * 256 + 32 * (ks + 2)); if (ks & 1) bq1[nt] = nb; else bq0[nt] = nb; }
                }
            }
            const float* wn = ain(I_MQN) + L * 96; bf16* mq = (bf16*)(ws + WS_MLAQ);
            asm volatile("" ::: "memory");
            f32x4 wq4[6], csq[2][2];
#pragma unroll
            for (int nt = 0; nt < 6; ++nt) wq4[nt] = *(const f32x4*)(wn + 16 * nt + 4 * fq);
#pragma unroll
            for (int mt = 0; mt < 2; ++mt) { const int tok_ = 32 * th + 16 * mt + fr; csq[mt][0] = *(const f32x4*)(csm + ((size_t)(t0 + tok_) * 16 + 4 * fq) * 2); csq[mt][1] = *(const f32x4*)(csm + ((size_t)(t0 + tok_) * 16 + 4 * fq + 2) * 2); }
#pragma unroll
            for (int mt = 0; mt < 2; ++mt) {
                const int tok = 32 * th + 16 * mt + fr; float s = 0.f;
#pragma unroll
                for (int nt = 0; nt < 6; ++nt) s += (acc[mt][nt][0] * acc[mt][nt][0] + acc[mt][nt][1] * acc[mt][nt][1]) + (acc[mt][nt][2] * acc[mt][nt][2] + acc[mt][nt][3] * acc[mt][nt][3]);
                s += __shfl_xor(s, 16); s += __shfl_xor(s, 32); const float r2 = rsqrtf(s * (1.0f / 96.0f) + EPS);
#pragma unroll
                for (int nt = 0; nt < 6; ++nt) acc[mt][nt] = acc[mt][nt] * r2 * wq4[nt];
                const f32x4 cs0 = csq[mt][0], cs1 = csq[mt][1];
                const float cc[4] = {cs0.x, cs0.z, cs1.x, cs1.z}, sn[4] = {cs0.y, cs0.w, cs1.y, cs1.w};
#pragma unroll
                for (int e = 0; e < 4; ++e) { const float x1 = acc[mt][4][e], x2 = acc[mt][5][e]; acc[mt][4][e] = x1 * cc[e] - x2 * sn[e]; acc[mt][5][e] = x1 * sn[e] + x2 * cc[e]; }
#pragma unroll
                for (int nt = 0; nt < 6; ++nt) { uint2 w; w.x = cvtpk(acc[mt][nt][0], acc[mt][nt][1]); w.y = cvtpk(acc[mt][nt][2], acc[mt][nt][3]); *(uint2*)(mq + (m0 + tok) * 384 + head * 96 + 16 * nt + 4 * fq) = w; }
            }
        }
        {
            const bf16* wkv_t = (const bf16*)(ws + WS_WUKV); f32x4 ak[2][4], av[2][4];
#pragma unroll
            for (int mt = 0; mt < 2; ++mt)
#pragma unroll
                for (int nt = 0; nt < 4; ++nt) { ak[mt][nt] = (f32x4){0.f, 0.f, 0.f, 0.f}; av[mt][nt] = (f32x4){0.f, 0.f, 0.f, 0.f}; }
            const bf16* wrk = wkv_t + (size_t)(head * 128 + fr) * 128 + 8 * fq; const bf16* wrv = wrk + (size_t)64 * 128;
            bf16x8 bk0[4], bv0[4], bk1[4], bv1[4];
#pragma unroll
            for (int nt = 0; nt < 4; ++nt) { bk0[nt] = *(const bf16x8*)(wrk + (size_t)nt * 16 * 128); bv0[nt] = *(const bf16x8*)(wrv + (size_t)nt * 16 * 128); }
#pragma unroll
            for (int ks = 0; ks < 4; ++ks) {
                if (ks + 1 < 4) {
#pragma unroll
                    for (int nt = 0; nt < 4; ++nt) { const bf16x8 nk = *(const bf16x8*)(wrk + (size_t)nt * 16 * 128 + 32 * (ks + 1)), nv = *(const bf16x8*)(wrv + (size_t)nt * 16 * 128 + 32 * (ks + 1));
                        if (ks & 1) { bk0[nt] = nk; bv0[nt] = nv; } else { bk1[nt] = nk; bv1[nt] = nv; } }
                }
                bf16x8 a[2];
#pragma unroll
                for (int mt = 0; mt < 2; ++mt) a[mt] = *(const LAS bf16x8*)(lds + T_CKV + (32 * th + 16 * mt + fr) * T_CKV_PITCH + (32 * ks + 8 * fq) * 2);
#pragma unroll
                for (int nt = 0; nt < 4; ++nt) { const bf16x8 bk = (ks & 1) ? bk1[nt] : bk0[nt], bv = (ks & 1) ? bv1[nt] : bv0[nt];
#pragma unroll
                    for (int mt = 0; mt < 2; ++mt) { ak[mt][nt] = __builtin_amdgcn_mfma_f32_16x16x32_bf16(bk, a[mt], ak[mt][nt], 0, 0, 0); av[mt][nt] = __builtin_amdgcn_mfma_f32_16x16x32_bf16(a[mt], bv, av[mt][nt], 0, 0, 0); } }
            }
            const float* wn = ain(I_MKN) + L * 96; bf16* mk = (bf16*)(ws + WS_MLAK); bf16* mvt = (bf16*)(ws + WS_MLAVT); const bf16* mm = (const bf16*)(ws + WS_MLAM);
            asm volatile("" ::: "memory");
            f32x4 wk4[4], wkr[2], csk[2][4]; uint4 krw[2];
#pragma unroll
            for (int nt = 0; nt < 4; ++nt) wk4[nt] = *(const f32x4*)(wn + 16 * nt + 4 * fq);
            wkr[0] = *(const f32x4*)(wn + 64 + 8 * fq); wkr[1] = *(const f32x4*)(wn + 64 + 8 * fq + 4);
#pragma unroll
            for (int mt = 0; mt < 2; ++mt) { const int tok_ = 32 * th + 16 * mt + fr; krw[mt] = *(const uint4*)(mm + (m0 + tok_) * 256 + 128 + 8 * fq);
#pragma unroll
                for (int e2 = 0; e2 < 4; ++e2) csk[mt][e2] = *(const f32x4*)(csm + ((size_t)(t0 + tok_) * 16 + 8 * (fq & 1) + 2 * e2) * 2); }
#pragma unroll
            for (int mt = 0; mt < 2; ++mt) {
                const int tok = 32 * th + 16 * mt + fr; const uint4 kw_ = krw[mt]; float kr[8] = {bflo(kw_.x), bfhi(kw_.x), bflo(kw_.y), bfhi(kw_.y), bflo(kw_.z), bfhi(kw_.z), bflo(kw_.w), bfhi(kw_.w)}; float s = 0.f;
#pragma unroll
                for (int nt = 0; nt < 4; ++nt) s += (ak[mt][nt][0] * ak[mt][nt][0] + ak[mt][nt][1] * ak[mt][nt][1]) + (ak[mt][nt][2] * ak[mt][nt][2] + ak[mt][nt][3] * ak[mt][nt][3]);
#pragma unroll
                for (int e = 0; e < 8; ++e) s += kr[e] * kr[e];
                s += __shfl_xor(s, 16); s += __shfl_xor(s, 32); const float r2 = rsqrtf(s * (1.0f / 96.0f) + EPS);
#pragma unroll
                for (int nt = 0; nt < 4; ++nt) { const f32x4 kk = ak[mt][nt] * r2 * wk4[nt]; uint2 w; w.x = cvtpk(kk[0], kk[1]); w.y = cvtpk(kk[2], kk[3]); *(uint2*)(mk + (m0 + tok) * 384 + head * 96 + 16 * nt + 4 * fq) = w; }
                float cc[8], sn[8];
#pragma unroll
                for (int e2 = 0; e2 < 4; ++e2) { const f32x4 v = csk[mt][e2]; cc[2 * e2] = v.x; sn[2 * e2] = v.y; cc[2 * e2 + 1] = v.z; sn[2 * e2 + 1] = v.w; }
#pragma unroll
                for (int e = 0; e < 8; ++e) { const float y = kr[e] * r2 * wkr[e >> 2][e & 3]; const float pe = __shfl_xor(y, 32); kr[e] = fq < 2 ? y * cc[e] - pe * sn[e] : pe * sn[e] + y * cc[e]; }
                st8(mk + (m0 + tok) * 384 + head * 96 + 64 + 8 * fq, kr);
#pragma unroll
                for (int nt = 0; nt < 4; ++nt) { uint2 w; w.x = cvtpk(av[mt][nt][0], av[mt][nt][1]); w.y = cvtpk(av[mt][nt][2], av[mt][nt][3]);
                    *(uint2*)(mvt + ((size_t)(b * 4 + head) * 64 + 16 * nt + fr) * SEQ + t0 + 32 * th + 16 * mt + 4 * fq) = w; }
            }
        }
    }
    __syncthreads();
}


__device__ __forceinline__ float max3f(float a, float b, float c) { float r; asm("v_max3_f32 %0, %1, %2, %3" : "=v"(r) : "v"(a), "v"(b), "v"(c)); return r; }
__device__ __forceinline__ float max2f(float a, float b) { float r; asm("v_max_f32_e32 %0, %1, %2" : "=v"(r) : "v"(a), "v"(b)); return r; }
__device__ __forceinline__ float xhalf_max(float x) { const unsigned u = __float_as_uint(x); const auto r = __builtin_amdgcn_permlane32_swap(u, u, false, false); return max2f(__uint_as_float(r[0]), __uint_as_float(r[1])); }
#define OPQ(x) asm("" : "+v"(x))
template <int DQK> struct AttnCfg { static constexpr int KP = DQK * 2 + 16, VP = 144, KB = 64 * KP, VB = 64 * VP, BUF = KB + VB, NKS = DQK / 16, KCH = 64 * DQK / 8; };

template <int DQK, bool SWA>
__device__ __forceinline__ void attn_unit(LAS unsigned char* lds, int L, int unit, int tid, int wave, int lane) {
    typedef AttnCfg<DQK> C;
    static_assert(3 * C::BUF <= RING_BYTES, "attention LDS ring");
    unsigned char* ws = aws();
    const int hh = lane >> 5, ql = lane & 31, b = unit >> 6;
    const int qb = SWA ? (unit & 31) : (unit & 15), h = SWA ? 2 * ((unit >> 5) & 1) + (wave >> 2) : (unit >> 4) & 3;
    const int q0 = SWA ? 128 * qb + 32 * (wave & 3) : 256 * qb + 32 * wave;
    const bool late = wave >= 4;
    const bf16* Kg; const bf16* Vt; const bf16* Qg; int kpitch, qpitch, ycol, slot; float c2, m_init, l_init;
    if (SWA) { const int kvh = h >> 1; Kg = (const bf16*)(ws + WS_SWAKV) + (size_t)b * SEQ * 256 + kvh * 64; kpitch = 256; Vt = (const bf16*)(ws + WS_SWAVT) + (size_t)(b * 2 + kvh) * 64 * SEQ;
        Qg = (const bf16*)(ws + WS_SWAQ) + (size_t)b * SEQ * 256 + h * 64; qpitch = 256; ycol = 512 + h * 64; slot = 8 + h; c2 = 0.125f * 1.4426950408889634f;
        m_init = ain(I_SINK)[L * 4 + h] * 1.4426950408889634f; l_init = hh == 0 ? 1.0f : 0.0f; }
    else { Kg = (const bf16*)(ws + WS_MLAK) + (size_t)b * SEQ * 384 + h * 96; kpitch = 384; Vt = (const bf16*)(ws + WS_MLAVT) + (size_t)(b * 4 + h) * 64 * SEQ;
        Qg = (const bf16*)(ws + WS_MLAQ) + (size_t)b * SEQ * 384 + h * 96; qpitch = 384; ycol = 768 + h * 64; slot = 12 + h; c2 = 0.10206207261596577f * 1.4426950408889634f; m_init = 0.f; l_init = 0.f; }
    bf16x8 qf[C::NKS];
#pragma unroll
    for (int ks = 0; ks < C::NKS; ++ks) { float x[8]; ld8(Qg + (size_t)(q0 + ql) * qpitch + 16 * ks + 8 * hh, x);
        union { bf16x8 v; unsigned u[4]; } t; t.u[0] = cvtpk(x[0] * c2, x[1] * c2); t.u[1] = cvtpk(x[2] * c2, x[3] * c2); t.u[2] = cvtpk(x[4] * c2, x[5] * c2); t.u[3] = cvtpk(x[6] * c2, x[7] * c2); qf[ks] = t.v; }
    int j0 = 0, j1 = SEQ / 64;
    if (SWA) { j0 = 2 * qb - 2 < 0 ? 0 : 2 * qb - 2; j1 = 2 * qb + 4 > SEQ / 64 ? SEQ / 64 : 2 * qb + 4; }
    f32x16 o0, o1;
#pragma unroll
    for (int i = 0; i < 16; ++i) { o0[i] = 0.f; o1[i] = 0.f; }
    float mrun = m_init, lrun = l_init;
    uint4 kr0A, kr1A = make_uint4(0u, 0u, 0u, 0u), vrA, kr0B, kr1B = make_uint4(0u, 0u, 0u, 0u), vrB;
    constexpr int CPR = DQK / 8;
    const int kc0 = tid, kc1 = tid + 512; const bool has1 = (C::KCH > 512) && (kc1 < C::KCH);
    const int vrow = tid >> 3, vc = tid & 7, vo0 = 32 * (vc >> 1) + ((vc & 1) ? 8 : 0), vo1 = 32 * (vc >> 1) + ((vc & 1) ? 24 : 16);
#define ATT_LOAD(j, R) do { const size_t key0_ = (size_t)(j) * 64; \
        kr0##R = *(const uint4*)(Kg + (key0_ + kc0 / CPR) * kpitch + 8 * (kc0 % CPR)); \
        if (has1) kr1##R = *(const uint4*)(Kg + (key0_ + kc1 / CPR) * kpitch + 8 * (kc1 % CPR)); \
        vr##R = *(const uint4*)(Vt + (size_t)vrow * SEQ + key0_ + 8 * vc); } while (0)
#define ATT_STORE(bufp, R) do { LAS unsigned char* kb_ = (bufp); LAS unsigned char* vb_ = kb_ + C::KB; \
        lds_st16(kb_ + (kc0 / CPR) * C::KP + 16 * (kc0 % CPR), kr0##R); \
        if (has1) lds_st16(kb_ + (kc1 / CPR) * C::KP + 16 * (kc1 % CPR), kr1##R); \
        *(LAS v2u*)(vb_ + vrow * C::VP + vo0) = (v2u){vr##R.x, vr##R.y}; *(LAS v2u*)(vb_ + vrow * C::VP + vo1) = (v2u){vr##R.z, vr##R.w}; } while (0)
#define ATT_VLD(vbp) do { const LAS unsigned char* v0_ = (vbp) + ql * C::VP + 16 * hh; const LAS unsigned char* v1_ = v0_ + 32 * C::VP; \
        _Pragma("unroll") for (int i_ = 0; i_ < 4; ++i_) { vf[2 * i_] = *(const LAS bf16x8*)(v0_ + 32 * i_); vf[2 * i_ + 1] = *(const LAS bf16x8*)(v1_ + 32 * i_); } } while (0)
#define ATT_PV(P0, P1, P2, P3) do { \
        o0 = __builtin_amdgcn_mfma_f32_32x32x16_bf16(vf[0], P0, o0, 0, 0, 0); o1 = __builtin_amdgcn_mfma_f32_32x32x16_bf16(vf[1], P0, o1, 0, 0, 0); \
        o0 = __builtin_amdgcn_mfma_f32_32x32x16_bf16(vf[2], P1, o0, 0, 0, 0); o1 = __builtin_amdgcn_mfma_f32_32x32x16_bf16(vf[3], P1, o1, 0, 0, 0); \
        o0 = __builtin_amdgcn_mfma_f32_32x32x16_bf16(vf[4], P2, o0, 0, 0, 0); o1 = __builtin_amdgcn_mfma_f32_32x32x16_bf16(vf[5], P2, o1, 0, 0, 0); \
        o0 = __builtin_amdgcn_mfma_f32_32x32x16_bf16(vf[6], P3, o0, 0, 0, 0); o1 = __builtin_amdgcn_mfma_f32_32x32x16_bf16(vf[7], P3, o1, 0, 0, 0); } while (0)
    ATT_LOAD(j0, A); ATT_STORE(lds, A);
    if (j0 + 1 < j1) ATT_LOAD(j0 + 1, B);
    __syncthreads();
#define ATT_ITER(LATE_, LD_, ST_) { \
        const int bn = bi == 2 ? 0 : bi + 1, bp = bi == 0 ? 2 : bi - 1; \
        LAS unsigned char* kb = lds + bi * C::BUF; LAS unsigned char* vb = kb + C::KB; \
        const bool more = j + 1 < j1; \
        if (more) ATT_STORE(lds + bn * C::BUF, ST_); \
        if (j + 2 < j1) ATT_LOAD(j + 2, LD_); \
        bool active = true; \
        if (SWA) active = !(64 * j + 63 < q0 - 128 || 64 * j > q0 + 31 + 128); \
 \
        bf16x8 vf[8], kf[2 * C::NKS]; \
        if (LATE_ && pend) { ATT_VLD(lds + bp * C::BUF + C::KB); ATT_PV(pp0, pp1, pp2, pp3); } \
        if (active) { \
_Pragma("unroll") \
            for (int ks = 0; ks < C::NKS; ++ks) { kf[2 * ks] = *(const LAS bf16x8*)(kb + ql * C::KP + (16 * ks + 8 * hh) * 2); kf[2 * ks + 1] = *(const LAS bf16x8*)(kb + (32 + ql) * C::KP + (16 * ks + 8 * hh) * 2); } \
            f32x16 s0, s1; { const float nm_ = -mrun; _Pragma("unroll") for (int i = 0; i < 16; ++i) { s0[i] = nm_; s1[i] = nm_; } } \
_Pragma("unroll") \
            for (int ks = 0; ks < C::NKS; ++ks) { \
                s0 = __builtin_amdgcn_mfma_f32_32x32x16_bf16(kf[2 * ks], qf[ks], s0, 0, 0, 0); \
                s1 = __builtin_amdgcn_mfma_f32_32x32x16_bf16(kf[2 * ks + 1], qf[ks], s1, 0, 0, 0); \
            } \
            asm volatile("s_nop 7\n\ts_nop 7" : "+v"(s0), "+v"(s1)); \
            if (!LATE_) ATT_VLD(vb); \
            if (SWA) { \
                const int qpos = q0 + ql, kbase = 64 * j + 4 * hh; \
_Pragma("unroll") \
                for (int r = 0; r < 16; ++r) { const int kp = kbase + (r & 3) + 8 * (r >> 2); const int d0 = kp - qpos, d1 = d0 + 32; \
                    if (d0 > 128 || d0 < -128) s0[r] = -INFINITY; if (d1 > 128 || d1 < -128) s1[r] = -INFINITY; } \
            } \
            float mxa = max2f(s0[0], s1[0]), mxb = max2f(s0[1], s1[1]), mxc = max2f(s0[2], s1[2]), mxd = max2f(s0[3], s1[3]); \
_Pragma("unroll") \
            for (int r = 4; r < 16; r += 4) { mxa = max3f(mxa, s0[r], s1[r]); mxb = max3f(mxb, s0[r + 1], s1[r + 1]); mxc = max3f(mxc, s0[r + 2], s1[r + 2]); mxd = max3f(mxd, s0[r + 3], s1[r + 3]); } \
            float mx = max2f(mxa, mxb); mx = max3f(mx, mxc, mxd); mx = xhalf_max(mx); \
            if (!__all(mx <= 8.0f)) { \
                const float dlt = max2f(mx, 0.f), alpha = __builtin_amdgcn_exp2f(-dlt); mrun += dlt; lrun *= alpha; \
_Pragma("unroll") \
                for (int i = 0; i < 16; ++i) { o0[i] *= alpha; o1[i] *= alpha; s0[i] -= dlt; s1[i] -= dlt; } \
            } \
            float la, lb, lc, ld; \
_Pragma("unroll") \
            for (int r = 0; r < 16; ++r) { s0[r] = __builtin_amdgcn_exp2f(s0[r]); s1[r] = __builtin_amdgcn_exp2f(s1[r]); \
                if (r == 0) { la = s0[r]; lb = s1[r]; } else if (r == 1) { lc = s0[r]; ld = s1[r]; } \
                else if ((r & 1) == 0) { la += s0[r]; OPQ(la); lb += s1[r]; OPQ(lb); } else { lc += s0[r]; OPQ(lc); ld += s1[r]; OPQ(ld); } } \
            la += lb; OPQ(la); lc += ld; OPQ(lc); lrun += la; OPQ(lrun); lrun += lc; \
            union { bf16x8 v; unsigned u[4]; } f0, f1, f2, f3; \
_Pragma("unroll") \
            for (int e = 0; e < 4; ++e) { f0.u[e] = cvtpk(s0[2 * e], s0[2 * e + 1]); f1.u[e] = cvtpk(s0[8 + 2 * e], s0[8 + 2 * e + 1]); f2.u[e] = cvtpk(s1[2 * e], s1[2 * e + 1]); f3.u[e] = cvtpk(s1[8 + 2 * e], s1[8 + 2 * e + 1]); } \
            if (LATE_) { pp0 = f0.v; pp1 = f1.v; pp2 = f2.v; pp3 = f3.v; pend = true; } \
            else ATT_PV(f0.v, f1.v, f2.v, f3.v); \
        } else if (LATE_) pend = false; \
        __syncthreads(); \
        bi = bn; \
    }
#define ATT_LOOP(LATE_) { \
    bf16x8 pp0 = qf[0], pp1 = qf[0], pp2 = qf[0], pp3 = qf[0]; bool pend = false; \
    int bi = 0; \
    for (int j = j0; j < j1; ++j) { \
        ATT_ITER(LATE_, A, B) \
        if (++j >= j1) break; \
        ATT_ITER(LATE_, B, A) \
    } \
    if (LATE_ && pend) { const int bp = bi == 0 ? 2 : bi - 1; bf16x8 vf[8]; ATT_VLD(lds + bp * C::BUF + C::KB); ATT_PV(pp0, pp1, pp2, pp3); } \
    }
    if (late) ATT_LOOP(true) else ATT_LOOP(false)
#undef ATT_LOOP
#undef ATT_ITER
#undef ATT_LOAD
#undef ATT_STORE
#undef ATT_PV
#undef ATT_VLD
    lrun += __shfl_xor(lrun, 32); const float inv = 1.0f / lrun; float sq = 0.f;
#pragma unroll
    for (int i = 0; i < 16; ++i) { o0[i] *= inv; o1[i] *= inv; sq += o0[i] * o0[i] + o1[i] * o1[i]; }
    sq += __shfl_xor(sq, 32);
    const size_t m = (size_t)b * SEQ + q0 + ql;
    if (hh == 0) ((float*)(ws + WS_SSQ))[m * 16 + slot] = sq;
    bf16* y = (bf16*)(ws + WS_Y) + m * 1024 + ycol + 4 * hh;
#pragma unroll
    for (int g4 = 0; g4 < 4; ++g4) { uint2 w0, w1; w0.x = cvtpk(o0[4 * g4], o0[4 * g4 + 1]); w0.y = cvtpk(o0[4 * g4 + 2], o0[4 * g4 + 3]); w1.x = cvtpk(o1[4 * g4], o1[4 * g4 + 1]); w1.y = cvtpk(o1[4 * g4 + 2], o1[4 * g4 + 3]);
        *(uint2*)(y + 8 * g4) = w0; *(uint2*)(y + 32 + 8 * g4) = w1; }
    __syncthreads();
}

__device__ __forceinline__ void swa_unit(LAS unsigned char* lds, int L, int unit, int tid, int wave, int lane) {
    typedef AttnCfg<64> C;
    static_assert(6 * C::BUF <= RING_BYTES, "SWA window in LDS");
    unsigned char* ws = aws();
    const int hh = lane >> 5, ql = lane & 31, b = unit >> 6, qb = unit & 31, kvh = (unit >> 5) & 1, h = 2 * kvh + (wave >> 2);
    const int q0 = 128 * qb + 32 * (wave & 3);
    const bf16* Kg = (const bf16*)(ws + WS_SWAKV) + (size_t)b * SEQ * 256 + kvh * 64; const bf16* Vt = (const bf16*)(ws + WS_SWAVT) + (size_t)(b * 2 + kvh) * 64 * SEQ;
    const bf16* Qg = (const bf16*)(ws + WS_SWAQ) + (size_t)b * SEQ * 256 + h * 64;
    const float c2 = 0.125f * 1.4426950408889634f;
    const int j0 = 2 * qb - 2 < 0 ? 0 : 2 * qb - 2, j1 = 2 * qb + 4 > SEQ / 64 ? SEQ / 64 : 2 * qb + 4, nt = j1 - j0;
    const int krow = tid >> 3, kc = tid & 7, vrow = tid >> 3, vc = tid & 7, vo0 = 32 * (vc >> 1) + ((vc & 1) ? 8 : 0), vo1 = 32 * (vc >> 1) + ((vc & 1) ? 24 : 16);
    uint4 kr[6], vr[6];
#pragma unroll
    for (int t = 0; t < 6; ++t) { const size_t key0 = (size_t)(j0 + t < j1 ? j0 + t : j1 - 1) * 64;
        kr[t] = *(const uint4*)(Kg + (key0 + krow) * 256 + 8 * kc); vr[t] = *(const uint4*)(Vt + (size_t)vrow * SEQ + key0 + 8 * vc); }
    uint4 qraw[4];
#pragma unroll
    for (int ks = 0; ks < 4; ++ks) qraw[ks] = *(const uint4*)(Qg + (size_t)(q0 + ql) * 256 + 16 * ks + 8 * hh);
    float mrun = ain(I_SINK)[L * 4 + h] * 1.4426950408889634f, lrun = hh == 0 ? 1.0f : 0.0f;
#pragma unroll
    for (int t = 0; t < 6; ++t) { LAS unsigned char* kb_ = lds + t * C::BUF; LAS unsigned char* vb_ = kb_ + C::KB;
        lds_st16(kb_ + krow * C::KP + 16 * kc, kr[t]);
        *(LAS v2u*)(vb_ + vrow * C::VP + vo0) = (v2u){vr[t].x, vr[t].y}; *(LAS v2u*)(vb_ + vrow * C::VP + vo1) = (v2u){vr[t].z, vr[t].w}; }
    bf16x8 qf[4];
#pragma unroll
    for (int ks = 0; ks < 4; ++ks) { const unsigned w4[4] = {qraw[ks].x, qraw[ks].y, qraw[ks].z, qraw[ks].w}; union { bf16x8 v; unsigned u[4]; } t;
#pragma unroll
        for (int e = 0; e < 4; ++e) t.u[e] = cvtpk(bflo(w4[e]) * c2, bfhi(w4[e]) * c2);
        qf[ks] = t.v; }
    f32x16 o0, o1;
#pragma unroll
    for (int i = 0; i < 16; ++i) { o0[i] = 0.f; o1[i] = 0.f; }
    __syncthreads();
#pragma unroll 1
    for (int t = 0; t < nt; ++t) {
        const int j = j0 + t;
        if (64 * j + 63 < q0 - 128 || 64 * j > q0 + 31 + 128) continue;
        const LAS unsigned char* kb = lds + t * C::BUF; const LAS unsigned char* vb = kb + C::KB;
        bf16x8 kf[8], vf[8];
#pragma unroll
        for (int ks = 0; ks < 4; ++ks) { kf[2 * ks] = *(const LAS bf16x8*)(kb + ql * C::KP + (16 * ks + 8 * hh) * 2); kf[2 * ks + 1] = *(const LAS bf16x8*)(kb + (32 + ql) * C::KP + (16 * ks + 8 * hh) * 2); }
        { const LAS unsigned char* v0_ = vb + ql * C::VP + 16 * hh; const LAS unsigned char* v1_ = v0_ + 32 * C::VP;
#pragma unroll
          for (int i_ = 0; i_ < 4; ++i_) { vf[2 * i_] = *(const LAS bf16x8*)(v0_ + 32 * i_); vf[2 * i_ + 1] = *(const LAS bf16x8*)(v1_ + 32 * i_); } }
        f32x16 s0, s1; { const float nm_ = -mrun;
#pragma unroll
            for (int i = 0; i < 16; ++i) { s0[i] = nm_; s1[i] = nm_; } }
#pragma unroll
        for (int ks = 0; ks < 4; ++ks) { s0 = __builtin_amdgcn_mfma_f32_32x32x16_bf16(kf[2 * ks], qf[ks], s0, 0, 0, 0); s1 = __builtin_amdgcn_mfma_f32_32x32x16_bf16(kf[2 * ks + 1], qf[ks], s1, 0, 0, 0); }
        asm volatile("s_nop 7\n\ts_nop 7" : "+v"(s0), "+v"(s1));
        { const int qpos = q0 + ql, kbase = 64 * j + 4 * hh;
#pragma unroll
          for (int r = 0; r < 16; ++r) { const int kp = kbase + (r & 3) + 8 * (r >> 2); const int d0 = kp - qpos, d1 = d0 + 32;
              if (d0 > 128 || d0 < -128) s0[r] = -INFINITY; if (d1 > 128 || d1 < -128) s1[r] = -INFINITY; } }
        float mxa = max2f(s0[0], s1[0]), mxb = max2f(s0[1], s1[1]), mxc = max2f(s0[2], s1[2]), mxd = max2f(s0[3], s1[3]);
#pragma unroll
        for (int r = 4; r < 16; r += 4) { mxa = max3f(mxa, s0[r], s1[r]); mxb = max3f(mxb, s0[r + 1], s1[r + 1]); mxc = max3f(mxc, s0[r + 2], s1[r + 2]); mxd = max3f(mxd, s0[r + 3], s1[r + 3]); }
        float mx = max2f(mxa, mxb); mx = max3f(mx, mxc, mxd); mx = xhalf_max(mx);
        if (!__all(mx <= 8.0f)) {
            const float dlt = max2f(mx, 0.f), alpha = __builtin_amdgcn_exp2f(-dlt); mrun += dlt; lrun *= alpha;
#pragma unroll
            for (int i = 0; i < 16; ++i) { o0[i] *= alpha; o1[i] *= alpha; s0[i] -= dlt; s1[i] -= dlt; }
        }
        float la, lb, lc, ld;
#pragma unroll
        for (int r = 0; r < 16; ++r) { s0[r] = __builtin_amdgcn_exp2f(s0[r]); s1[r] = __builtin_amdgcn_exp2f(s1[r]);
            if (r == 0) { la = s0[r]; lb = s1[r]; } else if (r == 1) { lc = s0[r]; ld = s1[r]; }
            else if ((r & 1) == 0) { la += s0[r]; OPQ(la); lb += s1[r]; OPQ(lb); } else { lc += s0[r]; OPQ(lc); ld += s1[r]; OPQ(ld); } }
        la += lb; OPQ(la); lc += ld; OPQ(lc); lrun += la; OPQ(lrun); lrun += lc;
        union { bf16x8 v; unsigned u[4]; } f0, f1, f2, f3;
#pragma unroll
        for (int e = 0; e < 4; ++e) { f0.u[e] = cvtpk(s0[2 * e], s0[2 * e + 1]); f1.u[e] = cvtpk(s0[8 + 2 * e], s0[8 + 2 * e + 1]); f2.u[e] = cvtpk(s1[2 * e], s1[2 * e + 1]); f3.u[e] = cvtpk(s1[8 + 2 * e], s1[8 + 2 * e + 1]); }
        o0 = __builtin_amdgcn_mfma_f32_32x32x16_bf16(vf[0], f0.v, o0, 0, 0, 0); o1 = __builtin_amdgcn_mfma_f32_32x32x16_bf16(vf[1], f0.v, o1, 0, 0, 0);
        o0 = __builtin_amdgcn_mfma_f32_32x32x16_bf16(vf[2], f1.v, o0, 0, 0, 0); o1 = __builtin_amdgcn_mfma_f32_32x32x16_bf16(vf[3], f1.v, o1, 0, 0, 0);
        o0 = __builtin_amdgcn_mfma_f32_32x32x16_bf16(vf[4], f2.v, o0, 0, 0, 0); o1 = __builtin_amdgcn_mfma_f32_32x32x16_bf16(vf[5], f2.v, o1, 0, 0, 0);
        o0 = __builtin_amdgcn_mfma_f32_32x32x16_bf16(vf[6], f3.v, o0, 0, 0, 0); o1 = __builtin_amdgcn_mfma_f32_32x32x16_bf16(vf[7], f3.v, o1, 0, 0, 0);
    }
    lrun += __shfl_xor(lrun, 32); const float inv = 1.0f / lrun; float sq = 0.f;
#pragma unroll
    for (int i = 0; i < 16; ++i) { o0[i] *= inv; o1[i] *= inv; sq += o0[i] * o0[i] + o1[i] * o1[i]; }
    sq += __shfl_xor(sq, 32);
    const size_t m = (size_t)b * SEQ + q0 + ql;
    if (hh == 0) ((float*)(ws + WS_SSQ))[m * 16 + 8 + h] = sq;
    bf16* y = (bf16*)(ws + WS_Y) + m * 1024 + 512 + h * 64 + 4 * hh;
#pragma unroll
    for (int g4 = 0; g4 < 4; ++g4) { uint2 w0, w1; w0.x = cvtpk(o0[4 * g4], o0[4 * g4 + 1]); w0.y = cvtpk(o0[4 * g4 + 2], o0[4 * g4 + 3]); w1.x = cvtpk(o1[4 * g4], o1[4 * g4 + 1]); w1.y = cvtpk(o1[4 * g4 + 2], o1[4 * g4 + 3]);
        *(uint2*)(y + 8 * g4) = w0; *(uint2*)(y + 32 + 8 * g4) = w1; }
    __syncthreads();
}

__device__ __forceinline__ void ssd_state_pass(int gtid) {
    unsigned char* ws = aws();
    if (gtid < 64 * 2048) {
        const int bhd = gtid >> 11, e = (gtid & 2047) * 4, dir = bhd & 1, h = (bhd >> 1) & 7, b = bhd >> 4;
        const float* dtc = (const float*)(ws + WS_DTC); const float* st = aout(); bf16* sin = (bf16*)(ws + WS_SIN);
        f32x4 v[16]; float d[16];
#pragma unroll
        for (int k = 0; k < 16; ++k) { v[k] = *(const f32x4*)(st + ((size_t)((b * 16 + k) * 8 + h) * 2 + dir) * 8192 + e);
            const size_t mt = (size_t)b * SEQ + (size_t)k * 256 + (dir == 0 ? 255 : 0); d[k] = __expf(dtc[(mt * 8 + h) * 4 + 2 + dir]); }
        f32x4 S = (f32x4){0.f, 0.f, 0.f, 0.f};
        bf16* o = sin + ((size_t)((b * 16) * 8 + h) * 2 + dir) * 8192 + e; constexpr size_t CS = (size_t)8 * 2 * 8192;
        if (dir == 0) {
#pragma unroll
            for (int k = 0; k < 16; ++k) { *(uint2*)(o + k * CS) = make_uint2(cvtpk(S[0], S[1]), cvtpk(S[2], S[3])); S = S * d[k] + v[k]; }
        } else {
#pragma unroll
            for (int k = 15; k >= 0; --k) { *(uint2*)(o + k * CS) = make_uint2(cvtpk(S[0], S[1]), cvtpk(S[2], S[3])); S = S * d[k] + v[k]; }
        }
    }
}
__device__ __forceinline__ void sp_arrive(unsigned* cnt, int tid) {
    asm volatile("s_waitcnt vmcnt(0)" ::: "memory"); __syncthreads();
    if (tid == 0) { __builtin_amdgcn_fence(__ATOMIC_RELEASE, "agent"); asm volatile("s_waitcnt vmcnt(0)" ::: "memory"); (void)xb_add(cnt, 1u); }
}
__device__ __forceinline__ void sp_wait(unsigned* cnt, unsigned G, int tid) {
    if (tid == 0) { unsigned sp = 0; while (xb_ld(cnt) < G) { __builtin_amdgcn_s_sleep(2); if (++sp > (1u << 22)) break; }
        __builtin_amdgcn_fence(__ATOMIC_ACQUIRE, "agent"); asm volatile("s_waitcnt vmcnt(0)" ::: "memory"); }
    __syncthreads();
}

constexpr int O_BM = 0, O_BM_PITCH = 272, O_S = 256 * 272, O_S_PITCH = 272, O_X = O_S + 2 * 64 * O_S_PITCH, O_X_PITCH = 192;
static_assert(O_X + 256 * O_X_PITCH <= TAB_OFF, "SSD out unit LDS (RTAB is dead in this phase)");

__device__ __forceinline__ void ssd_out_unit(LAS unsigned char* lds, int L, int unit, int tid, int wave, int lane, int abl = 0) {
    unsigned char* ws = aws();
    const int h = unit & 7, c = (unit >> 3) & 15, b = unit >> 7, g = h >> 2, hh = lane >> 5, ql = lane & 31;
    const size_t m0 = (size_t)b * SEQ + (size_t)c * 256;
    const bf16* xc = (const bf16*)(ws + WS_XBCC); const float* dtc = (const float*)(ws + WS_DTC);
    LAS float* tF = (LAS float*)(lds + TAB_OFF); LAS float* tB = tF + 256; LAS float* tD = tF + 512;
    int nst_ = __builtin_amdgcn_readfirstlane(REPB(16) ? 2 : (abl == 1 ? 0 : 1));
    for (int st_ = 0; st_ < nst_; ++st_) {
    if (st_ > 0) __syncthreads();
    if (tid < 256) { const f32x4 v = *(const f32x4*)(dtc + ((m0 + tid) * 8 + h) * 4);
        tF[tid] = v[2] * 1.4426950408889634f - __builtin_amdgcn_logf(v[0]); tB[tid] = v[3] * 1.4426950408889634f - __builtin_amdgcn_logf(v[1]); tD[tid] = v[0] + v[1]; }
#pragma unroll
    for (int r = 0; r < 8; ++r) { const int id = tid + 512 * r, s = id >> 4, c8 = id & 15; lds_st16(lds + O_BM + s * O_BM_PITCH + 16 * c8, *(const uint4*)(xc + (m0 + s) * 1024 + 512 + g * 128 + 8 * c8)); }
#pragma unroll
    for (int r = 0; r < 4; ++r) { const int id = tid + 512 * r, s = id >> 3, c8 = id & 7; lds_st16(lds + O_X + s * O_X_PITCH + 16 * c8, *(const uint4*)(xc + (m0 + s) * 1024 + h * 64 + 8 * c8)); }
    {
        const bf16* sin = (const bf16*)(ws + WS_SIN) + ((size_t)((b * 16 + c) * 8 + h) * 2) * 8192;
#pragma unroll
        for (int i = 0; i < 4; ++i) { const int id = tid + 512 * i, dir = id >> 10, e = (id & 1023) * 8, p = e >> 7, nn = e & 127;
            lds_st16(lds + O_S + dir * 64 * O_S_PITCH + p * O_S_PITCH + nn * 2, *(const uint4*)(sin + (size_t)dir * 8192 + e)); }
    }
    }
    bf16x8 cf[8];
#pragma unroll
    for (int ks = 0; ks < 8; ++ks) cf[ks] = *(const bf16x8*)(xc + (m0 + 32 * wave + ql) * 1024 + 768 + g * 128 + 16 * ks + 8 * hh);
    const f32x4 mine = *(const f32x4*)(dtc + ((m0 + 32 * wave + ql) * 8 + h) * 4);
    __syncthreads();
    const float clf = mine[2] * 1.4426950408889634f, clb = mine[3] * 1.4426950408889634f;
    f32x16 yf0, yf1, yb0, yb1;
#pragma unroll
    for (int i = 0; i < 16; ++i) { yf0[i] = 0.f; yf1[i] = 0.f; yb0[i] = 0.f; yb1[i] = 0.f; }
    if (abl != 2)
#pragma unroll
    for (int kh = 0; kh < 2; ++kh) {
        bf16x8 as[4][4];
#pragma unroll
        for (int k4 = 0; k4 < 4; ++k4) { const LAS unsigned char* sp = lds + O_S + (16 * (4 * kh + k4) + 8 * hh) * 2;
#pragma unroll
            for (int i = 0; i < 4; ++i) as[k4][i] = *(const LAS bf16x8*)(sp + (32 * i + ql) * O_S_PITCH); }
#pragma unroll
        for (int k4 = 0; k4 < 4; ++k4) { const int ks = 4 * kh + k4;
            yf0 = __builtin_amdgcn_mfma_f32_32x32x16_bf16(as[k4][0], cf[ks], yf0, 0, 0, 0); yf1 = __builtin_amdgcn_mfma_f32_32x32x16_bf16(as[k4][1], cf[ks], yf1, 0, 0, 0);
            yb0 = __builtin_amdgcn_mfma_f32_32x32x16_bf16(as[k4][2], cf[ks], yb0, 0, 0, 0); yb1 = __builtin_amdgcn_mfma_f32_32x32x16_bf16(as[k4][3], cf[ks], yb1, 0, 0, 0); }
    }
    { const float ef = __builtin_amdgcn_exp2f(clf), eb = __builtin_amdgcn_exp2f(clb);
#pragma unroll
      for (int i = 0; i < 16; ++i) { yf0[i] = yf0[i] * ef + yb0[i] * eb; yf1[i] = yf1[i] * ef + yb1[i] * eb; } }
    const int lpos = 32 * wave + ql, blk = (lane >> 4) & 1, q4 = (lane & 15) >> 2, p4 = lane & 3;
    bf16x8 am[8]; v4i16 xt[8];
#define SSD_LD_AM(sb_) do { _Pragma("unroll") for (int ks = 0; ks < 8; ++ks) am[ks] = *(const LAS bf16x8*)(lds + O_BM + (32 * (sb_) + ql) * O_BM_PITCH + (16 * ks + 8 * hh) * 2); } while (0)
#define SSD_LD_XT(sb_) do { _Pragma("unroll") for (int s2 = 0; s2 < 2; ++s2) { const LAS unsigned char* xp = lds + O_X + (32 * (sb_) + 16 * s2 + 4 * hh + q4) * O_X_PITCH + (16 * blk + 4 * p4) * 2; \
            xt[4 * s2] = tr4(xp); xt[4 * s2 + 1] = tr4(xp + 8 * O_X_PITCH); xt[4 * s2 + 2] = tr4(xp + 64); xt[4 * s2 + 3] = tr4(xp + 8 * O_X_PITCH + 64); } } while (0)
    SSD_LD_AM(0); SSD_LD_XT(0);
#pragma unroll 1
    for (int sb = 0; sb < (abl == 3 ? 0 : 8); ++sb) {
        const int sn = sb < 7 ? sb + 1 : 7;
        __builtin_amdgcn_sched_barrier(0);
        f32x16 gt;
#pragma unroll
        for (int i = 0; i < 16; ++i) gt[i] = 0.f;
#pragma unroll
        for (int ks = 0; ks < 8; ++ks) gt = __builtin_amdgcn_mfma_f32_32x32x16_bf16(am[ks], cf[ks], gt, 0, 0, 0);
        __builtin_amdgcn_sched_barrier(0);
        SSD_LD_AM(sn);
        __builtin_amdgcn_sched_barrier(0);
        const int sbase = 32 * sb + 4 * hh;
        if (sb < wave) {
#pragma unroll
            for (int i = 0; i < 4; ++i) { const f32x4 t = *(const LAS f32x4*)(tF + sbase + 8 * i);
#pragma unroll
                for (int e = 0; e < 4; ++e) gt[4 * i + e] *= __builtin_amdgcn_exp2f(clf - t[e]); }
        } else if (sb > wave) {
#pragma unroll
            for (int i = 0; i < 4; ++i) { const f32x4 t = *(const LAS f32x4*)(tB + sbase + 8 * i);
#pragma unroll
                for (int e = 0; e < 4; ++e) gt[4 * i + e] *= __builtin_amdgcn_exp2f(clb - t[e]); }
        } else {
#pragma unroll
            for (int i = 0; i < 4; ++i) { const f32x4 a = *(const LAS f32x4*)(tF + sbase + 8 * i), bq = *(const LAS f32x4*)(tB + sbase + 8 * i), d = *(const LAS f32x4*)(tD + sbase + 8 * i);
#pragma unroll
                for (int e = 0; e < 4; ++e) { const int s = sbase + 8 * i + e; const float arg = s < lpos ? clf - a[e] : clb - bq[e];
                    const float w = __builtin_amdgcn_exp2f(arg); gt[4 * i + e] *= s == lpos ? d[e] : w; } }
        }
#pragma unroll
        for (int s2 = 0; s2 < 2; ++s2) {
            union { bf16x8 v; unsigned u[4]; } wfz; wfz.u[0] = cvtpk(gt[8 * s2 + 0], gt[8 * s2 + 1]); wfz.u[1] = cvtpk(gt[8 * s2 + 2], gt[8 * s2 + 3]); wfz.u[2] = cvtpk(gt[8 * s2 + 4], gt[8 * s2 + 5]); wfz.u[3] = cvtpk(gt[8 * s2 + 6], gt[8 * s2 + 7]);
            const bf16x8 x0 = cat4(xt[4 * s2], xt[4 * s2 + 1]), x1 = cat4(xt[4 * s2 + 2], xt[4 * s2 + 3]);
            yf0 = __builtin_amdgcn_mfma_f32_32x32x16_bf16(x0, wfz.v, yf0, 0, 0, 0); yf1 = __builtin_amdgcn_mfma_f32_32x32x16_bf16(x1, wfz.v, yf1, 0, 0, 0);
        }
        __builtin_amdgcn_sched_barrier(0);
        SSD_LD_XT(sn);
    }
#undef SSD_LD_AM
#undef SSD_LD_XT
    {
        const float Dh = ain(I_SSDD)[L * 8 + h]; const size_t m = m0 + lpos; const bf16* z = (const bf16*)(ws + WS_Z) + m * 512 + h * 64 + 4 * hh;
        bf16* y = (bf16*)(ws + WS_Y) + m * 1024 + h * 64 + 4 * hh; float sq = 0.f;
        uint2 zall[8];
#pragma unroll
        for (int i = 0; i < 8; ++i) zall[i] = *(const uint2*)(z + 8 * i);
#pragma unroll
        for (int pb = 0; pb < 2; ++pb)
#pragma unroll
            for (int g4 = 0; g4 < 4; ++g4) {
                const int pp = 32 * pb + 8 * g4 + 4 * hh; const v2u xw = *(const LAS v2u*)(lds + O_X + lpos * O_X_PITCH + pp * 2); const uint2 zw = zall[4 * pb + g4];
                const float xv[4] = {bflo(xw.x), bfhi(xw.x), bflo(xw.y), bfhi(xw.y)}, zv[4] = {bflo(zw.x), bfhi(zw.x), bflo(zw.y), bfhi(zw.y)}; float o[4];
#pragma unroll
                for (int e = 0; e < 4; ++e) { const float yv = (pb == 0 ? yf0[4 * g4 + e] : yf1[4 * g4 + e]) + Dh * xv[e]; o[e] = yv * silu_f(zv[e]); sq += o[e] * o[e]; }
                uint2 w; w.x = cvtpk(o[0], o[1]); w.y = cvtpk(o[2], o[3]); *(uint2*)(y + 32 * pb + 8 * g4) = w;
            }
        sq += __shfl_xor(sq, 32);
        if (hh == 0 && abl == 0) ((float*)(ws + WS_SSQ))[m * 16 + h] = sq;
    }
    __syncthreads();
}
__device__ __forceinline__ void build_out_tab(LAS unsigned char* lds, int pm, int tid) {
    if (tid < 256) { const float* q = (const float*)(aws() + WS_SSQ) + ((size_t)pm * 256 + tid) * 16; float rs[4];
#pragma unroll
        for (int g = 0; g < 4; ++g) { const f32x4 v = *(const f32x4*)(q + 4 * g); rs[g] = rsqrtf(((v[0] + v[1]) + (v[2] + v[3])) * (1.0f / 256.0f) + EPS); }
        ((LAS f32x4*)(lds + TAB_OFF))[tid] = (f32x4){rs[0] / rs[1], rs[1] / rs[2], rs[2] / rs[3], rs[3]}; }
    __syncthreads();
}

constexpr int NPHASES = 1 + 9 * DEPTH;

#define PHASE_IDS \
    int zero = 0; asm volatile("" : "+s"(zero)); \
    const int wave = __builtin_amdgcn_readfirstlane((int)threadIdx.x >> 6) + zero; \
    const int G = (int)gridDim.x + zero, bx = (int)blockIdx.x + zero; \
    const int vcu = (G % 8 == 0) ? (bx % 8) * (G / 8) + bx / 8 : bx; \
    const int gw = vcu * NWAVES + wave, NGW = G * NWAVES, NT = G * NWAVES * 64; \
    int tid = threadIdx.x; asm volatile("" : "+v"(tid)); const int lane = tid & 63, gtid = bx * (NWAVES * 64) + tid; \
    unsigned char* ws = aws(); (void)lane; (void)gtid; (void)gw; (void)NGW; (void)NT; (void)wave; (void)ws; (void)vcu;
#define GRID_BAR() do { XcdBarrier bar; bar.bar = (unsigned*)(aws() + WS_CTL) + CW_BAR; bar.x = xb_xcc_id(); bar.st = (volatile LAS unsigned*)(lds + MISC_OFF) + 8; xcd_barrier(bar); } while (0)
#define IN(k) (lo <= (k) && (k) < hi)
#define SEAM(k) do { if ((k) + 1 < hi) { int nb_ = REPB(14) ? 2 : 1; asm volatile("" : "+s"(nb_)); for (int r_ = 0; r_ < nb_; ++r_) GRID_BAR(); } } while (0)

template <int L> __device__ __forceinline__ void layer_phases(LAS unsigned char* lds, int lo, int hi) {
    constexpr int P = 1 + 9 * L;
    if (IN(P + 0)) {
        PHASE_IDS
        pg8::Gemm g{(const bf16*)(ws + WS_XB), (const bf16*)(ws + WS_WGU1), M, 2 * FF, D}; pg8::StaticOrder S; S.init(M, 2 * FF, G, bx);
        PG8_LAS float* rt = (PG8_LAS float*)(lds + RTAB_OFF); const bool ut = fill_rstd_tab(rt, S, (const float*)(ws + WS_SS), tid);
        EpiGU E{(bf16*)(ws + WS_HB), (const float*)(ws + WS_SS), rt, ut};
        pg8::gemm_phase<EpiGU, pg8::StaticOrder, true, true>(lds, g, S, E);
        if (REPB(11)) { EpiDry Ed; pg8::gemm_phase<EpiDry, pg8::StaticOrder, true, true>(lds, g, S, Ed); }
        if (REPB(1)) pg8::gemm_phase<EpiGU, pg8::StaticOrder, true, true>(lds, g, S, E);
        { TAIL_WORKER(64 * 22) int ntr_ = REPB(15) ? 2 : 1; asm volatile("" : "+s"(ntr_)); for (int tr_ = 0; tr_ < ntr_; ++tr_) if (tail_) { convert_job<J_D1>(L, lds, tw_, tnw_, wave, lane, 0); convert_job<J_IN>(L, lds, tw_, tnw_, wave, lane, 704); if (L == 1) convert_job<J_UQKV>(1, lds, tw_, tnw_, wave, lane, 1408); } }
        SEAM(P + 0);
    }
    if (IN(P + 1)) {
        PHASE_IDS
        pg8::Gemm g{(const bf16*)(ws + WS_HB), (const bf16*)(ws + WS_WD1), M, D, FF}; pg8::StaticOrder S; S.init(M, D, G, bx);
        if (REPB(5)) { EpiDry Ed; pg8::gemm_phase<EpiDry, pg8::StaticOrder, false, true>(lds, g, S, Ed); }
        EpiDown<0, false> E{aout(), (bf16*)(ws + WS_XB), (float*)(ws + WS_SS), 0.5f, nullptr};
        pg8::gemm_phase<EpiDown<0, false>, pg8::StaticOrder, false, true>(lds, g, S, E);
        SEAM(P + 1);
    }
    if (IN(P + 2)) {
        PHASE_IDS
        pg8::Gemm g{(const bf16*)(ws + WS_XB), (const bf16*)(ws + WS_WIN), M, NPROJP, D}; pg8::StaticOrder S; S.init(M, NPROJP, G, bx);
        PG8_LAS float* rt = (PG8_LAS float*)(lds + RTAB_OFF); const bool ut = fill_rstd_tab(rt, S, (const float*)(ws + WS_SS), tid);
        EpiProj E{(bf16*)(ws + WS_PROJ), (float*)(ws + WS_DTRAW), (const float*)(ws + WS_SS), rt, ut};
        pg8::gemm_phase<EpiProj, pg8::StaticOrder, true, true>(lds, g, S, E);
        if (REPB(2)) pg8::gemm_phase<EpiProj, pg8::StaticOrder, true, true>(lds, g, S, E);
        { TAIL_WORKER(64 * 10) int ntr_ = REPB(15) ? 2 : 1; asm volatile("" : "+s"(ntr_)); for (int tr_ = 0; tr_ < ntr_; ++tr_) if (tail_) { convert_job<J_OUT>(L, lds, tw_, tnw_, wave, lane, 0); convert_job<J_GU2>(L, lds, tw_, tnw_, wave, lane, 256); } }
        SEAM(P + 2);
    }
    if (IN(P + 3)) {
        PHASE_IDS
        { int nrep = (REPB(3) || REPB(12)) ? REP_N : 1; asm volatile("" : "+s"(nrep));
          for (int r = 0; r < nrep; ++r) for (int u = vcu; u < 512; u += G) ssd_state_unit(lds, L, G == 256 ? 64 * (vcu >> 5) + (vcu & 31) + (u >= 256 ? 32 : 0) : u, tid, wave, lane); }
#if defined(PREP_STOP) && defined(PREFIX_K)
        if (hi != PREFIX_K)
#endif
        for (int u = vcu; u < 256; u += G) token_prep_unit(lds, L, u, tid, wave, lane, true);
        if (REPB(3) || REPB(13)) { for (int u = vcu; u < 256; u += G) token_prep_unit(lds, L, u, tid, wave, lane, false); }
        SEAM(P + 3);
    }
    if (IN(P + 4)) {
        PHASE_IDS
        ssd_state_pass(gtid); sp_arrive((unsigned*)(ws + WS_CTL) + CW_SP + 64 * L, tid);
#if defined(MIX_STOP) && defined(PREFIX_K)
#define MIXGO(n) (hi != PREFIX_K || (n) <= MIX_STOP)
#else
#define MIXGO(n) true
#endif
        if (MIXGO(2))
        { int nrep = REPB(8) ? REP_N : 1; asm volatile("" : "+s"(nrep));
          for (int r = 0; r < nrep; ++r) for (int u = vcu; u < 256; u += G) attn_unit<96, false>(lds, L, u, tid, wave, lane); }
#ifdef ABL_N
        for (int u = vcu; u < 256; u += G) attn_unit<96, false, ABL_N>(lds, L, u, tid, wave, lane);
#endif
        if (MIXGO(3))
        { int nrep = REPB(9) ? REP_N : 1; asm volatile("" : "+s"(nrep));
          for (int r = 0; r < nrep; ++r) for (int u = vcu; u < 256; u += G) swa_unit(lds, L, u, tid, wave, lane); }
        if (MIXGO(4)) sp_wait((unsigned*)(ws + WS_CTL) + CW_SP + 64 * L, (unsigned)G, tid);
        if (MIXGO(5))
        { int nrep = REPB(10) ? REP_N : 1; asm volatile("" : "+s"(nrep));
#ifdef ABL_S
          for (int r = 0; r < nrep; ++r) { const int ab_ = __builtin_amdgcn_readfirstlane(r > 0 ? ABL_S : 0); for (int u = vcu; u < 512; u += G) ssd_out_unit(lds, L, G == 256 ? 64 * (vcu >> 5) + (vcu & 31) + (u >= 256 ? 32 : 0) : u, tid, wave, lane, ab_); } }
#else
          for (int r = 0; r < nrep; ++r) for (int u = vcu; u < 512; u += G) ssd_out_unit(lds, L, G == 256 ? 64 * (vcu >> 5) + (vcu & 31) + (u >= 256 ? 32 : 0) : u, tid, wave, lane); }
#endif
        SEAM(P + 5);
    }
    if (IN(P + 6)) {
        PHASE_IDS
        pg8::Gemm g{(const bf16*)(ws + WS_Y), (const bf16*)(ws + WS_WOUT), M, D, D}; pg8::StaticOrder S; S.init(M, D, G, bx);
        if (REPB(6)) { EpiDry Ed; pg8::gemm_phase<EpiDry, pg8::StaticOrder, false, true>(lds, g, S, Ed); }
        pg8::Unit u0; if (S.next(0, u0)) build_out_tab(lds, u0.pm, tid);
        EpiDown<1, false> E{aout(), (bf16*)(ws + WS_XB), (float*)(ws + WS_SS), 1.0f, (const PG8_LAS float*)(lds + TAB_OFF)};
        pg8::gemm_phase<EpiDown<1, false>, pg8::StaticOrder, false, true>(lds, g, S, E);
        SEAM(P + 6);
    }
    if (IN(P + 7)) {
        PHASE_IDS
        pg8::Gemm g{(const bf16*)(ws + WS_XB), (const bf16*)(ws + WS_WGU2), M, 2 * FF, D}; pg8::StaticOrder S; S.init(M, 2 * FF, G, bx);
        PG8_LAS float* rt = (PG8_LAS float*)(lds + RTAB_OFF); const bool ut = fill_rstd_tab(rt, S, (const float*)(ws + WS_SS), tid);
        EpiGU E{(bf16*)(ws + WS_HB), (const float*)(ws + WS_SS), rt, ut};
        pg8::gemm_phase<EpiGU, pg8::StaticOrder, true, true>(lds, g, S, E);
        if (REPB(11)) { EpiDry Ed; pg8::gemm_phase<EpiDry, pg8::StaticOrder, true, true>(lds, g, S, Ed); }
        if (REPB(1)) pg8::gemm_phase<EpiGU, pg8::StaticOrder, true, true>(lds, g, S, E);
        { TAIL_WORKER(64 * 22) int ntr_ = REPB(15) ? 2 : 1; asm volatile("" : "+s"(ntr_)); for (int tr_ = 0; tr_ < ntr_; ++tr_) if (tail_) { convert_job<J_D2>(L, lds, tw_, tnw_, wave, lane, 0); if (L == 0) convert_job<J_GU1>(1, lds, tw_, tnw_, wave, lane, 704); } }
        SEAM(P + 7);
    }
    if (IN(P + 8)) {
        PHASE_IDS
        pg8::Gemm g{(const bf16*)(ws + WS_HB), (const bf16*)(ws + WS_WD2), M, D, FF}; pg8::StaticOrder S; S.init(M, D, G, bx);
        if (REPB(5)) { EpiDry Ed; pg8::gemm_phase<EpiDry, pg8::StaticOrder, false, true>(lds, g, S, Ed); }
        EpiDown<0, L == DEPTH - 1> E{aout(), (bf16*)(ws + WS_XB), (float*)(ws + WS_SS), 0.5f, nullptr};
        pg8::gemm_phase<EpiDown<0, L == DEPTH - 1>, pg8::StaticOrder, false, true>(lds, g, S, E);
        SEAM(P + 8);
    }
}

__global__ void __launch_bounds__(NWAVES * 64, 2) mk_fwd(Args args) {
    extern __shared__ __attribute__((aligned(16))) unsigned char lds_raw[];
    LAS unsigned char* lds = (LAS unsigned char*)lds_raw;
    for (int u = threadIdx.x; u < (LDS_BYTES - LDSCTL_OFF) / 4; u += NWAVES * 64) ((LAS unsigned*)(lds + LDSCTL_OFF))[u] = 0u;
    __syncthreads();
    const int lo = ((const int*)__builtin_amdgcn_kernarg_segment_ptr())[2 * (N_IN + 2)], hi = ((const int*)__builtin_amdgcn_kernarg_segment_ptr())[2 * (N_IN + 2) + 1];
    if (hi - lo > 1) (void)xcd_barrier_post((unsigned*)(aws() + WS_CTL) + CW_BAR, (volatile LAS unsigned*)(lds + MISC_OFF) + 8);
    if (IN(0)) {
        PHASE_IDS
#ifndef NO_P0
        convert_job<J_GU1>(0, lds, gw, NGW, wave, lane); convert_job<J_UQKV>(0, lds, gw, NGW, wave, lane);
        p0_x_and_tables(gw, NGW, lane, gtid, NT);
        if (REPB(0)) { convert_job<J_GU1>(0, lds, gw, NGW, wave, lane); convert_job<J_UQKV>(0, lds, gw, NGW, wave, lane); p0_x_and_tables(gw, NGW, lane, gtid, NT); }
#endif
        SEAM(0);
    }
    layer_phases<0>(lds, lo, hi);
    layer_phases<1>(lds, lo, hi);
}


extern "C" void kernel_launch(void* const* d_in, const int* in_sizes, int n_in, void* d_out, int out_size, void* d_ws, size_t ws_size, hipStream_t stream) {
    static int grid = 0;
    if (grid == 0) {
        if (n_in != N_IN || out_size != M * D || ws_size < WS_END) { fprintf(stderr, "kernel_launch: unexpected shapes (n_in %d out %d ws %zu)\n", n_in, out_size, ws_size); grid = -1; return; }
        int dev = 0, cus = 0, per_cu = 0;
        if (hipGetDevice(&dev) != hipSuccess || hipDeviceGetAttribute(&cus, hipDeviceAttributeMultiprocessorCount, dev) != hipSuccess) { grid = -1; return; }
        if (hipFuncSetAttribute((const void*)mk_fwd, hipFuncAttributeMaxDynamicSharedMemorySize, LDS_BYTES) != hipSuccess) { fprintf(stderr, "kernel_launch: hipFuncSetAttribute failed\n"); grid = -1; return; }
        if (hipOccupancyMaxActiveBlocksPerMultiprocessor(&per_cu, (const void*)mk_fwd, NWAVES * 64, LDS_BYTES) != hipSuccess || per_cu < 1) fprintf(stderr, "kernel_launch: occupancy query says %d\n", per_cu);
        (void)hipGetLastError();
        grid = cus;
    }
    if (grid < 0) return;
    (void)hipMemsetAsync((char*)d_ws + WS_CTL, 0, CTL_ZERO_BYTES, stream);
    Args a{};
    for (int i = 0; i < N_IN; ++i) a.in[i] = (const float*)d_in[i];
    a.out = (float*)d_out; a.ws = (unsigned char*)d_ws;
#ifdef PREFIX_K
#ifndef PREFIX_REP
#define PREFIX_REP 1
#endif
    a.ph_lo = 0; a.ph_hi = PREFIX_K;
    for (int pr_ = 0; pr_ < PREFIX_REP; ++pr_) {
        hipLaunchKernelGGL(mk_fwd, dim3(grid), dim3(NWAVES * 64), LDS_BYTES, stream, a);
        (void)hipMemsetAsync((char*)d_ws + WS_CTL, 0, CTL_ZERO_BYTES, stream);
    }
#endif
    a.ph_lo = 0; a.ph_hi = NPHASES;
    hipLaunchKernelGGL(mk_fwd, dim3(grid), dim3(NWAVES * 64), LDS_BYTES, stream, a);
}
```

```cpp
#include <hip/hip_runtime.h>
#include <cstdio>
#include <cstdint>

namespace pg8 {
#define PG8_LAS __attribute__((address_space(3)))

typedef unsigned short bf16_t;
typedef short bf16x8 __attribute__((ext_vector_type(8)));
typedef float f32x4 __attribute__((ext_vector_type(4)));
typedef unsigned u32x4 __attribute__((ext_vector_type(4)));
constexpr int BM = 256, BK = 64, HALF = 128, HTB = HALF * BK * 2  , STAGE_BYTES = 8 * HTB, NXCD = 8, WGM = 8;

__host__ __device__ __forceinline__ int lds_byte(int r, int c) { const int st = (r >> 4) * 2 + (c >> 5), rr = r & 15, cc = c & 31, ob = rr * 64 + cc * 2; return st * 1024 + (ob ^ (((ob >> 9) & 1) << 5)); }
__host__ __device__ __forceinline__ void stage_rc(int b, int& R, int& C) { const int st = b / 1024, sb = b % 1024, swz = sb ^ (((sb >> 9) & 1) << 5); R = (st >> 1) * 16 + swz / 64; C = (st & 1) * 32 + (swz % 64) / 2; }
__host__ __device__ __forceinline__ int perm32(int rho) { const int n = rho >> 4, i = rho & 15; return 8 * (i >> 2) + 4 * n + (i & 3); }

struct Unit { int pm, pn; };
struct Gemm { const bf16_t* A; const bf16_t* Bt; int M, N, K; };

struct StaticOrder {
    int nM, nN, nwg, G, c;
    __host__ __device__ __forceinline__ void init(int M, int N, int G_, int c_) { nM = M / BM; nN = N / BM; nwg = nM * nN; G = G_; c = c_; }
    __host__ __device__ __forceinline__ bool next(int i, Unit& u) const {
        const long L = (long)i * G + c; if (L >= nwg) return false;
        int wgid = (int)L; { const int q = nwg / NXCD, r = nwg % NXCD, xcd = wgid % NXCD, off = wgid / NXCD; wgid = (xcd < r ? xcd * (q + 1) : r * (q + 1) + (xcd - r) * q) + off; }
        const int nig = WGM * nN, gid = wgid / nig, fm = gid * WGM, gsz = (nM - fm) < WGM ? (nM - fm) : WGM;
        u.pm = fm + ((wgid % nig) % gsz); u.pn = (wgid % nig) / gsz; return true;
    }
    __device__ __forceinline__ void a_ready(const Unit&) const {}
    __device__ __forceinline__ void done(const Unit&) const {}
};


__device__ __forceinline__ unsigned cvt_pk_bf16(float lo, float hi) { unsigned r; asm volatile("v_cvt_pk_bf16_f32 %0, %1, %2" : "=v"(r) : "v"(lo), "v"(hi)); return r; }

template <class Epi, class Sched, bool ALIGN_EPI = false, bool SP2 = false>
__device__ __forceinline__ void gemm_phase(PG8_LAS unsigned char* lds, const Gemm g, const Sched& S, const Epi& E) {
    int tid_ = threadIdx.x; asm volatile("" : "+v"(tid_)); const int tid = tid_, wid = __builtin_amdgcn_readfirstlane(tid >> 6), lane = tid & 63, wr = wid >> 2, wc = wid & 3, fr = lane & 15, fq = lane >> 4;
    const int K = g.K, nt = K / BK;
    unsigned voffA[2], voffB[2];
#pragma unroll
    for (int i = 0; i < 2; ++i) { int R, C; stage_rc(tid * 16 + i * 8192, R, C); const int Rb = Epi::PERM ? ((R & ~31) + perm32(R & 31)) : R;
        voffA[i] = (unsigned)(R * K + C) * 2u; voffB[i] = (unsigned)(Rb * K + C) * 2u; }
    const size_t kstep = (size_t)(BK * 2);
    const size_t hstep = (size_t)HALF * K * 2;
    const size_t tstep = 2 * hstep;
    const unsigned ldsw = (unsigned)wid * 1024u;
    const int aoff = lds_byte(wr * 64 + fr, fq * 8), boff = lds_byte(wc * 32 + fr, fq * 8);
#define PG8_SA(b, h) (((b) * 2 + (h)) * HTB)
#define PG8_SB(b, h) ((4 + (b) * 2 + (h)) * HTB)
#define PG8_STAGE(bufoff, gbase, voff) do { _Pragma("unroll") for (int _i = 0; _i < 2; ++_i) \
        __builtin_amdgcn_global_load_lds((const unsigned*)((const char*)(gbase) + (voff)[_i]), (PG8_LAS unsigned*)(lds + (bufoff) + ldsw + _i * 8192), 16, 0, 0); } while (0)
#define PG8_STAGE_A(bufoff, gbase, voff) do { _Pragma("unroll") for (int _i = 0; _i < 2; ++_i) \
        __builtin_amdgcn_global_load_lds((const unsigned*)((const char*)(gbase) + (voff)[_i]), (PG8_LAS unsigned*)(lds + (bufoff) + ldsw + _i * 8192), 16, 0, Epi::AUX_A); } while (0)
#define PG8_LDA(dst, b, h) do { _Pragma("unroll") for (int m = 0; m < 4; ++m) _Pragma("unroll") for (int k = 0; k < 2; ++k) dst[m][k] = *(const PG8_LAS bf16x8*)(lds + PG8_SA(b, h) + aoff + m * 2048 + k * 1024); } while (0)
#define PG8_LDB(dst, b, h) do { _Pragma("unroll") for (int n = 0; n < 2; ++n) _Pragma("unroll") for (int k = 0; k < 2; ++k) dst[n][k] = *(const PG8_LAS bf16x8*)(lds + PG8_SB(b, h) + boff + n * 2048 + k * 1024); } while (0)
#define PG8_MMA(ai, bj, At, Bt) do { __builtin_amdgcn_s_setprio(1); _Pragma("unroll") for (int m = 0; m < 4; ++m) _Pragma("unroll") for (int n = 0; n < 2; ++n) _Pragma("unroll") for (int k = 0; k < 2; ++k) \
        acc[ai][bj][m][n] = __builtin_amdgcn_mfma_f32_16x16x32_bf16(Bt[n][k], At[m][k], acc[ai][bj][m][n], 0, 0, 0); __builtin_amdgcn_s_setprio(0); } while (0)
#define PG8_WAIT_V(n) asm volatile("s_waitcnt vmcnt(" #n ")" ::: "memory")
#define PG8_WAIT_L(n) asm volatile("s_waitcnt lgkmcnt(" #n ")" ::: "memory")
#define PG8_BAR __builtin_amdgcn_s_barrier()
#define PG8_SCHED __builtin_amdgcn_sched_barrier(0)
    Unit cur, nxt; int ui = 0;
    if (!S.next(0, cur)) return;
    f32x4 acc[2][2][4][2];
#pragma unroll
    for (int a = 0; a < 2; ++a)
#pragma unroll
        for (int b = 0; b < 2; ++b)
#pragma unroll
            for (int m = 0; m < 4; ++m)
#pragma unroll
                for (int n = 0; n < 2; ++n) acc[a][b][m][n] = (f32x4){0.f, 0.f, 0.f, 0.f};
    bf16x8 At[4][2], B0[2][2], B1[2][2];
    const char* cA = (const char*)g.A + (size_t)cur.pm * tstep; const char* cB = (const char*)g.Bt + (size_t)cur.pn * tstep;
    S.a_ready(cur);
    if constexpr (SP2) {
        PG8_STAGE(PG8_SB(0, 0), cB, voffB); PG8_STAGE(PG8_SB(0, 1), cB + hstep, voffB); PG8_STAGE_A(PG8_SA(0, 0), cA, voffA); PG8_STAGE_A(PG8_SA(0, 1), cA + hstep, voffA);
        if (wr == 1) PG8_BAR;
        PG8_WAIT_V(2); PG8_BAR;
        PG8_STAGE(PG8_SB(1, 0), cB + kstep, voffB); PG8_STAGE_A(PG8_SA(1, 0), cA + kstep, voffA); PG8_STAGE(PG8_SB(1, 1), cB + hstep + kstep, voffB);
        PG8_WAIT_V(6); PG8_BAR;
    } else {
        PG8_STAGE(PG8_SB(0, 0), cB, voffB); PG8_STAGE_A(PG8_SA(0, 0), cA, voffA); PG8_STAGE(PG8_SB(0, 1), cB + hstep, voffB); PG8_STAGE_A(PG8_SA(0, 1), cA + hstep, voffA);
        if (wr == 1) PG8_BAR;
        PG8_WAIT_V(4); PG8_BAR;
        PG8_STAGE(PG8_SB(1, 0), cB + kstep, voffB); PG8_STAGE_A(PG8_SA(1, 0), cA + kstep, voffA); PG8_STAGE(PG8_SB(1, 1), cB + hstep + kstep, voffB);
        PG8_WAIT_V(6); PG8_BAR;
    }
    for (;;) {
        const bool has_next = S.next(ui + 1, nxt);
        const char* nA = has_next ? (const char*)g.A + (size_t)nxt.pm * tstep : cA; const char* nB = has_next ? (const char*)g.Bt + (size_t)nxt.pn * tstep : cB;
        for (int t = 0; t < nt; t += 2) {
            const bool last = (t == nt - 2);
            const char* a1 = cA + (size_t)(t + 1) * kstep;
            const char* a2 = last ? nA : cA + (size_t)(t + 2) * kstep; const char* b2 = last ? nB : cB + (size_t)(t + 2) * kstep;
            const char* a3 = a2 + kstep; const char* b3 = b2 + kstep;
            if (last && has_next) S.a_ready(nxt);
            if constexpr (SP2) {
            PG8_LDB(B0, 0, 0); PG8_LDB(B1, 0, 1); PG8_SCHED; PG8_LDA(At, 0, 0); PG8_STAGE_A(PG8_SA(1, 1), a1 + hstep, voffA);
            PG8_WAIT_V(8); PG8_WAIT_L(0); PG8_BAR; PG8_MMA(0, 0, At, B0); PG8_MMA(0, 1, At, B1); PG8_BAR; PG8_SCHED;
            PG8_LDA(At, 0, 1); PG8_STAGE(PG8_SB(0, 0), b2, voffB); PG8_STAGE(PG8_SB(0, 1), b2 + hstep, voffB); PG8_STAGE_A(PG8_SA(0, 0), a2, voffA);
            PG8_WAIT_V(8); PG8_WAIT_L(0); PG8_BAR; PG8_MMA(1, 0, At, B0); PG8_MMA(1, 1, At, B1); PG8_BAR; PG8_SCHED;
            PG8_LDB(B0, 1, 0); PG8_LDB(B1, 1, 1); PG8_SCHED; PG8_LDA(At, 1, 0); PG8_STAGE_A(PG8_SA(0, 1), a2 + hstep, voffA);
            PG8_WAIT_V(8); PG8_WAIT_L(0); PG8_BAR; PG8_MMA(0, 0, At, B0); PG8_MMA(0, 1, At, B1); PG8_BAR; PG8_SCHED;
            PG8_LDA(At, 1, 1); PG8_STAGE(PG8_SB(1, 0), b3, voffB); PG8_STAGE(PG8_SB(1, 1), b3 + hstep, voffB); PG8_STAGE_A(PG8_SA(1, 0), a3, voffA);
            PG8_WAIT_V(8); PG8_WAIT_L(0); PG8_BAR; PG8_MMA(1, 0, At, B0); PG8_MMA(1, 1, At, B1); PG8_BAR; PG8_SCHED;
            } else {
            PG8_LDB(B0, 0, 0); PG8_SCHED; PG8_LDA(At, 0, 0); PG8_STAGE_A(PG8_SA(1, 1), a1 + hstep, voffA);
            PG8_WAIT_L(8); PG8_BAR; PG8_WAIT_L(0); PG8_MMA(0, 0, At, B0); PG8_BAR; PG8_SCHED;
            PG8_LDB(B1, 0, 1); PG8_STAGE(PG8_SB(0, 0), b2, voffB);
            PG8_BAR; PG8_WAIT_L(0); PG8_MMA(0, 1, At, B1); PG8_BAR;
            PG8_LDA(At, 0, 1); PG8_STAGE_A(PG8_SA(0, 0), a2, voffA);
            PG8_BAR; PG8_WAIT_L(0); PG8_MMA(1, 0, At, B0); PG8_BAR; PG8_SCHED;
            PG8_STAGE(PG8_SB(0, 1), b2 + hstep, voffB);
            PG8_WAIT_V(6); PG8_BAR; PG8_MMA(1, 1, At, B1); PG8_BAR;
            PG8_LDB(B0, 1, 0); PG8_SCHED; PG8_LDA(At, 1, 0); PG8_STAGE_A(PG8_SA(0, 1), a2 + hstep, voffA);
            PG8_WAIT_L(8); PG8_BAR; PG8_WAIT_L(0); PG8_MMA(0, 0, At, B0); PG8_BAR; PG8_SCHED;
            PG8_LDB(B1, 1, 1); PG8_STAGE(PG8_SB(1, 0), b3, voffB);
            PG8_BAR; PG8_WAIT_L(0); PG8_MMA(0, 1, At, B1); PG8_BAR;
            PG8_LDA(At, 1, 1); PG8_STAGE_A(PG8_SA(1, 0), a3, voffA);
            PG8_BAR; PG8_WAIT_L(0); PG8_MMA(1, 0, At, B0); PG8_BAR; PG8_SCHED;
            PG8_STAGE(PG8_SB(1, 1), b3 + hstep, voffB);
            PG8_WAIT_V(6); PG8_BAR; PG8_MMA(1, 1, At, B1); PG8_BAR;
            }
            if constexpr (Epi::KHOOK) { if ((((t + 2) & 3) == 0) && !last) E.khook(acc, (t + 2) / 4 - 1, wr, fr); }
        }
        if constexpr (ALIGN_EPI) { if (wr == 0) PG8_BAR; }
        if constexpr (!Epi::AFTER_DRAIN) { E(acc, cur, wr, wc, fr, fq); S.done(cur); }
        if (!has_next) break;
#pragma unroll
        for (int a = 0; a < 2; ++a)
#pragma unroll
            for (int b = 0; b < 2; ++b)
#pragma unroll
                for (int m = 0; m < 4; ++m)
#pragma unroll
                    for (int n = 0; n < 2; ++n) acc[a][b][m][n] = (f32x4){0.f, 0.f, 0.f, 0.f};
        cur = nxt; cA = nA; cB = nB; ++ui;
        if constexpr (ALIGN_EPI) { if (wr == 1) PG8_BAR; }
    }
    PG8_WAIT_V(0);
    if constexpr (!ALIGN_EPI) { if (wr == 0) PG8_BAR; }
    PG8_BAR;
    if constexpr (Epi::AFTER_DRAIN) { E.fused(acc, cur, wr, wc, fr, fq, lds, wid, lane); S.done(cur); }
#undef PG8_SA
#undef PG8_SB
#undef PG8_STAGE
#undef PG8_STAGE_A
#undef PG8_LDA
#undef PG8_LDB
#undef PG8_MMA
#undef PG8_WAIT_V
#undef PG8_WAIT_L
#undef PG8_BAR
#undef PG8_SCHED
}
}

#define GAS __attribute__((address_space(1)))
#define LAS __attribute__((address_space(3)))
typedef unsigned short bf16;
typedef unsigned v4u __attribute__((ext_vector_type(4)));
typedef float f32x4 __attribute__((ext_vector_type(4)));
typedef short bf16x8 __attribute__((ext_vector_type(8)));
typedef GAS unsigned gu32;
typedef GAS unsigned long long gu64;
#define RLX_AGENT __ATOMIC_RELAXED, __HIP_MEMORY_SCOPE_AGENT
#define LDS_WAIT() asm volatile("s_waitcnt lgkmcnt(0)" ::: "memory")
#define VM_WAIT() asm volatile("s_waitcnt vmcnt(0)" ::: "memory")
__device__ __forceinline__ unsigned long long rt() { return __builtin_amdgcn_s_memrealtime(); }
__device__ __forceinline__ unsigned f2bf(float f) { unsigned u = __builtin_bit_cast(unsigned, f); return (u + 0x7fffu + ((u >> 16) & 1u)) >> 16; }
__device__ __forceinline__ unsigned pk2(float lo, float hi) { return f2bf(lo) | (f2bf(hi) << 16); }

#define XB_TMO      128
#define XB_XCNT(j)  (256  + 64 * (j))
#define XB_XSUB(j)  (1280 + 64 * (j))
#define XB_XGEN(j)  (2304 + 64 * (j))
#define XB_TOP      3328
#define XB_TOPGEN   3392
#define XCD_BAR_WORDS 3456
#define XB_SPIN_CAP (1u << 18)

__device__ __forceinline__ unsigned xb_ld(unsigned* p)              { return __hip_atomic_load(p, __ATOMIC_RELAXED, __HIP_MEMORY_SCOPE_AGENT); }
__device__ __forceinline__ unsigned xb_add(unsigned* p, unsigned v) { return __hip_atomic_fetch_add(p, v, __ATOMIC_RELAXED, __HIP_MEMORY_SCOPE_AGENT); }
__device__ __forceinline__ unsigned xb_xcc_id() { return (unsigned)__builtin_amdgcn_s_getreg((3 << 11) | 20) & 0xFu; }
#define XB_SPIN(cond, bar) do { unsigned _sp = 0; while (cond) { __builtin_amdgcn_s_sleep(1); \
    if ((++_sp & 255u) == 0u) { if (xb_ld(&(bar)[XB_TMO])) break; if (_sp > XB_SPIN_CAP) { atomicAdd(&(bar)[XB_TMO], 1u); break; } } } } while (0)

struct XcdBarrier {
    unsigned* bar; unsigned x;
    volatile LAS unsigned* st;
};

__device__ __forceinline__ XcdBarrier xcd_barrier_post(unsigned* bar, volatile LAS unsigned* st) {
    XcdBarrier b; b.bar = bar; b.x = xb_xcc_id(); b.st = st;
    if (threadIdx.x == 0) (void)xb_add(&bar[XB_XCNT(b.x)], 1u);
    return b;
}
__device__ __forceinline__ void xcd_barrier_complete(unsigned* bar, unsigned x, unsigned& nloc, unsigned& nx) {
    const unsigned G = gridDim.x * gridDim.y * gridDim.z;
    unsigned sum, cnt, mine, sp = 0u;
    for (;;) {
        sum = 0u; cnt = 0u; mine = 0u;
#pragma unroll
        for (unsigned j = 0; j < 16; ++j) { const unsigned c = xb_ld(&bar[XB_XCNT(j)]); sum += c; cnt += (c > 0u) ? 1u : 0u; mine = (j == x) ? c : mine; }
        if (sum == G) break;
        __builtin_amdgcn_s_sleep(1);
        if ((++sp & 255u) == 0u) { if (xb_ld(&bar[XB_TMO])) break; if (sp > XB_SPIN_CAP) { atomicAdd(&bar[XB_TMO], 1u); break; } }
    }
    nloc = mine > 0u ? mine : 1u; nx = cnt > 0u ? cnt : 1u;
}

__device__ __forceinline__ void xcd_barrier(const XcdBarrier& b) {
    asm volatile("s_waitcnt vmcnt(0)" ::: "memory");
    __syncthreads();
    if (threadIdx.x == 0) {
        unsigned* bar = b.bar;
        __builtin_amdgcn_s_waitcnt(0);
        unsigned nloc = b.st[0], nx = b.st[1];
        if (nloc == 0u) { xcd_barrier_complete(bar, b.x, nloc, nx); b.st[0] = nloc; b.st[1] = nx; }
        const unsigned old = xb_add(&bar[XB_XSUB(b.x)], 1u);
        const unsigned gen = old / nloc;
        if (old + 1u == (gen + 1u) * nloc) {
            __builtin_amdgcn_fence(__ATOMIC_RELEASE, "agent");
            asm volatile("s_waitcnt vmcnt(0)" ::: "memory");
            const unsigned og = xb_add(&bar[XB_TOP], 1u);
            const unsigned tg = og / nx;
            if (og + 1u == (tg + 1u) * nx) xb_add(&bar[XB_TOPGEN], 1u);
            else XB_SPIN(xb_ld(&bar[XB_TOPGEN]) == tg, bar);
            __builtin_amdgcn_fence(__ATOMIC_ACQUIRE, "agent");
            xb_add(&bar[XB_XGEN(b.x)], 1u);
            asm volatile("s_waitcnt vmcnt(0)" ::: "memory");
        } else {
            XB_SPIN(xb_ld(&bar[XB_XGEN(b.x)]) == gen, bar);
            __builtin_amdgcn_fence(__ATOMIC_ACQUIRE, "agent");
            asm volatile("s_waitcnt vmcnt(0)" ::: "memory");
        }
    }
    __syncthreads();
}


#ifndef REP_MASK
#define REP_MASK 0
#endif
#define REPB(bit) (((REP_MASK) >> (bit)) & 1)
#ifndef REP_N
#define REP_N 2
#endif
constexpr int NWAVES = 8;
constexpr int NB = 4, SEQ = 4096, M = NB * SEQ, D = 1024, FF = 2816, NPROJ = 2480, NPROJP = 2560, DEPTH = 2;
constexpr float EPS = 1e-6f;
constexpr float LOG2_10000 = 13.287712379549449f;

enum { I_X = 0, I_F1N, I_F1G, I_F1U, I_F1D, I_MIXN, I_WIN, I_CONVW, I_CONVB, I_DTB, I_ALOG, I_SSDD, I_SSDN, I_SWAQN, I_SWAKN, I_SINK, I_SWAON,
       I_MQLN, I_WUQ, I_MKVN, I_WUKV, I_MQN, I_MKN, I_MON, I_WOUT, I_F2N, I_F2G, I_F2U, I_F2D, N_IN };

constexpr size_t MiB = 1u << 20;
constexpr size_t WS_CTL = 0, CTL_ZERO_BYTES = 64 * 1024;
constexpr size_t WS_CSSWA = 1 * MiB;
constexpr size_t WS_CSMLA = 2 * MiB;
constexpr size_t WS_SS = 3 * MiB;
constexpr size_t WS_WGU1 = 4 * MiB, WS_WD1 = 15 * MiB, WS_WIN = WS_WD1 + 5 * MiB + MiB / 2, WS_WOUT = WS_WIN + 5 * MiB, WS_WGU2 = WS_WOUT + 2 * MiB, WS_WD2 = WS_WGU2 + 11 * MiB,
                 WS_WUQ = 44 * MiB, WS_WUKV = 44 * MiB + MiB / 4;
static_assert(WS_WD2 + 5 * MiB + MiB / 2 == 44 * MiB, "weights map");
constexpr size_t WS_XB = 45 * MiB;
constexpr size_t WS_OV = 77 * MiB;
constexpr size_t WS_HB = WS_OV;
constexpr size_t WS_PROJ = WS_OV;
constexpr size_t WS_Z = WS_PROJ, WS_XBCR = WS_PROJ + 16 * MiB, WS_SWAQ = WS_PROJ + 48 * MiB, WS_SWAKV = WS_PROJ + 56 * MiB, WS_MLAQR = WS_PROJ + 64 * MiB, WS_MLAM = WS_PROJ + 72 * MiB;
constexpr size_t WS_Y = WS_XBCR;
constexpr size_t WS_DTRAW = WS_OV + 80 * MiB;
constexpr size_t WS_XBCC = WS_OV + 81 * MiB;
constexpr size_t WS_DTC = WS_OV + 113 * MiB;
constexpr size_t WS_SWAVT = WS_OV + 115 * MiB;
constexpr size_t WS_MLAQ = WS_OV + 119 * MiB;
constexpr size_t WS_MLAK = WS_OV + 131 * MiB;
constexpr size_t WS_MLAVT = WS_OV + 143 * MiB;
constexpr size_t WS_SSQ = WS_OV + 151 * MiB;
constexpr size_t WS_SIN = WS_OV + 152 * MiB;
constexpr size_t WS_END = WS_OV + 168 * MiB;
constexpr size_t WS_YTMP = WS_XB;
static_assert(WS_END <= 256 * MiB, "ws map");

constexpr int CW_BAR = 4096, CW_SP = 8192  ;
constexpr int RING_BYTES = 131072, LDS_BYTES = 163840, LDSCTL_OFF = LDS_BYTES - 1024, MISC_OFF = LDSCTL_OFF + 64, WTAB_OFF = LDSCTL_OFF - 256  ,
              TAB_OFF = WTAB_OFF - 4096  , RTAB_OFF = TAB_OFF - 8192  ;
static_assert(RTAB_OFF >= RING_BYTES, "LDS map");

struct Args { const float* in[N_IN]; float* out; unsigned char* ws; int ph_lo, ph_hi; };
static_assert(sizeof(Args) == N_IN * 8 + 8 + 8 + 8, "Args has no padding");
__device__ __forceinline__ const float* ain(int i) { asm volatile("" : "+s"(i)); return ((const float* const*)__builtin_amdgcn_kernarg_segment_ptr())[i]; }
__device__ __forceinline__ float* aout() { int i = N_IN; asm volatile("" : "+s"(i)); return ((float* const*)__builtin_amdgcn_kernarg_segment_ptr())[i]; }
__device__ __forceinline__ unsigned char* aws() { int i = N_IN + 1; asm volatile("" : "+s"(i)); return ((unsigned char* const*)__builtin_amdgcn_kernarg_segment_ptr())[i]; }

__device__ __forceinline__ float bf2f(unsigned short b) { return __uint_as_float((unsigned)b << 16); }
__device__ __forceinline__ float bflo(unsigned w) { return __uint_as_float(w << 16); }
__device__ __forceinline__ float bfhi(unsigned w) { return __uint_as_float(w & 0xffff0000u); }
__device__ __forceinline__ float wave_sum(float v) {
#pragma unroll
    for (int o = 1; o < 64; o <<= 1) v += __shfl_xor(v, o);
    return v;
}
__device__ __forceinline__ float silu_f(float g) { return g * __builtin_amdgcn_rcpf(1.0f + __expf(-g)); }
__device__ __forceinline__ float softplus_f(float x) { return fmaxf(x, 0.f) + log1pf(expf(-fabsf(x))); }

typedef pg8::f32x4 f4;
typedef pg8::u32x4 u4;
typedef short v4i16 __attribute__((ext_vector_type(4)));
typedef unsigned v2u __attribute__((ext_vector_type(2)));
typedef __amdgpu_buffer_rsrc_t rsrc_t;
__device__ __forceinline__ rsrc_t mk_rsrc(const void* base, unsigned bytes) { return __builtin_amdgcn_make_buffer_rsrc(const_cast<void*>(base), 0, (int)bytes, 0x00020000); }
__device__ __forceinline__ void st16_wt(rsrc_t r, size_t byte_off, v4u v) { __builtin_amdgcn_raw_buffer_store_b128(v, r, (int)byte_off, 0, 16); }
__device__ __forceinline__ void st8_wt(rsrc_t r, size_t byte_off, v2u v) { __builtin_amdgcn_raw_buffer_store_b64(v, r, (int)byte_off, 0, 16); }
__device__ __forceinline__ void load_rstd(const float* ss, int row0, int fq, float (&rs)[2][4]) {
#pragma unroll
    for (int ai = 0; ai < 2; ++ai)
#pragma unroll
        for (int m = 0; m < 4; ++m) {
            const f4 v = *(const f4*)(ss + (size_t)(row0 + ai * 128 + m * 16) * 16 + 4 * fq);
            float s = (v[0] + v[1]) + (v[2] + v[3]); s += __shfl_xor(s, 16); s += __shfl_xor(s, 32);
            rs[ai][m] = rsqrtf(s * (1.0f / D) + EPS);
        }
}
template <class Sched> __device__ __forceinline__ bool fill_rstd_tab(PG8_LAS float* rt, const Sched& S, const float* ss, int tid) {
    pg8::Unit u; bool ok = true; int grp = -1;
    for (int i = 0; S.next(i, u); ++i) { if (grp < 0) grp = u.pm >> 3; ok = ok && ((u.pm >> 3) == grp); }
    if (ok) for (int i = 0; S.next(i, u); ++i) if (tid < 256) {
        const float* p = ss + ((size_t)u.pm * 256 + tid) * 16; const f4 a = *(const f4*)p, b = *(const f4*)(p + 4), c = *(const f4*)(p + 8), d = *(const f4*)(p + 12);
        const float s = ((a[0] + a[1]) + (a[2] + a[3])) + ((b[0] + b[1]) + (b[2] + b[3])) + ((c[0] + c[1]) + (c[2] + c[3])) + ((d[0] + d[1]) + (d[2] + d[3]));
        rt[(u.pm & 7) * 256 + tid] = rsqrtf(s * (1.0f / D) + EPS); }
    __syncthreads();
    return ok;
}
__device__ __forceinline__ void get_rstd(const PG8_LAS float* rt, bool use_tab, const float* ss, const pg8::Unit& u, int wr, int fr, int fq, float (&rs)[2][4]) {
    if (use_tab) {
#pragma unroll
        for (int ai = 0; ai < 2; ++ai)
#pragma unroll
            for (int m = 0; m < 4; ++m) rs[ai][m] = rt[(u.pm & 7) * 256 + ai * 128 + wr * 64 + m * 16 + fr];
    } else load_rstd(ss, u.pm * 256 + wr * 64 + fr, fq, rs);
}
struct EpiGU {
    static constexpr bool PERM = false, AFTER_DRAIN = false, KHOOK = false; static constexpr int AUX_A = 0;
    pg8::bf16_t* H; const float* ss; const PG8_LAS float* rt; bool use_tab;
    __device__ __forceinline__ void operator()(const f4 (&acc)[2][2][4][2], const pg8::Unit& u, int wr, int wc, int fr, int fq) const {
        const int row0 = u.pm * 256 + wr * 64 + fr; float rs[2][4]; get_rstd(rt, use_tab, ss, u, wr, fr, fq, rs);
        const int col = u.pn * 128 + wc * 32 + fq * 8; const rsrc_t rH = mk_rsrc(H, (unsigned)((size_t)M * FF * 2));
#pragma unroll
        for (int ai = 0; ai < 2; ++ai)
#pragma unroll
            for (int m = 0; m < 4; ++m) {
                const float r = rs[ai][m], rl = r * -1.4426950408889634f, r2 = r * r; float h[8];
#pragma unroll
                for (int bj = 0; bj < 2; ++bj) {
                    const f4 g = acc[ai][bj][m][0], gu = g * acc[ai][bj][m][1], ex = g * rl;
                    f4 t; t[0] = __builtin_amdgcn_exp2f(ex[0]); t[1] = __builtin_amdgcn_exp2f(ex[1]); t[2] = __builtin_amdgcn_exp2f(ex[2]); t[3] = __builtin_amdgcn_exp2f(ex[3]);
                    t = t + 1.0f;
                    f4 d; d[0] = __builtin_amdgcn_rcpf(t[0]); d[1] = __builtin_amdgcn_rcpf(t[1]); d[2] = __builtin_amdgcn_rcpf(t[2]); d[3] = __builtin_amdgcn_rcpf(t[3]);
                    const f4 hv = gu * (d * r2);
                    h[bj * 4 + 0] = hv[0]; h[bj * 4 + 1] = hv[1]; h[bj * 4 + 2] = hv[2]; h[bj * 4 + 3] = hv[3];
                }
                u4 w; w.x = pg8::cvt_pk_bf16(h[0], h[1]); w.y = pg8::cvt_pk_bf16(h[2], h[3]); w.z = pg8::cvt_pk_bf16(h[4], h[5]); w.w = pg8::cvt_pk_bf16(h[6], h[7]);
                st16_wt(rH, ((size_t)(row0 + ai * 128 + m * 16) * FF + col) * 2, (v4u){w.x, w.y, w.z, w.w});
            }
    }
    __device__ __forceinline__ void khook(f4 (&)[2][2][4][2], int, int, int) const {}
};
#ifndef XB_WT
#define XB_WT 0
#endif
#ifndef DOWN_AUX_A
#define DOWN_AUX_A 0
#endif
template <int MODE, bool FINAL> struct EpiDown {
    static constexpr bool PERM = true, AFTER_DRAIN = false, KHOOK = (MODE == 1); static constexpr int AUX_A = DOWN_AUX_A;
    float* xout; pg8::bf16_t* xb; float* ss; float scale; const PG8_LAS float* tab;
    __device__ __forceinline__ void operator()(const f4 (&acc)[2][2][4][2], const pg8::Unit& u, int wr, int wc, int fr, int fq) const {
#if XB_WT
        const rsrc_t rB = mk_rsrc(xb, (unsigned)((size_t)M * D * 2));
#endif
        v4u xa[2][4][2];
#pragma unroll
        for (int ai = 0; ai < 2; ++ai)
#pragma unroll
            for (int m = 0; m < 4; ++m)
#pragma unroll
                for (int bj = 0; bj < 2; ++bj) xa[ai][m][bj] = *(const v4u*)(xb + (size_t)(u.pm * 256 + ai * 128 + wr * 64 + m * 16 + fr) * D + u.pn * 256 + bj * 128 + wc * 32 + fq * 8);
#pragma unroll
        for (int ai = 0; ai < 2; ++ai) {
            const v4u (&xi)[4][2] = xa[ai];
#pragma unroll
            for (int m = 0; m < 4; ++m) {
                const int lr = ai * 128 + wr * 64 + m * 16 + fr; const size_t row = (size_t)(u.pm * 256 + lr);
                const float sc = MODE == 1 ? tab[lr * 4 + 3] : scale; float sq = 0.f;
#pragma unroll
                for (int bj = 0; bj < 2; ++bj) {
                    const int col = u.pn * 256 + bj * 128 + wc * 32 + fq * 8; const v4u r = xi[m][bj];
                    const f4 r0 = (f4){bflo(r[0]), bfhi(r[0]), bflo(r[1]), bfhi(r[1])}, r1 = (f4){bflo(r[2]), bfhi(r[2]), bflo(r[3]), bfhi(r[3])};
                    const f4 o0 = r0 + acc[ai][bj][m][0] * sc, o1 = r1 + acc[ai][bj][m][1] * sc;
                    if (FINAL) { *(f4*)(xout + row * D + col) = o0; *(f4*)(xout + row * D + col + 4) = o1; }
                    else {
                        const v4u w = (v4u){pg8::cvt_pk_bf16(o0[0], o0[1]), pg8::cvt_pk_bf16(o0[2], o0[3]), pg8::cvt_pk_bf16(o1[0], o1[1]), pg8::cvt_pk_bf16(o1[2], o1[3])};
#if XB_WT
                        st16_wt(rB, (row * D + col) * 2, w);
#else
                        *(v4u*)(xb + row * D + col) = w;
#endif
                        const f4 q0 = (f4){bflo(w[0]), bfhi(w[0]), bflo(w[1]), bfhi(w[1])}, q1 = (f4){bflo(w[2]), bfhi(w[2]), bflo(w[3]), bfhi(w[3])};
                        sq += ((q0[0] * q0[0] + q0[1] * q0[1]) + (q0[2] * q0[2] + q0[3] * q0[3])) + ((q1[0] * q1[0] + q1[1] * q1[1]) + (q1[2] * q1[2] + q1[3] * q1[3]));
                    }
                }
                if (!FINAL) { sq += __shfl_xor(sq, 16); sq += __shfl_xor(sq, 32);
                    if (fq == 0) ss[row * 16 + u.pn * 4 + wc] = sq; }
            }
        }
    }
    __device__ __forceinline__ void khook(f4 (&acc)[2][2][4][2], int g, int wr, int fr) const {
#pragma unroll
        for (int ai = 0; ai < 2; ++ai)
#pragma unroll
            for (int m = 0; m < 4; ++m) { const float r = tab[(ai * 128 + wr * 64 + m * 16 + fr) * 4 + g];
#pragma unroll
                for (int bj = 0; bj < 2; ++bj)
#pragma unroll
                    for (int n = 0; n < 2; ++n) acc[ai][bj][m][n] = acc[ai][bj][m][n] * r; }
    }
};
struct EpiDry {
    static constexpr bool PERM = false, AFTER_DRAIN = false, KHOOK = false; static constexpr int AUX_A = 0;
    __device__ __forceinline__ void operator()(const f4 (&acc)[2][2][4][2], const pg8::Unit&, int, int, int, int) const {
#pragma unroll
        for (int ai = 0; ai < 2; ++ai)
#pragma unroll
            for (int bj = 0; bj < 2; ++bj)
#pragma unroll
                for (int m = 0; m < 4; ++m)
#pragma unroll
                    for (int n = 0; n < 2; ++n) asm volatile("" :: "v"(acc[ai][bj][m][n]));
    }
    __device__ __forceinline__ void khook(f4 (&)[2][2][4][2], int, int, int) const {}
};
struct EpiProj {
    static constexpr bool PERM = true, AFTER_DRAIN = false, KHOOK = false; static constexpr int AUX_A = 0;
    pg8::bf16_t* proj; float* dtraw; const float* ss; const PG8_LAS float* rt; bool use_tab;
    __device__ __forceinline__ void operator()(const f4 (&acc)[2][2][4][2], const pg8::Unit& u, int wr, int wc, int fr, int fq) const {
        const int row0 = u.pm * 256 + wr * 64 + fr; float rs[2][4]; get_rstd(rt, use_tab, ss, u, wr, fr, fq, rs);
        size_t off; int pitch, c0;
        if (u.pn < 2) { off = 0; pitch = 512; c0 = u.pn * 256; } else if (u.pn < 6) { off = (size_t)M * 512; pitch = 1024; c0 = (u.pn - 2) * 256; } else { off = (size_t)M * 1536 + (size_t)(u.pn - 6) * M * 256; pitch = 256; c0 = 0; }
        pg8::bf16_t* base = proj + off + c0 + wc * 32 + fq * 8;
        const bool dtw = (u.pn == 9) && (wc == 1) && (fq < 2);
#pragma unroll
        for (int ai = 0; ai < 2; ++ai)
#pragma unroll
            for (int m = 0; m < 4; ++m) {
                const float r = rs[ai][m]; const size_t row = (size_t)(row0 + ai * 128 + m * 16);
#pragma unroll
                for (int bj = 0; bj < 2; ++bj) {
                    const f4 v0 = acc[ai][bj][m][0] * r, v1 = acc[ai][bj][m][1] * r;
                    u4 w; w.x = pg8::cvt_pk_bf16(v0[0], v0[1]); w.y = pg8::cvt_pk_bf16(v0[2], v0[3]); w.z = pg8::cvt_pk_bf16(v1[0], v1[1]); w.w = pg8::cvt_pk_bf16(v1[2], v1[3]);
                    *(u4*)(base + row * pitch + bj * 128) = w;
                    if (bj == 1 && dtw) { *(f4*)(dtraw + row * 16 + fq * 8) = v0; *(f4*)(dtraw + row * 16 + fq * 8 + 4) = v1; }
                }
            }
    }
    __device__ __forceinline__ void khook(f4 (&)[2][2][4][2], int, int, int) const {}
};

__device__ __forceinline__ int gu_row(int j, int n01) { const int pn = j >> 7, jj = j & 127; return 256 * pn + 128 * ((jj >> 2) & 1) + 32 * (jj >> 5) + 16 * n01 + 4 * ((jj >> 3) & 3) + (jj & 3); }
__device__ __forceinline__ int win_row(int o) { return o < 1536 ? o : (o < 1552 ? 2464 + (o - 1536) : o - 16); }
__device__ __forceinline__ int map_row(int mode, int n) { return mode == 0 ? n : (mode == 1 ? gu_row(n, 0) : (mode == 2 ? gu_row(n, 1) : win_row(n))); }
struct TrItem { const float* W; bf16* WT; const float* ks; int K, N, mode, k0, n0; };
__device__ __forceinline__ TrItem tr_desc(const float* W, int K, int N, bf16* WT, int mode, const float* ks, int item) {
    const int nblk = (N + 63) / 64; TrItem d; d.W = W; d.WT = WT; d.ks = ks; d.K = K; d.N = N; d.mode = mode; d.k0 = 64 * (item / nblk); d.n0 = 64 * (item % nblk); return d;
}
__device__ __forceinline__ void tr_load(const TrItem& d, f32x4 (&v)[16], f32x4 (&sc)[4], int lane) {
    const int r4 = lane >> 4, c4 = lane & 15; const bool nok = d.n0 + 4 * c4 < d.N; const int ncol = nok ? d.n0 + 4 * c4 : 0;
    const float* p = d.W + (size_t)(d.k0 + 16 * r4) * d.N + ncol;
#pragma unroll
    for (int i = 0; i < 16; ++i) { v[i] = __builtin_nontemporal_load((const f32x4*)p); p += d.N; asm volatile("" : "+v"(p)); }
    if (d.ks) {
#pragma unroll
        for (int j = 0; j < 4; ++j) sc[j] = *(const f32x4*)(d.ks + d.k0 + 16 * r4 + 4 * j);
    } else {
#pragma unroll
        for (int j = 0; j < 4; ++j) sc[j] = (f32x4){1.f, 1.f, 1.f, 1.f};
    }
}
__device__ __forceinline__ void tr_finish(const TrItem& d, f32x4 (&v)[16], f32x4 (&sc)[4], LAS unsigned char* scr, int lane) {
    const int r4 = lane >> 4, c4 = lane & 15; const bool nok = d.n0 + 4 * c4 < d.N;
#pragma unroll
    for (int i = 0; i < 16; ++i) { const int k = 16 * r4 + i; f32x4 x = v[i] * sc[i >> 2][i & 3]; if (!nok) x = (f32x4){0.f, 0.f, 0.f, 0.f};
        *(LAS v2u*)(scr + k * 192 + 8 * c4) = (v2u){pg8::cvt_pk_bf16(x.x, x.y), pg8::cvt_pk_bf16(x.z, x.w)}; }
    LDS_WAIT(); asm volatile("" ::: "memory");
    const int hh = lane >> 5, blk = (lane >> 4) & 1, q = (lane & 15) >> 2, p = lane & 3;
#pragma unroll
    for (int c = 0; c < 2; ++c)
#pragma unroll
        for (int k2 = 0; k2 < 4; ++k2) {
            const LAS unsigned char* ad = scr + (16 * k2 + 8 * hh + q) * 192 + (32 * c + 16 * blk + 4 * p) * 2;
            const v4i16 v0 = __builtin_amdgcn_ds_read_tr16_b64_v4i16((LAS v4i16*)ad), v1 = __builtin_amdgcn_ds_read_tr16_b64_v4i16((LAS v4i16*)(ad + 4 * 192));
            const int n = d.n0 + 32 * c + (lane & 31);
            union { v4i16 h[2]; v4u u; } o; o.h[0] = v0; o.h[1] = v1;
            if (n < d.N) *(GAS v4u*)(d.WT + (size_t)map_row(d.mode, n) * d.K + d.k0 + 16 * k2 + 8 * hh) = o.u;
        }
    LDS_WAIT(); asm volatile("" ::: "memory");
}
enum { J_GU1 = 0, J_D1, J_IN, J_UQKV, J_OUT, J_GU2, J_D2 };
#define CONV_LOOP(NITEMS, DESC) do { int it_ = w; if (it_ < (NITEMS)) { TrItem d_ = DESC(it_); f32x4 v_[16], s_[4]; tr_load(d_, v_, s_, lane); \
        for (;;) { const int nx_ = it_ + nw; const bool more_ = nx_ < (NITEMS); TrItem dn_ = d_; f32x4 vn_[16], sn_[4]; if (more_) { dn_ = DESC(nx_); tr_load(dn_, vn_, sn_, lane); } \
            tr_finish(d_, v_, s_, scr, lane); if (!more_) break; d_ = dn_; _Pragma("unroll") for (int i_ = 0; i_ < 16; ++i_) v_[i_] = vn_[i_]; _Pragma("unroll") for (int i_ = 0; i_ < 4; ++i_) s_[i_] = sn_[i_]; it_ = nx_; } } } while (0)
template <int JOB> __device__ __forceinline__ void convert_job(int l, LAS unsigned char* lds, int w_, int nw, int wave, int lane, int off = 0) {
    unsigned char* ws = aws(); LAS unsigned char* scr = lds + wave * 16384; const int w = ((w_ - off) % nw + nw) % nw;
    constexpr int I_GU = 16 * 44, I_DN = 44 * 16, I_IN = 16 * 39, I_OUT = 16 * 16, I_UQ = 4 * 6, I_UKV = 2 * 8;
    if (JOB == J_GU1 || JOB == J_GU2) {
        const float* g = ain(JOB == J_GU1 ? I_F1G : I_F2G) + (size_t)l * D * FF; const float* u = ain(JOB == J_GU1 ? I_F1U : I_F2U) + (size_t)l * D * FF; const float* nrm = ain(JOB == J_GU1 ? I_F1N : I_F2N) + l * D;
        bf16* dst = (bf16*)(ws + (JOB == J_GU1 ? WS_WGU1 : WS_WGU2));
#define DESC_GU(it) ((it) < I_GU ? tr_desc(g, D, FF, dst, 1, nrm, (it)) : tr_desc(u, D, FF, dst, 2, nrm, (it) - I_GU))
        CONV_LOOP(2 * I_GU, DESC_GU);
#undef DESC_GU
    } else if (JOB == J_D1 || JOB == J_D2) {
        const float* d = ain(JOB == J_D1 ? I_F1D : I_F2D) + (size_t)l * FF * D; bf16* dst = (bf16*)(ws + (JOB == J_D1 ? WS_WD1 : WS_WD2));
#define DESC_D(it) tr_desc(d, FF, D, dst, 0, nullptr, (it))
        CONV_LOOP(I_DN, DESC_D);
#undef DESC_D
    } else if (JOB == J_IN) {
        const float* win = ain(I_WIN) + (size_t)l * D * NPROJ; const float* mw = ain(I_MIXN) + l * D;
#define DESC_IN(it) tr_desc(win, D, NPROJ, (bf16*)(ws + WS_WIN), 3, mw, (it))
        CONV_LOOP(I_IN, DESC_IN);
#undef DESC_IN
        for (int it = w; it < 80; it += nw) { GAS v4u* p = (GAS v4u*)((bf16*)(ws + WS_WIN) + (size_t)(NPROJ + it) * D) + lane * 2; p[0] = (v4u){0u, 0u, 0u, 0u}; p[1] = (v4u){0u, 0u, 0u, 0u}; }
    } else if (JOB == J_UQKV) {
        const float* wuq = ain(I_WUQ) + (size_t)l * 256 * 384; const float* wukv = ain(I_WUKV) + (size_t)l * 128 * 512; const float* n1 = ain(I_MQLN) + l * 256; const float* n2 = ain(I_MKVN) + l * 128;
#define DESC_U(it) ((it) < I_UQ ? tr_desc(wuq, 256, 384, (bf16*)(ws + WS_WUQ), 0, n1, (it)) : tr_desc(wukv, 128, 512, (bf16*)(ws + WS_WUKV), 0, n2, (it) - I_UQ))
        CONV_LOOP(I_UQ + I_UKV, DESC_U);
#undef DESC_U
    } else {
        const float* wo = ain(I_WOUT) + (size_t)l * D * D; const float* k0p = ain(I_SSDN) + l * 512; const float* k1p = ain(I_SWAON) + l * 256 - 512; const float* k2p = ain(I_MON) + l * 256 - 768;
#define DESC_O(it) tr_desc(wo, D, D, (bf16*)(ws + WS_WOUT), 0, (64 * ((it) / 16) < 512 ? k0p : (64 * ((it) / 16) < 768 ? k1p : k2p)), (it))
        CONV_LOOP(I_OUT, DESC_O);
#undef DESC_O
    }
}
#define TAIL_WORKER(nwg) const int rem_ = (nwg) % G; const bool tail_ = bx >= rem_; const int tw_ = (bx - rem_) * NWAVES + wave, tnw_ = (G - rem_) * NWAVES;
__device__ __forceinline__ void p0_x_and_tables(int gw, int NGW, int lane, int gtid, int NT) {
    unsigned char* ws = aws(); const float* x = ain(I_X); bf16* xb = (bf16*)(ws + WS_XB); float* ss = (float*)(ws + WS_SS);
    for (int m0 = 4 * gw; m0 < M; m0 += 4 * NGW) {
        f32x4 v[4][4];
#pragma unroll
        for (int r = 0; r < 4; ++r)
#pragma unroll
            for (int j = 0; j < 4; ++j) v[r][j] = ((const GAS f32x4*)(x + (size_t)(m0 + r) * D) + lane)[64 * j];
#pragma unroll
        for (int r = 0; r < 4; ++r) {
            float s = 0.f;
#pragma unroll
            for (int j = 0; j < 4; ++j) s += (v[r][j].x * v[r][j].x + v[r][j].y * v[r][j].y) + (v[r][j].z * v[r][j].z + v[r][j].w * v[r][j].w);
            s = wave_sum(s);
            GAS unsigned long long* o8 = (GAS unsigned long long*)(xb + (size_t)(m0 + r) * D) + lane;
#pragma unroll
            for (int j = 0; j < 4; ++j) o8[64 * j] = (unsigned long long)pk2(v[r][j].x, v[r][j].y) | ((unsigned long long)pk2(v[r][j].z, v[r][j].w) << 32);
            if (lane < 16) ss[(size_t)(m0 + r) * 16 + lane] = lane == 0 ? s : 0.f;
        }
    }
    float* cs1 = (float*)(ws + WS_CSSWA); float* cs2 = (float*)(ws + WS_CSMLA);
    for (int idx = gtid; idx < SEQ * 48; idx += NT) {
        const int t = idx / 48, i = idx % 48; float inv; float* dst;
        if (i < 32) { inv = exp2f(-(float)i * (LOG2_10000 / 32.0f)); dst = cs1 + ((size_t)t * 32 + i) * 2; } else { inv = exp2f(-(float)(i - 32) * (LOG2_10000 / 16.0f)); dst = cs2 + ((size_t)t * 16 + (i - 32)) * 2; }
        const float ang = (float)t * inv; const double rev = (double)ang * 0.15915494309189535; const float fr = (float)(rev - rint(rev));
        dst[0] = __builtin_amdgcn_cosf(fr); dst[1] = __builtin_amdgcn_sinf(fr);
    }
}

__device__ __forceinline__ void ld8(const bf16* p, float* x) { const uint4 w = *(const uint4*)p; x[0] = bflo(w.x); x[1] = bfhi(w.x); x[2] = bflo(w.y); x[3] = bfhi(w.y); x[4] = bflo(w.z); x[5] = bfhi(w.z); x[6] = bflo(w.w); x[7] = bfhi(w.w); }
__device__ __forceinline__ void st8(bf16* p, const float* x) { uint4 w; w.x = pk2(x[0], x[1]); w.y = pk2(x[2], x[3]); w.z = pk2(x[4], x[5]); w.w = pk2(x[6], x[7]); *(uint4*)p = w; }


typedef float f32x16 __attribute__((ext_vector_type(16)));
__device__ __forceinline__ v4i16 tr4(LAS const unsigned char* p) { return __builtin_amdgcn_ds_read_tr16_b64_v4i16((LAS v4i16*)p); }
__device__ __forceinline__ bf16x8 cat4(v4i16 a, v4i16 b) { bf16x8 r; r[0] = a[0]; r[1] = a[1]; r[2] = a[2]; r[3] = a[3]; r[4] = b[0]; r[5] = b[1]; r[6] = b[2]; r[7] = b[3]; return r; }
typedef __bf16 bf16x2_t __attribute__((ext_vector_type(2)));
typedef float f32x2_t __attribute__((ext_vector_type(2)));
__device__ __forceinline__ unsigned cvtpk(float lo, float hi) { f32x2_t v = {lo, hi}; bf16x2_t b = __builtin_convertvector(v, bf16x2_t); return __builtin_bit_cast(unsigned, b); }
__device__ __forceinline__ void lds_st16(LAS unsigned char* p, uint4 v) { *(LAS v4u*)p = (v4u){v.x, v.y, v.z, v.w}; }

constexpr int SX_PITCH = 192, SB_PITCH = 320, S_XS = 0, S_BM = 256 * SX_PITCH;
static_assert(S_BM + 256 * SB_PITCH <= RING_BYTES, "S unit LDS");

__device__ __forceinline__ void ssd_state_unit(LAS unsigned char* lds, int L, int unit, int tid, int wave, int lane) {
    const int h = unit & 7, c = (unit >> 3) & 15, b = unit >> 7, g = h >> 2, hl = h & 3; const size_t m0 = (size_t)b * SEQ + (size_t)c * 256;
    unsigned char* ws = aws();
    LAS float* fsc = (LAS float*)(lds + TAB_OFF);
    if (wave < 2) {
        const int dir = wave; const float A = -expf(ain(I_ALOG)[L * 16 + dir * 8 + h]); const float bias = ain(I_DTB)[L * 16 + dir * 8 + h];
        const float* dtraw = (const float*)(ws + WS_DTRAW); float* dtc = (float*)(ws + WS_DTC);
        float dt[4], cu[4];
#pragma unroll
        for (int j = 0; j < 4; ++j) dt[j] = softplus_f(dtraw[(m0 + 4 * lane + j) * 16 + dir * 8 + h] + bias);
        float tot, v;
        if (dir == 0) {
            cu[0] = dt[0] * A; cu[1] = cu[0] + dt[1] * A; cu[2] = cu[1] + dt[2] * A; cu[3] = cu[2] + dt[3] * A; tot = cu[3]; v = tot;
#pragma unroll
            for (int o = 1; o < 64; o <<= 1) { const float n = __shfl_up(v, o); if (lane >= o) v += n; }
        } else {
            cu[3] = dt[3] * A; cu[2] = cu[3] + dt[2] * A; cu[1] = cu[2] + dt[1] * A; cu[0] = cu[1] + dt[0] * A; tot = cu[0]; v = tot;
#pragma unroll
            for (int o = 1; o < 64; o <<= 1) { const float n = __shfl_down(v, o); if (lane + o < 64) v += n; }
        }
        const float excl = v - tot; const float total = wave_sum(tot);
#pragma unroll
        for (int j = 0; j < 4; ++j) { const float cum = cu[j] + excl; const size_t m = m0 + 4 * lane + j;
            fsc[dir * 256 + 4 * lane + j] = dt[j] * __expf(total - cum); dtc[(m * 8 + h) * 4 + dir] = dt[j]; dtc[(m * 8 + h) * 4 + 2 + dir] = cum; }
    }
    {
        const bf16* xr = (const bf16*)(ws + WS_XBCR); bf16* xc = (bf16*)(ws + WS_XBCC);
        const float* cw = ain(I_CONVW) + L * 5 * 1024; const float* cb = ain(I_CONVB) + L * 1024;
        constexpr int ncg = 28;
        for (int item = tid; item < ncg * 16; item += NWAVES * 64) {
            const int cg = item % ncg, tr = item / ncg;
            const int col = cg < 8 ? h * 64 + 8 * cg : (cg < 24 ? 512 + g * 128 + 8 * (cg - 8) : 768 + g * 128 + 8 * (4 * hl + cg - 24));
            float w[5][8], bb[8];
#pragma unroll
            for (int k = 0; k < 5; ++k) { const f32x4 w0 = *(const f32x4*)(cw + k * 1024 + col), w1 = *(const f32x4*)(cw + k * 1024 + col + 4);
                w[k][0] = w0.x; w[k][1] = w0.y; w[k][2] = w0.z; w[k][3] = w0.w; w[k][4] = w1.x; w[k][5] = w1.y; w[k][6] = w1.z; w[k][7] = w1.w; }
            { const f32x4 b0 = *(const f32x4*)(cb + col), b1 = *(const f32x4*)(cb + col + 4); bb[0] = b0.x; bb[1] = b0.y; bb[2] = b0.z; bb[3] = b0.w; bb[4] = b1.x; bb[5] = b1.y; bb[6] = b1.z; bb[7] = b1.w; }
            const int t0 = 16 * tr, sq0 = c * 256 + t0;
            uint4 rows[20];
#pragma unroll
            for (int i = 0; i < 20; ++i) { const int sq_ = sq0 + i - 2; const int di = (i < 2 || i >= 18) ? (sq_ < 0 ? -sq0 : (sq_ >= SEQ ? SEQ - 1 - sq0 : i - 2)) : i - 2;
                rows[i] = *(const uint4*)(xr + (m0 + t0 + di) * 1024 + col); }
            const float e0 = sq0 - 2 >= 0 ? 1.f : 0.f, e1 = sq0 - 1 >= 0 ? 1.f : 0.f, e18 = sq0 + 16 < SEQ ? 1.f : 0.f, e19 = sq0 + 17 < SEQ ? 1.f : 0.f;
            float win[5][8];
#define UNPK(dst, rw) do { dst[0] = bflo(rw.x); dst[1] = bfhi(rw.x); dst[2] = bflo(rw.y); dst[3] = bfhi(rw.y); dst[4] = bflo(rw.z); dst[5] = bfhi(rw.z); dst[6] = bflo(rw.w); dst[7] = bfhi(rw.w); } while (0)
            UNPK(win[0], rows[0]); UNPK(win[1], rows[1]); UNPK(win[2], rows[2]); UNPK(win[3], rows[3]);
#pragma unroll
            for (int e = 0; e < 8; ++e) { win[0][e] *= e0; win[1][e] *= e1; }
#pragma unroll
            for (int tt = 0; tt < 16; ++tt) {
                UNPK(win[(tt + 4) % 5], rows[tt + 4]);
                if (tt == 14) {
#pragma unroll
                    for (int e = 0; e < 8; ++e) win[(tt + 4) % 5][e] *= e18; }
                if (tt == 15) {
#pragma unroll
                    for (int e = 0; e < 8; ++e) win[(tt + 4) % 5][e] *= e19; }
                float o[8];
#pragma unroll
                for (int e = 0; e < 8; ++e) { o[e] = bb[e];
#pragma unroll
                    for (int k = 0; k < 5; ++k) o[e] += win[(tt + k) % 5][e] * w[k][e]; }
#pragma unroll
                for (int e = 0; e < 8; ++e) o[e] = silu_f(o[e]);
                uint4 pk; pk.x = cvtpk(o[0], o[1]); pk.y = cvtpk(o[2], o[3]); pk.z = cvtpk(o[4], o[5]); pk.w = cvtpk(o[6], o[7]);
                const int t = t0 + tt;
                if (cg < 8) lds_st16(lds + S_XS + t * SX_PITCH + 16 * cg, pk);
                else if (cg < 24) lds_st16(lds + S_BM + t * SB_PITCH + 16 * (cg - 8), pk);
                if (cg < 8 || cg >= 24 || hl == 0) *(uint4*)(xc + (m0 + t) * 1024 + col) = pk;
            }
#undef UNPK
        }
    }
    __syncthreads();
    {
        const int nb = wave & 3, pb = wave >> 2, hh = lane >> 5, blk = (lane >> 4) & 1, q = (lane & 15) >> 2, p = lane & 3;
        f32x16 accf, accb;
#pragma unroll
        for (int i = 0; i < 16; ++i) { accf[i] = 0.f; accb[i] = 0.f; }
        const LAS unsigned char* xa = lds + S_XS + (8 * hh + q) * SX_PITCH + (32 * pb + 16 * blk + 4 * p) * 2;
        const LAS unsigned char* ba = lds + S_BM + (8 * hh + q) * SB_PITCH + (32 * nb + 16 * blk + 4 * p) * 2;
#pragma unroll 2
        for (int ks = 0; ks < 16; ++ks) {
            const v4i16 x0 = tr4(xa + (16 * ks) * SX_PITCH), x1 = tr4(xa + (16 * ks + 4) * SX_PITCH);
            const v4i16 b0 = tr4(ba + (16 * ks) * SB_PITCH), b1 = tr4(ba + (16 * ks + 4) * SB_PITCH);
            const f32x4 ff0 = *(const LAS f32x4*)(fsc + 16 * ks + 8 * hh), ff1 = *(const LAS f32x4*)(fsc + 16 * ks + 8 * hh + 4);
            const f32x4 fb0 = *(const LAS f32x4*)(fsc + 256 + 16 * ks + 8 * hh), fb1 = *(const LAS f32x4*)(fsc + 256 + 16 * ks + 8 * hh + 4);
            float xv[8];
#pragma unroll
            for (int e = 0; e < 4; ++e) { xv[e] = bf2f((unsigned short)x0[e]); xv[4 + e] = bf2f((unsigned short)x1[e]); }
            union { bf16x8 v; unsigned u[4]; } af, ab;
            af.u[0] = cvtpk(xv[0] * ff0[0], xv[1] * ff0[1]); af.u[1] = cvtpk(xv[2] * ff0[2], xv[3] * ff0[3]); af.u[2] = cvtpk(xv[4] * ff1[0], xv[5] * ff1[1]); af.u[3] = cvtpk(xv[6] * ff1[2], xv[7] * ff1[3]);
            ab.u[0] = cvtpk(xv[0] * fb0[0], xv[1] * fb0[1]); ab.u[1] = cvtpk(xv[2] * fb0[2], xv[3] * fb0[3]); ab.u[2] = cvtpk(xv[4] * fb1[0], xv[5] * fb1[1]); ab.u[3] = cvtpk(xv[6] * fb1[2], xv[7] * fb1[3]);
            const bf16x8 bf = cat4(b0, b1);
            accf = __builtin_amdgcn_mfma_f32_32x32x16_bf16(af.v, bf, accf, 0, 0, 0);
            accb = __builtin_amdgcn_mfma_f32_32x32x16_bf16(ab.v, bf, accb, 0, 0, 0);
        }
        float* st = aout() + ((size_t)((b * 16 + c) * 8 + h) * 2) * 8192;
#pragma unroll
        for (int r = 0; r < 16; ++r) { const int pp = 32 * pb + (r & 3) + 8 * (r >> 2) + 4 * hh, n = 32 * nb + (lane & 31);
            st[pp * 128 + n] = accf[r]; st[8192 + pp * 128 + n] = accb[r]; }
    }
    __syncthreads();
}

constexpr int T_QL = 0, T_QL_PITCH = 528, T_CKV = 64 * 528, T_CKV_PITCH = 272, T_VS = T_CKV + 64 * 272, T_VS_PITCH = 272;
__device__ __forceinline__ float red8(float s) { s += __shfl_xor(s, 1); s += __shfl_xor(s, 2); s += __shfl_xor(s, 4); return s; }

template <int TSTOP = 99>
__device__ __forceinline__ void token_prep_unit(LAS unsigned char* lds, int L, int unit, int tid, int wave, int lane, bool do_swa = true) {
    unsigned char* ws = aws();
    const size_t m0 = (size_t)unit * 64; const int b = unit >> 6, t0 = (unit & 63) * 64;
    uint4 sv[2], sq[4], sc[2];
    {
        const bf16* swakv = (const bf16*)(ws + WS_SWAKV); const bf16* qr = (const bf16*)(ws + WS_MLAQR); const bf16* mm = (const bf16*)(ws + WS_MLAM);
#pragma unroll
        for (int r = 0; r < 2; ++r) { const int id = tid + 512 * r, tok = id >> 4, c8 = id & 15; sv[r] = *(const uint4*)(swakv + (m0 + tok) * 256 + 128 + 8 * c8); }
#pragma unroll
        for (int r = 0; r < 4; ++r) { const int tok = (tid >> 5) + 16 * r, c8 = tid & 31; sq[r] = *(const uint4*)(qr + (m0 + tok) * 256 + 8 * c8); }
#pragma unroll
        for (int r = 0; r < 2; ++r) { const int tok = (tid >> 4) + 32 * r, c8 = tid & 15; sc[r] = *(const uint4*)(mm + (m0 + tok) * 256 + 8 * c8); }
    }
    if (do_swa) {
        bf16* swaq = (bf16*)(ws + WS_SWAQ); bf16* swakv = (bf16*)(ws + WS_SWAKV); const float* cs = (const float*)(ws + WS_CSSWA);
        const int tok = tid >> 3, sub = tid & 7; const size_t m = m0 + tok; const int t = t0 + tok;
        float cc[8], sn[8];
#pragma unroll
        for (int e2 = 0; e2 < 4; ++e2) { const f32x4 v = *(const f32x4*)(cs + ((size_t)t * 32 + 8 * (sub & 3) + 2 * e2) * 2); cc[2 * e2] = v.x; sn[2 * e2] = v.y; cc[2 * e2 + 1] = v.z; sn[2 * e2 + 1] = v.w; }
        uint4 raw[6];
#pragma unroll
        for (int hh = 0; hh < 6; ++hh) raw[hh] = *(const uint4*)((hh < 4 ? swaq + m * 256 + hh * 64 : swakv + m * 256 + (hh - 4) * 64) + 8 * sub);
        float wq8[8], wk8[8];
        { const f32x4 a0 = *(const f32x4*)(ain(I_SWAQN) + L * 64 + 8 * sub), a1 = *(const f32x4*)(ain(I_SWAQN) + L * 64 + 8 * sub + 4), b0 = *(const f32x4*)(ain(I_SWAKN) + L * 64 + 8 * sub), b1 = *(const f32x4*)(ain(I_SWAKN) + L * 64 + 8 * sub + 4);
          wq8[0] = a0.x; wq8[1] = a0.y; wq8[2] = a0.z; wq8[3] = a0.w; wq8[4] = a1.x; wq8[5] = a1.y; wq8[6] = a1.z; wq8[7] = a1.w; wk8[0] = b0.x; wk8[1] = b0.y; wk8[2] = b0.z; wk8[3] = b0.w; wk8[4] = b1.x; wk8[5] = b1.y; wk8[6] = b1.z; wk8[7] = b1.w; }
#pragma unroll
        for (int hh = 0; hh < 6; ++hh) {
            bf16* p = (hh < 4 ? swaq + m * 256 + hh * 64 : swakv + m * 256 + (hh - 4) * 64) + 8 * sub;
            const uint4 rw = raw[hh]; float x[8] = {bflo(rw.x), bfhi(rw.x), bflo(rw.y), bfhi(rw.y), bflo(rw.z), bfhi(rw.z), bflo(rw.w), bfhi(rw.w)}; float s = 0.f;
#pragma unroll
            for (int e = 0; e < 8; ++e) s += x[e] * x[e];
            s = red8(s); const float r = rsqrtf(s * (1.0f / 64.0f) + EPS);
#pragma unroll
            for (int e = 0; e < 8; ++e) { const float y = x[e] * r * (hh < 4 ? wq8[e] : wk8[e]); const float pe = __shfl_xor(y, 4); x[e] = sub < 4 ? y * cc[e] - pe * sn[e] : pe * sn[e] + y * cc[e]; }
            st8(p, x);
        }
    }
    {
#define UNP8(x, rw) float x[8] = {bflo(rw.x), bfhi(rw.x), bflo(rw.y), bfhi(rw.y), bflo(rw.z), bfhi(rw.z), bflo(rw.w), bfhi(rw.w)}
#pragma unroll
        for (int r = 0; r < 2; ++r) { const int id = tid + 512 * r, tok = id >> 4, c8 = id & 15; lds_st16(lds + T_VS + tok * T_VS_PITCH + 16 * c8, sv[r]); }
#pragma unroll
        for (int r = 0; r < 4; ++r) { const int tok = (tid >> 5) + 16 * r, c8 = tid & 31; UNP8(x, sq[r]); float s = 0.f;
#pragma unroll
            for (int e = 0; e < 8; ++e) s += x[e] * x[e];
            s = red8(s); s += __shfl_xor(s, 8); s += __shfl_xor(s, 16); const float rr = rsqrtf(s * (1.0f / 256.0f) + EPS);
            uint4 pk; pk.x = cvtpk(x[0] * rr, x[1] * rr); pk.y = cvtpk(x[2] * rr, x[3] * rr); pk.z = cvtpk(x[4] * rr, x[5] * rr); pk.w = cvtpk(x[6] * rr, x[7] * rr);
            lds_st16(lds + T_QL + tok * T_QL_PITCH + 16 * c8, pk); }
#pragma unroll
        for (int r = 0; r < 2; ++r) { const int tok = (tid >> 4) + 32 * r, c8 = tid & 15; UNP8(x, sc[r]); float s = 0.f;
#pragma unroll
            for (int e = 0; e < 8; ++e) s += x[e] * x[e];
            s = red8(s); s += __shfl_xor(s, 8); const float rr = rsqrtf(s * (1.0f / 128.0f) + EPS);
            uint4 pk; pk.x = cvtpk(x[0] * rr, x[1] * rr); pk.y = cvtpk(x[2] * rr, x[3] * rr); pk.z = cvtpk(x[4] * rr, x[5] * rr); pk.w = cvtpk(x[6] * rr, x[7] * rr);
            lds_st16(lds + T_CKV + tok * T_CKV_PITCH + 16 * c8, pk); }
#undef UNP8
    }
    __syncthreads();
    if (TSTOP < 2) return;
    {
        bf16* vt = (bf16*)(ws + WS_SWAVT); const int ch = tid >> 2, tq = tid & 3; unsigned pk[8];
#pragma unroll
        for (int i = 0; i < 8; ++i) { const unsigned lo = *(const LAS unsigned short*)(lds + T_VS + (16 * tq + 2 * i) * T_VS_PITCH + 2 * ch), hi = *(const LAS unsigned short*)(lds + T_VS + (16 * tq + 2 * i + 1) * T_VS_PITCH + 2 * ch); pk[i] = lo | (hi << 16); }
        bf16* dst = vt + (size_t)(b * 2 + (ch >> 6)) * 64 * SEQ + (size_t)(t0 >> 6) * 4096 + (ch & 63) * 64 + 16 * tq;
        *(uint4*)dst = make_uint4(pk[0], pk[1], pk[2], pk[3]); *(uint4*)(dst + 8) = make_uint4(pk[4], pk[5], pk[6], pk[7]);
    }
    if (TSTOP < 3) { __syncthreads(); return; }
    {
        const int head = wave >> 1, th = wave & 1, fr = lane & 15, fq = lane >> 4;
        const float* csm = (const float*)(ws + WS_CSMLA);
        {
            const bf16* wq_t = (const bf16*)(ws + WS_WUQ); f32x4 acc[2][6];
#pragma unroll
            for (int mt = 0; mt < 2; ++mt)
#pragma unroll
                for (int nt = 0; nt < 6; ++nt) acc[mt][nt] = (f32x4){0.f, 0.f, 0.f, 0.f};
            const bf16* wrow = wq_t + (size_t)(head * 96 + fr) * 256 + 8 * fq;
            bf16x8 bq0[6], bq1[6];
#pragma unroll
            for (int nt = 0; nt < 6; ++nt) { bq0[nt] = *(const bf16x8*)(wrow + (size_t)nt * 16 * 256); bq1[nt] = *(const bf16x8*)(wrow + (size_t)nt * 16 * 256 + 32); }
#pragma unroll
            for (int ks = 0; ks < 8; ++ks) {
                bf16x8 a[2];
#pragma unroll
                for (int mt = 0; mt < 2; ++mt) a[mt] = *(const LAS bf16x8*)(lds + T_QL + (32 * th + 16 * mt + fr) * T_QL_PITCH + (32 * ks + 8 * fq) * 2);
#pragma unroll
                for (int nt = 0; nt < 6; ++nt) { const bf16x8 bq = (ks & 1) ? bq1[nt] : bq0[nt];
#pragma unroll
                    for (int mt = 0; mt < 2; ++mt) acc[mt][nt] = __builtin_amdgcn_mfma_f32_16x16x32_bf16(bq, a[mt], acc[mt][nt], 0, 0, 0); }
                if (ks + 2 < 8) {
#pragma unroll
                    for (int nt = 0; nt < 6; ++nt) { const bf16x8 nb = *(const bf16x8*)(wrow + (size_t)nt * 16 * 256 + 32 * (ks + 2)); if (ks & 1) bq1[nt] = nb; else bq0[nt] = nb; }
                }
            }
            const float* wn = ain(I_MQN) + L * 96; bf16* mq = (bf16*)(ws + WS_MLAQ);
            asm volatile("" ::: "memory");
            f32x4 wq4[6], csq[2][2];
#pragma unroll
            for (int nt = 0; nt < 6; ++nt) wq4[nt] = *(const f32x4*)(wn + 16 * nt + 4 * fq);
#pragma unroll
            for (int mt = 0; mt < 2; ++mt) { const int tok_ = 32 * th + 16 * mt + fr; csq[mt][0] = *(const f32x4*)(csm + ((size_t)(t0 + tok_) * 16 + 4 * fq) * 2); csq[mt][1] = *(const f32x4*)(csm + ((size_t)(t0 + tok_) * 16 + 4 * fq + 2) * 2); }
#pragma unroll
            for (int mt = 0; mt < 2; ++mt) {
                const int tok = 32 * th + 16 * mt + fr; float s = 0.f;
#pragma unroll
                for (int nt = 0; nt < 6; ++nt) s += (acc[mt][nt][0] * acc[mt][nt][0] + acc[mt][nt][1] * acc[mt][nt][1]) + (acc[mt][nt][2] * acc[mt][nt][2] + acc[mt][nt][3] * acc[mt][nt][3]);
                s += __shfl_xor(s, 16); s += __shfl_xor(s, 32); const float r2 = rsqrtf(s * (1.0f / 96.0f) + EPS);
#pragma unroll
                for (int nt = 0; nt < 6; ++nt) acc[mt][nt] = acc[mt][nt] * r2 * wq4[nt];
                const f32x4 cs0 = csq[mt][0], cs1 = csq[mt][1];
                const float cc[4] = {cs0.x, cs0.z, cs1.x, cs1.z}, sn[4] = {cs0.y, cs0.w, cs1.y, cs1.w};
#pragma unroll
                for (int e = 0; e < 4; ++e) { const float x1 = acc[mt][4][e], x2 = acc[mt][5][e]; acc[mt][4][e] = x1 * cc[e] - x2 * sn[e]; acc[mt][5][e] = x1 * sn[e] + x2 * cc[e]; }
#pragma unroll
                for (int nt = 0; nt < 6; ++nt) { uint2 w; w.x = cvtpk(acc[mt][nt][0], acc[mt][nt][1]); w.y = cvtpk(acc[mt][nt][2], acc[mt][nt][3]); *(uint2*)(mq + (m0 + tok) * 384 + head * 96 + 16 * nt + 4 * fq) = w; }
            }
        }
        if (TSTOP < 4) { __syncthreads(); return; }
        {
            const bf16* wkv_t = (const bf16*)(ws + WS_WUKV); f32x4 ak[2][4], av[2][4];
#pragma unroll
            for (int mt = 0; mt < 2; ++mt)
#pragma unroll
                for (int nt = 0; nt < 4; ++nt) { ak[mt][nt] = (f32x4){0.f, 0.f, 0.f, 0.f}; av[mt][nt] = (f32x4){0.f, 0.f, 0.f, 0.f}; }
            const bf16* wrk = wkv_t + (size_t)(head * 128 + fr) * 128 + 8 * fq; const bf16* wrv = wrk + (size_t)64 * 128;
            bf16x8 bk0[4], bv0[4], bk1[4], bv1[4];
#pragma unroll
            for (int nt = 0; nt < 4; ++nt) { bk0[nt] = *(const bf16x8*)(wrk + (size_t)nt * 16 * 128); bv0[nt] = *(const bf16x8*)(wrv + (size_t)nt * 16 * 128); }
#pragma unroll
            for (int ks = 0; ks < 4; ++ks) {
                if (ks + 1 < 4) {
#pragma unroll
                    for (int nt = 0; nt < 4; ++nt) { const bf16x8 nk = *(const bf16x8*)(wrk + (size_t)nt * 16 * 128 + 32 * (ks + 1)), nv = *(const bf16x8*)(wrv + (size_t)nt * 16 * 128 + 32 * (ks + 1));
                        if (ks & 1) { bk0[nt] = nk; bv0[nt] = nv; } else { bk1[nt] = nk; bv1[nt] = nv; } }
                }
                bf16x8 a[2];
#pragma unroll
                for (int mt = 0; mt < 2; ++mt) a[mt] = *(const LAS bf16x8*)(lds + T_CKV + (32 * th + 16 * mt + fr) * T_CKV_PITCH + (32 * ks + 8 * fq) * 2);
#pragma unroll
                for (int nt = 0; nt < 4; ++nt) { const bf16x8 bk = (ks & 1) ? bk1[nt] : bk0[nt], bv = (ks & 1) ? bv1[nt] : bv0[nt];
#pragma unroll
                    for (int mt = 0; mt < 2; ++mt) { ak[mt][nt] = __builtin_amdgcn_mfma_f32_16x16x32_bf16(bk, a[mt], ak[mt][nt], 0, 0, 0); av[mt][nt] = __builtin_amdgcn_mfma_f32_16x16x32_bf16(a[mt], bv, av[mt][nt], 0, 0, 0); } }
            }
            const float* wn = ain(I_MKN) + L * 96; bf16* mk = (bf16*)(ws + WS_MLAK); bf16* mvt = (bf16*)(ws + WS_MLAVT); const bf16* mm = (const bf16*)(ws + WS_MLAM);
            asm volatile("" ::: "memory");
            f32x4 wk4[4], wkr[2], csk[2][4]; uint4 krw[2];
#pragma unroll
            for (int nt = 0; nt < 4; ++nt) wk4[nt] = *(const f32x4*)(wn + 16 * nt + 4 * fq);
            wkr[0] = *(const f32x4*)(wn + 64 + 8 * fq); wkr[1] = *(const f32x4*)(wn + 64 + 8 * fq + 4);
#pragma unroll
            for (int mt = 0; mt < 2; ++mt) { const int tok_ = 32 * th + 16 * mt + fr; krw[mt] = *(const uint4*)(mm + (m0 + tok_) * 256 + 128 + 8 * fq);
#pragma unroll
                for (int e2 = 0; e2 < 4; ++e2) csk[mt][e2] = *(const f32x4*)(csm + ((size_t)(t0 + tok_) * 16 + 8 * (fq & 1) + 2 * e2) * 2); }
#pragma unroll
            for (int mt = 0; mt < 2; ++mt) {
                const int tok = 32 * th + 16 * mt + fr; const uint4 kw_ = krw[mt]; float kr[8] = {bflo(kw_.x), bfhi(kw_.x), bflo(kw_.y), bfhi(kw_.y), bflo(kw_.z), bfhi(kw_.z), bflo(kw_.w), bfhi(kw_.w)}; float s = 0.f;
#pragma unroll
                for (int nt = 0; nt < 4; ++nt) s += (ak[mt][nt][0] * ak[mt][nt][0] + ak[mt][nt][1] * ak[mt][nt][1]) + (ak[mt][nt][2] * ak[mt][nt][2] + ak[mt][nt][3] * ak[mt][nt][3]);
#pragma unroll
                for (int e = 0; e < 8; ++e) s += kr[e] * kr[e];
                s += __shfl_xor(s, 16); s += __shfl_xor(s, 32); const float r2 = rsqrtf(s * (1.0f / 96.0f) + EPS);
#pragma unroll
                for (int nt = 0; nt < 4; ++nt) { const f32x4 kk = ak[mt][nt] * r2 * wk4[nt]; uint2 w; w.x = cvtpk(kk[0], kk[1]); w.y = cvtpk(kk[2], kk[3]); *(uint2*)(mk + (m0 + tok) * 384 + head * 96 + 16 * nt + 4 * fq) = w; }
                float cc[8], sn[8];
#pragma unroll
                for (int e2 = 0; e2 < 4; ++e2) { const f32x4 v = csk[mt][e2]; cc[2 * e2] = v.x; sn[2 * e2] = v.y; cc[2 * e2 + 1] = v.z; sn[2 * e2 + 1] = v.w; }
#pragma unroll
                for (int e = 0; e < 8; ++e) { const float y = kr[e] * r2 * wkr[e >> 2][e & 3]; const float pe = __shfl_xor(y, 32); kr[e] = fq < 2 ? y * cc[e] - pe * sn[e] : pe * sn[e] + y * cc[e]; }
                st8(mk + (m0 + tok) * 384 + head * 96 + 64 + 8 * fq, kr);
#pragma unroll
                for (int nt = 0; nt < 4; ++nt) { uint2 w; w.x = cvtpk(av[mt][nt][0], av[mt][nt][1]); w.y = cvtpk(av[mt][nt][2], av[mt][nt][3]);
                    *(uint2*)(mvt + (size_t)(b * 4 + head) * 64 * SEQ + (size_t)(t0 >> 6) * 4096 + (16 * nt + fr) * 64 + 32 * th + 16 * mt + 4 * fq) = w; }
            }
        }
    }
    __syncthreads();
}


__device__ __forceinline__ float max3f(float a, float b, float c) { float r; asm("v_max3_f32 %0, %1, %2, %3" : "=v"(r) : "v"(a), "v"(b), "v"(c)); return r; }
__device__ __forceinline__ float max2f(float a, float b) { float r; asm("v_max_f32_e32 %0, %1, %2" : "=v"(r) : "v"(a), "v"(b)); return r; }
__device__ __forceinline__ float xhalf_max(float x) { const unsigned u = __float_as_uint(x); const auto r = __builtin_amdgcn_permlane32_swap(u, u, false, false); return max2f(__uint_as_float(r[0]), __uint_as_float(r[1])); }
#define OPQ(x) asm("" : "+v"(x))
template <int DQK> struct AttnCfg { static constexpr int KP = DQK * 2 + 16, VP = 144, KB = 64 * KP, VB = 64 * VP, BUF = KB + VB, NKS = DQK / 16, KCH = 64 * DQK / 8; };

template <int DQK, bool SWA>
__device__ __forceinline__ void attn_unit(LAS unsigned char* lds, int L, int unit, int tid, int wave, int lane) {
    typedef AttnCfg<DQK> C;
    static_assert(3 * C::BUF <= RING_BYTES, "attention LDS ring");
    unsigned char* ws = aws();
    const int hh = lane >> 5, ql = lane & 31, b = unit >> 6;
    const int qb = SWA ? (unit & 31) : (unit & 15), h = SWA ? 2 * ((unit >> 5) & 1) + (wave >> 2) : (unit >> 4) & 3;
    const int q0 = SWA ? 128 * qb + 32 * (wave & 3) : 256 * qb + 32 * wave;
    const bool late = wave >= 4;
    const bf16* Kg; const bf16* Vt; const bf16* Qg; int kpitch, qpitch, ycol, slot; float c2, m_init, l_init;
    if (SWA) { const int kvh = h >> 1; Kg = (const bf16*)(ws + WS_SWAKV) + (size_t)b * SEQ * 256 + kvh * 64; kpitch = 256; Vt = (const bf16*)(ws + WS_SWAVT) + (size_t)(b * 2 + kvh) * 64 * SEQ;
        Qg = (const bf16*)(ws + WS_SWAQ) + (size_t)b * SEQ * 256 + h * 64; qpitch = 256; ycol = 512 + h * 64; slot = 8 + h; c2 = 0.125f * 1.4426950408889634f;
        m_init = ain(I_SINK)[L * 4 + h] * 1.4426950408889634f; l_init = hh == 0 ? 1.0f : 0.0f; }
    else { Kg = (const bf16*)(ws + WS_MLAK) + (size_t)b * SEQ * 384 + h * 96; kpitch = 384; Vt = (const bf16*)(ws + WS_MLAVT) + (size_t)(b * 4 + h) * 64 * SEQ;
        Qg = (const bf16*)(ws + WS_MLAQ) + (size_t)b * SEQ * 384 + h * 96; qpitch = 384; ycol = 768 + h * 64; slot = 12 + h; c2 = 0.10206207261596577f * 1.4426950408889634f; m_init = 0.f; l_init = 0.f; }
    bf16x8 qf[C::NKS];
#pragma unroll
    for (int ks = 0; ks < C::NKS; ++ks) { float x[8]; ld8(Qg + (size_t)(q0 + ql) * qpitch + 16 * ks + 8 * hh, x);
        union { bf16x8 v; unsigned u[4]; } t; t.u[0] = cvtpk(x[0] * c2, x[1] * c2); t.u[1] = cvtpk(x[2] * c2, x[3] * c2); t.u[2] = cvtpk(x[4] * c2, x[5] * c2); t.u[3] = cvtpk(x[6] * c2, x[7] * c2); qf[ks] = t.v; }
    int j0 = 0, j1 = SEQ / 64;
    if (SWA) { j0 = 2 * qb - 2 < 0 ? 0 : 2 * qb - 2; j1 = 2 * qb + 4 > SEQ / 64 ? SEQ / 64 : 2 * qb + 4; }
    f32x16 o0, o1;
#pragma unroll
    for (int i = 0; i < 16; ++i) { o0[i] = 0.f; o1[i] = 0.f; }
    float mrun = m_init, lrun = l_init;
    uint4 kr0A, kr1A = make_uint4(0u, 0u, 0u, 0u), vrA, kr0B, kr1B = make_uint4(0u, 0u, 0u, 0u), vrB;
    constexpr int CPR = DQK / 8;
    const int kc0 = tid, kc1 = tid + 512; const bool has1 = (C::KCH > 512) && (kc1 < C::KCH);
    const int vrow = tid >> 3, vc = tid & 7, vo0 = 32 * (vc >> 1) + ((vc & 1) ? 8 : 0), vo1 = 32 * (vc >> 1) + ((vc & 1) ? 24 : 16);
#define ATT_LOAD(j, R) do { const size_t key0_ = (size_t)(j) * 64; \
        kr0##R = *(const uint4*)(Kg + (key0_ + kc0 / CPR) * kpitch + 8 * (kc0 % CPR)); \
        if (has1) kr1##R = *(const uint4*)(Kg + (key0_ + kc1 / CPR) * kpitch + 8 * (kc1 % CPR)); \
        vr##R = *(const uint4*)(Vt + (size_t)(j) * 4096 + vrow * 64 + 8 * vc); } while (0)
#define ATT_STORE(bufp, R) do { LAS unsigned char* kb_ = (bufp); LAS unsigned char* vb_ = kb_ + C::KB; \
        lds_st16(kb_ + (kc0 / CPR) * C::KP + 16 * (kc0 % CPR), kr0##R); \
        if (has1) lds_st16(kb_ + (kc1 / CPR) * C::KP + 16 * (kc1 % CPR), kr1##R); \
        *(LAS v2u*)(vb_ + vrow * C::VP + vo0) = (v2u){vr##R.x, vr##R.y}; *(LAS v2u*)(vb_ + vrow * C::VP + vo1) = (v2u){vr##R.z, vr##R.w}; } while (0)
#define ATT_VLD(vbp) do { const LAS unsigned char* v0_ = (vbp) + ql * C::VP + 16 * hh; const LAS unsigned char* v1_ = v0_ + 32 * C::VP; \
        _Pragma("unroll") for (int i_ = 0; i_ < 4; ++i_) { vf[2 * i_] = *(const LAS bf16x8*)(v0_ + 32 * i_); vf[2 * i_ + 1] = *(const LAS bf16x8*)(v1_ + 32 * i_); } } while (0)
#define ATT_PV(P0, P1, P2, P3) do { \
        o0 = __builtin_amdgcn_mfma_f32_32x32x16_bf16(vf[0], P0, o0, 0, 0, 0); o1 = __builtin_amdgcn_mfma_f32_32x32x16_bf16(vf[1], P0, o1, 0, 0, 0); \
        o0 = __builtin_amdgcn_mfma_f32_32x32x16_bf16(vf[2], P1, o0, 0, 0, 0); o1 = __builtin_amdgcn_mfma_f32_32x32x16_bf16(vf[3], P1, o1, 0, 0, 0); \
        o0 = __builtin_amdgcn_mfma_f32_32x32x16_bf16(vf[4], P2, o0, 0, 0, 0); o1 = __builtin_amdgcn_mfma_f32_32x32x16_bf16(vf[5], P2, o1, 0, 0, 0); \
        o0 = __builtin_amdgcn_mfma_f32_32x32x16_bf16(vf[6], P3, o0, 0, 0, 0); o1 = __builtin_amdgcn_mfma_f32_32x32x16_bf16(vf[7], P3, o1, 0, 0, 0); } while (0)
    ATT_LOAD(j0, A); ATT_STORE(lds, A);
    if (j0 + 1 < j1) ATT_LOAD(j0 + 1, B);
    __syncthreads();
#define ATT_ITER(LATE_, LD_, ST_) { \
        const int bn = bi == 2 ? 0 : bi + 1, bp = bi == 0 ? 2 : bi - 1; \
        LAS unsigned char* kb = lds + bi * C::BUF; LAS unsigned char* vb = kb + C::KB; \
        const bool more = j + 1 < j1; \
        if (more) ATT_STORE(lds + bn * C::BUF, ST_); \
        if (j + 2 < j1) ATT_LOAD(j + 2, LD_); \
        bool active = true; \
        if (SWA) active = !(64 * j + 63 < q0 - 128 || 64 * j > q0 + 31 + 128); \
 \
        bf16x8 vf[8], kf[2 * C::NKS]; \
        if (LATE_ && pend) { ATT_VLD(lds + bp * C::BUF + C::KB); ATT_PV(pp0, pp1, pp2, pp3); } \
        if (active) { \
_Pragma("unroll") \
            for (int ks = 0; ks < C::NKS; ++ks) { kf[2 * ks] = *(const LAS bf16x8*)(kb + ql * C::KP + (16 * ks + 8 * hh) * 2); kf[2 * ks + 1] = *(const LAS bf16x8*)(kb + (32 + ql) * C::KP + (16 * ks + 8 * hh) * 2); } \
            f32x16 s0, s1; { const float nm_ = -mrun; _Pragma("unroll") for (int i = 0; i < 16; ++i) { s0[i] = nm_; s1[i] = nm_; } } \
_Pragma("unroll") \
            for (int ks = 0; ks < C::NKS; ++ks) { \
                s0 = __builtin_amdgcn_mfma_f32_32x32x16_bf16(kf[2 * ks], qf[ks], s0, 0, 0, 0); \
                s1 = __builtin_amdgcn_mfma_f32_32x32x16_bf16(kf[2 * ks + 1], qf[ks], s1, 0, 0, 0); \
            } \
            asm volatile("s_nop 7\n\ts_nop 7" : "+v"(s0), "+v"(s1)); \
            if (!LATE_) ATT_VLD(vb); \
            if (SWA) { \
                const int qpos = q0 + ql, kbase = 64 * j + 4 * hh; \
_Pragma("unroll") \
                for (int r = 0; r < 16; ++r) { const int kp = kbase + (r & 3) + 8 * (r >> 2); const int d0 = kp - qpos, d1 = d0 + 32; \
                    if (d0 > 128 || d0 < -128) s0[r] = -INFINITY; if (d1 > 128 || d1 < -128) s1[r] = -INFINITY; } \
            } \
            float mxa = max2f(s0[0], s1[0]), mxb = max2f(s0[1], s1[1]), mxc = max2f(s0[2], s1[2]), mxd = max2f(s0[3], s1[3]); \
_Pragma("unroll") \
            for (int r = 4; r < 16; r += 4) { mxa = max3f(mxa, s0[r], s1[r]); mxb = max3f(mxb, s0[r + 1], s1[r + 1]); mxc = max3f(mxc, s0[r + 2], s1[r + 2]); mxd = max3f(mxd, s0[r + 3], s1[r + 3]); } \
            float mx = max2f(mxa, mxb); mx = max3f(mx, mxc, mxd); mx = xhalf_max(mx); \
            if (!__all(mx <= 8.0f)) { \
                const float dlt = max2f(mx, 0.f), alpha = __builtin_amdgcn_exp2f(-dlt); mrun += dlt; lrun *= alpha; \
_Pragma("unroll") \
                for (int i = 0; i < 16; ++i) { o0[i] *= alpha; o1[i] *= alpha; s0[i] -= dlt; s1[i] -= dlt; } \
            } \
            float la, lb, lc, ld; \
_Pragma("unroll") \
            for (int r = 0; r < 16; ++r) { s0[r] = __builtin_amdgcn_exp2f(s0[r]); s1[r] = __builtin_amdgcn_exp2f(s1[r]); \
                if (r == 0) { la = s0[r]; lb = s1[r]; } else if (r == 1) { lc = s0[r]; ld = s1[r]; } \
                else if ((r & 1) == 0) { la += s0[r]; OPQ(la); lb += s1[r]; OPQ(lb); } else { lc += s0[r]; OPQ(lc); ld += s1[r]; OPQ(ld); } } \
            la += lb; OPQ(la); lc += ld; OPQ(lc); lrun += la; OPQ(lrun); lrun += lc; \
            union { bf16x8 v; unsigned u[4]; } f0, f1, f2, f3; \
_Pragma("unroll") \
            for (int e = 0; e < 4; ++e) { f0.u[e] = cvtpk(s0[2 * e], s0[2 * e + 1]); f1.u[e] = cvtpk(s0[8 + 2 * e], s0[8 + 2 * e + 1]); f2.u[e] = cvtpk(s1[2 * e], s1[2 * e + 1]); f3.u[e] = cvtpk(s1[8 + 2 * e], s1[8 + 2 * e + 1]); } \
            if (LATE_) { pp0 = f0.v; pp1 = f1.v; pp2 = f2.v; pp3 = f3.v; pend = true; } \
            else ATT_PV(f0.v, f1.v, f2.v, f3.v); \
        } else if (LATE_) pend = false; \
        __syncthreads(); \
        bi = bn; \
    }
#define ATT_LOOP(LATE_) { \
    bf16x8 pp0 = qf[0], pp1 = qf[0], pp2 = qf[0], pp3 = qf[0]; bool pend = false; \
    int bi = 0; \
    for (int j = j0; j < j1; ++j) { \
        ATT_ITER(LATE_, A, B) \
        if (++j >= j1) break; \
        ATT_ITER(LATE_, B, A) \
    } \
    if (LATE_ && pend) { const int bp = bi == 0 ? 2 : bi - 1; bf16x8 vf[8]; ATT_VLD(lds + bp * C::BUF + C::KB); ATT_PV(pp0, pp1, pp2, pp3); } \
    }
    if (late) ATT_LOOP(true) else ATT_LOOP(false)
#undef ATT_LOOP
#undef ATT_ITER
#undef ATT_LOAD
#undef ATT_STORE
#undef ATT_PV
#undef ATT_VLD
    lrun += __shfl_xor(lrun, 32); const float inv = 1.0f / lrun; float sq = 0.f;
#pragma unroll
    for (int i = 0; i < 16; ++i) { o0[i] *= inv; o1[i] *= inv; sq += o0[i] * o0[i] + o1[i] * o1[i]; }
    sq += __shfl_xor(sq, 32);
    const size_t m = (size_t)b * SEQ + q0 + ql;
    if (hh == 0) ((float*)(ws + WS_SSQ))[m * 16 + slot] = sq;
    bf16* y = (bf16*)(ws + WS_Y) + m * 1024 + ycol + 4 * hh;
#pragma unroll
    for (int g4 = 0; g4 < 4; ++g4) { uint2 w0, w1; w0.x = cvtpk(o0[4 * g4], o0[4 * g4 + 1]); w0.y = cvtpk(o0[4 * g4 + 2], o0[4 * g4 + 3]); w1.x = cvtpk(o1[4 * g4], o1[4 * g4 + 1]); w1.y = cvtpk(o1[4 * g4 + 2], o1[4 * g4 + 3]);
        *(uint2*)(y + 8 * g4) = w0; *(uint2*)(y + 32 + 8 * g4) = w1; }
    __syncthreads();
}

__device__ __forceinline__ void swa_unit(LAS unsigned char* lds, int L, int unit, int tid, int wave, int lane) {
    typedef AttnCfg<64> C;
    static_assert(6 * C::BUF <= RING_BYTES, "SWA window in LDS");
    unsigned char* ws = aws();
    const int hh = lane >> 5, ql = lane & 31, b = unit >> 6, qb = unit & 31, kvh = (unit >> 5) & 1, h = 2 * kvh + (wave >> 2);
    const int q0 = 128 * qb + 32 * (wave & 3);
    const bf16* Kg = (const bf16*)(ws + WS_SWAKV) + (size_t)b * SEQ * 256 + kvh * 64; const bf16* Vt = (const bf16*)(ws + WS_SWAVT) + (size_t)(b * 2 + kvh) * 64 * SEQ;
    const bf16* Qg = (const bf16*)(ws + WS_SWAQ) + (size_t)b * SEQ * 256 + h * 64;
    const float c2 = 0.125f * 1.4426950408889634f;
    const int j0 = 2 * qb - 2 < 0 ? 0 : 2 * qb - 2, j1 = 2 * qb + 4 > SEQ / 64 ? SEQ / 64 : 2 * qb + 4, nt = j1 - j0;
    const int krow = tid >> 3, kc = tid & 7, vrow = tid >> 3, vc = tid & 7, vo0 = 32 * (vc >> 1) + ((vc & 1) ? 8 : 0), vo1 = 32 * (vc >> 1) + ((vc & 1) ? 24 : 16);
    uint4 kr[6], vr[6];
#pragma unroll
    for (int t = 0; t < 6; ++t) { const size_t key0 = (size_t)(j0 + t < j1 ? j0 + t : j1 - 1) * 64;
        kr[t] = *(const uint4*)(Kg + (key0 + krow) * 256 + 8 * kc); vr[t] = *(const uint4*)(Vt + (key0 >> 6) * 4096 + vrow * 64 + 8 * vc); }
    uint4 qraw[4];
#pragma unroll
    for (int ks = 0; ks < 4; ++ks) qraw[ks] = *(const uint4*)(Qg + (size_t)(q0 + ql) * 256 + 16 * ks + 8 * hh);
    float mrun = ain(I_SINK)[L * 4 + h] * 1.4426950408889634f, lrun = hh == 0 ? 1.0f : 0.0f;
#pragma unroll
    for (int t = 0; t < 6; ++t) { LAS unsigned char* kb_ = lds + t * C::BUF; LAS unsigned char* vb_ = kb_ + C::KB;
        lds_st16(kb_ + krow * C::KP + 16 * kc, kr[t]);
        *(LAS v2u*)(vb_ + vrow * C::VP + vo0) = (v2u){vr[t].x, vr[t].y}; *(LAS v2u*)(vb_ + vrow * C::VP + vo1) = (v2u){vr[t].z, vr[t].w}; }
    bf16x8 qf[4];
#pragma unroll
    for (int ks = 0; ks < 4; ++ks) { const unsigned w4[4] = {qraw[ks].x, qraw[ks].y, qraw[ks].z, qraw[ks].w}; union { bf16x8 v; unsigned u[4]; } t;
#pragma unroll
        for (int e = 0; e < 4; ++e) t.u[e] = cvtpk(bflo(w4[e]) * c2, bfhi(w4[e]) * c2);
        qf[ks] = t.v; }
    f32x16 o0, o1;
#pragma unroll
    for (int i = 0; i < 16; ++i) { o0[i] = 0.f; o1[i] = 0.f; }
    __syncthreads();
#pragma unroll 1
    for (int t = 0; t < nt; ++t) {
        const int j = j0 + t;
        if (64 * j + 63 < q0 - 128 || 64 * j > q0 + 31 + 128) continue;
        const LAS unsigned char* kb = lds + t * C::BUF; const LAS unsigned char* vb = kb + C::KB;
        bf16x8 kf[8], vf[8];
#pragma unroll
        for (int ks = 0; ks < 4; ++ks) { kf[2 * ks] = *(const LAS bf16x8*)(kb + ql * C::KP + (16 * ks + 8 * hh) * 2); kf[2 * ks + 1] = *(const LAS bf16x8*)(kb + (32 + ql) * C::KP + (16 * ks + 8 * hh) * 2); }
        { const LAS unsigned char* v0_ = vb + ql * C::VP + 16 * hh; const LAS unsigned char* v1_ = v0_ + 32 * C::VP;
#pragma unroll
          for (int i_ = 0; i_ < 4; ++i_) { vf[2 * i_] = *(const LAS bf16x8*)(v0_ + 32 * i_); vf[2 * i_ + 1] = *(const LAS bf16x8*)(v1_ + 32 * i_); } }
        f32x16 s0, s1; { const float nm_ = -mrun;
#pragma unroll
            for (int i = 0; i < 16; ++i) { s0[i] = nm_; s1[i] = nm_; } }
#pragma unroll
        for (int ks = 0; ks < 4; ++ks) { s0 = __builtin_amdgcn_mfma_f32_32x32x16_bf16(kf[2 * ks], qf[ks], s0, 0, 0, 0); s1 = __builtin_amdgcn_mfma_f32_32x32x16_bf16(kf[2 * ks + 1], qf[ks], s1, 0, 0, 0); }
        asm volatile("s_nop 7\n\ts_nop 7" : "+v"(s0), "+v"(s1));
        { const int qpos = q0 + ql, kbase = 64 * j + 4 * hh;
#pragma unroll
          for (int r = 0; r < 16; ++r) { const int kp = kbase + (r & 3) + 8 * (r >> 2); const int d0 = kp - qpos, d1 = d0 + 32;
              if (d0 > 128 || d0 < -128) s0[r] = -INFINITY; if (d1 > 128 || d1 < -128) s1[r] = -INFINITY; } }
        float mxa = max2f(s0[0], s1[0]), mxb = max2f(s0[1], s1[1]), mxc = max2f(s0[2], s1[2]), mxd = max2f(s0[3], s1[3]);
#pragma unroll
        for (int r = 4; r < 16; r += 4) { mxa = max3f(mxa, s0[r], s1[r]); mxb = max3f(mxb, s0[r + 1], s1[r + 1]); mxc = max3f(mxc, s0[r + 2], s1[r + 2]); mxd = max3f(mxd, s0[r + 3], s1[r + 3]); }
        float mx = max2f(mxa, mxb); mx = max3f(mx, mxc, mxd); mx = xhalf_max(mx);
        if (!__all(mx <= 8.0f)) {
            const float dlt = max2f(mx, 0.f), alpha = __builtin_amdgcn_exp2f(-dlt); mrun += dlt; lrun *= alpha;
#pragma unroll
            for (int i = 0; i < 16; ++i) { o0[i] *= alpha; o1[i] *= alpha; s0[i] -= dlt; s1[i] -= dlt; }
        }
        float la, lb, lc, ld;
#pragma unroll
        for (int r = 0; r < 16; ++r) { s0[r] = __builtin_amdgcn_exp2f(s0[r]); s1[r] = __builtin_amdgcn_exp2f(s1[r]);
            if (r == 0) { la = s0[r]; lb = s1[r]; } else if (r == 1) { lc = s0[r]; ld = s1[r]; }
            else if ((r & 1) == 0) { la += s0[r]; OPQ(la); lb += s1[r]; OPQ(lb); } else { lc += s0[r]; OPQ(lc); ld += s1[r]; OPQ(ld); } }
        la += lb; OPQ(la); lc += ld; OPQ(lc); lrun += la; OPQ(lrun); lrun += lc;
        union { bf16x8 v; unsigned u[4]; } f0, f1, f2, f3;
#pragma unroll
        for (int e = 0; e < 4; ++e) { f0.u[e] = cvtpk(s0[2 * e], s0[2 * e + 1]); f1.u[e] = cvtpk(s0[8 + 2 * e], s0[8 + 2 * e + 1]); f2.u[e] = cvtpk(s1[2 * e], s1[2 * e + 1]); f3.u[e] = cvtpk(s1[8 + 2 * e], s1[8 + 2 * e + 1]); }
        o0 = __builtin_amdgcn_mfma_f32_32x32x16_bf16(vf[0], f0.v, o0, 0, 0, 0); o1 = __builtin_amdgcn_mfma_f32_32x32x16_bf16(vf[1], f0.v, o1, 0, 0, 0);
        o0 = __builtin_amdgcn_mfma_f32_32x32x16_bf16(vf[2], f1.v, o0, 0, 0, 0); o1 = __builtin_amdgcn_mfma_f32_32x32x16_bf16(vf[3], f1.v, o1, 0, 0, 0);
        o0 = __builtin_amdgcn_mfma_f32_32x32x16_bf16(vf[4], f2.v, o0, 0, 0, 0); o1 = __builtin_amdgcn_mfma_f32_32x32x16_bf16(vf[5], f2.v, o1, 0, 0, 0);
        o0 = __builtin_amdgcn_mfma_f32_32x32x16_bf16(vf[6], f3.v, o0, 0, 0, 0); o1 = __builtin_amdgcn_mfma_f32_32x32x16_bf16(vf[7], f3.v, o1, 0, 0, 0);
    }
    lrun += __shfl_xor(lrun, 32); const float inv = 1.0f / lrun; float sq = 0.f;
#pragma unroll
    for (int i = 0; i < 16; ++i) { o0[i] *= inv; o1[i] *= inv; sq += o0[i] * o0[i] + o1[i] * o1[i]; }
    sq += __shfl_xor(sq, 32);
    const size_t m = (size_t)b * SEQ + q0 + ql;
    if (hh == 0) ((float*)(ws + WS_SSQ))[m * 16 + 8 + h] = sq;
    bf16* y = (bf16*)(ws + WS_Y) + m * 1024 + 512 + h * 64 + 4 * hh;
#pragma unroll
    for (int g4 = 0; g4 < 4; ++g4) { uint2 w0, w1; w0.x = cvtpk(o0[4 * g4], o0[4 * g4 + 1]); w0.y = cvtpk(o0[4 * g4 + 2], o0[4 * g4 + 3]); w1.x = cvtpk(o1[4 * g4], o1[4 * g4 + 1]); w1.y = cvtpk(o1[4 * g4 + 2], o1[4 * g4 + 3]);
        *(uint2*)(y + 8 * g4) = w0; *(uint2*)(y + 32 + 8 * g4) = w1; }
    __syncthreads();
}

__device__ __forceinline__ void ssd_state_pass(int gtid) {
    unsigned char* ws = aws();
    if (gtid < 64 * 2048) {
        const int bhd = gtid >> 11, e = (gtid & 2047) * 4, dir = bhd & 1, h = (bhd >> 1) & 7, b = bhd >> 4;
        const float* dtc = (const float*)(ws + WS_DTC); const float* st = aout(); bf16* sin = (bf16*)(ws + WS_SIN);
        f32x4 v[16]; float d[16];
#pragma unroll
        for (int k = 0; k < 16; ++k) { v[k] = *(const f32x4*)(st + ((size_t)((b * 16 + k) * 8 + h) * 2 + dir) * 8192 + e);
            const size_t mt = (size_t)b * SEQ + (size_t)k * 256 + (dir == 0 ? 255 : 0); d[k] = __expf(dtc[(mt * 8 + h) * 4 + 2 + dir]); }
        f32x4 S = (f32x4){0.f, 0.f, 0.f, 0.f};
        bf16* o = sin + ((size_t)((b * 16) * 8 + h) * 2 + dir) * 8192 + e; constexpr size_t CS = (size_t)8 * 2 * 8192;
        if (dir == 0) {
#pragma unroll
            for (int k = 0; k < 16; ++k) { *(uint2*)(o + k * CS) = make_uint2(cvtpk(S[0], S[1]), cvtpk(S[2], S[3])); S = S * d[k] + v[k]; }
        } else {
#pragma unroll
            for (int k = 15; k >= 0; --k) { *(uint2*)(o + k * CS) = make_uint2(cvtpk(S[0], S[1]), cvtpk(S[2], S[3])); S = S * d[k] + v[k]; }
        }
    }
}
__device__ __forceinline__ void sp_arrive(unsigned* cnt, int tid) {
    asm volatile("s_waitcnt vmcnt(0)" ::: "memory"); __syncthreads();
    if (tid == 0) { __builtin_amdgcn_fence(__ATOMIC_RELEASE, "agent"); asm volatile("s_waitcnt vmcnt(0)" ::: "memory"); (void)xb_add(cnt, 1u); }
}
__device__ __forceinline__ void sp_wait(unsigned* cnt, unsigned G, int tid) {
    if (tid == 0) { unsigned sp = 0; while (xb_ld(cnt) < G) { __builtin_amdgcn_s_sleep(2); if (++sp > (1u << 22)) break; }
        __builtin_amdgcn_fence(__ATOMIC_ACQUIRE, "agent"); asm volatile("s_waitcnt vmcnt(0)" ::: "memory"); }
    __syncthreads();
}

constexpr int O_BM = 0, O_BM_PITCH = 272, O_S = 256 * 272, O_S_PITCH = 272, O_X = O_S + 2 * 64 * O_S_PITCH, O_X_PITCH = 192;
static_assert(O_X + 256 * O_X_PITCH <= TAB_OFF, "SSD out unit LDS (RTAB is dead in this phase)");

__device__ __forceinline__ void ssd_out_unit(LAS unsigned char* lds, int L, int unit, int tid, int wave, int lane, int abl = 0) {
    unsigned char* ws = aws();
    const int h = unit & 7, c = (unit >> 3) & 15, b = unit >> 7, g = h >> 2, hh = lane >> 5, ql = lane & 31;
    const size_t m0 = (size_t)b * SEQ + (size_t)c * 256;
    const bf16* xc = (const bf16*)(ws + WS_XBCC); const float* dtc = (const float*)(ws + WS_DTC);
    LAS float* tF = (LAS float*)(lds + TAB_OFF); LAS float* tB = tF + 256; LAS float* tD = tF + 512;
    int nst_ = __builtin_amdgcn_readfirstlane(REPB(16) ? 2 : (abl == 1 ? 0 : 1));
    for (int st_ = 0; st_ < nst_; ++st_) {
    if (st_ > 0) __syncthreads();
    if (tid < 256) { const f32x4 v = *(const f32x4*)(dtc + ((m0 + tid) * 8 + h) * 4);
        tF[tid] = v[2] * 1.4426950408889634f - __builtin_amdgcn_logf(v[0]); tB[tid] = v[3] * 1.4426950408889634f - __builtin_amdgcn_logf(v[1]); tD[tid] = v[0] + v[1]; }
#pragma unroll
    for (int r = 0; r < 8; ++r) { const int id = tid + 512 * r, s = id >> 4, c8 = id & 15; lds_st16(lds + O_BM + s * O_BM_PITCH + 16 * c8, *(const uint4*)(xc + (m0 + s) * 1024 + 512 + g * 128 + 8 * c8)); }
#pragma unroll
    for (int r = 0; r < 4; ++r) { const int id = tid + 512 * r, s = id >> 3, c8 = id & 7; lds_st16(lds + O_X + s * O_X_PITCH + 16 * c8, *(const uint4*)(xc + (m0 + s) * 1024 + h * 64 + 8 * c8)); }
    {
        const bf16* sin = (const bf16*)(ws + WS_SIN) + ((size_t)((b * 16 + c) * 8 + h) * 2) * 8192;
#pragma unroll
        for (int i = 0; i < 4; ++i) { const int id = tid + 512 * i, dir = id >> 10, e = (id & 1023) * 8, p = e >> 7, nn = e & 127;
            lds_st16(lds + O_S + dir * 64 * O_S_PITCH + p * O_S_PITCH + nn * 2, *(const uint4*)(sin + (size_t)dir * 8192 + e)); }
    }
    }
    bf16x8 cf[8];
#pragma unroll
    for (int ks = 0; ks < 8; ++ks) cf[ks] = *(const bf16x8*)(xc + (m0 + 32 * wave + ql) * 1024 + 768 + g * 128 + 16 * ks + 8 * hh);
    const f32x4 mine = *(const f32x4*)(dtc + ((m0 + 32 * wave + ql) * 8 + h) * 4);
    __syncthreads();
    const float clf = mine[2] * 1.4426950408889634f, clb = mine[3] * 1.4426950408889634f;
    f32x16 yf0, yf1, yb0, yb1;
#pragma unroll
    for (int i = 0; i < 16; ++i) { yf0[i] = 0.f; yf1[i] = 0.f; yb0[i] = 0.f; yb1[i] = 0.f; }
    if (abl != 2)
#pragma unroll
    for (int kh = 0; kh < 2; ++kh) {
        bf16x8 as[4][4];
#pragma unroll
        for (int k4 = 0; k4 < 4; ++k4) { const LAS unsigned char* sp = lds + O_S + (16 * (4 * kh + k4) + 8 * hh) * 2;
#pragma unroll
            for (int i = 0; i < 4; ++i) as[k4][i] = *(const LAS bf16x8*)(sp + (32 * i + ql) * O_S_PITCH); }
#pragma unroll
        for (int k4 = 0; k4 < 4; ++k4) { const int ks = 4 * kh + k4;
            yf0 = __builtin_amdgcn_mfma_f32_32x32x16_bf16(as[k4][0], cf[ks], yf0, 0, 0, 0); yf1 = __builtin_amdgcn_mfma_f32_32x32x16_bf16(as[k4][1], cf[ks], yf1, 0, 0, 0);
            yb0 = __builtin_amdgcn_mfma_f32_32x32x16_bf16(as[k4][2], cf[ks], yb0, 0, 0, 0); yb1 = __builtin_amdgcn_mfma_f32_32x32x16_bf16(as[k4][3], cf[ks], yb1, 0, 0, 0); }
    }
    { const float ef = __builtin_amdgcn_exp2f(clf), eb = __builtin_amdgcn_exp2f(clb);
#pragma unroll
      for (int i = 0; i < 16; ++i) { yf0[i] = yf0[i] * ef + yb0[i] * eb; yf1[i] = yf1[i] * ef + yb1[i] * eb; } }
    const int lpos = 32 * wave + ql, blk = (lane >> 4) & 1, q4 = (lane & 15) >> 2, p4 = lane & 3;
    bf16x8 am[8]; v4i16 xt[8];
#define SSD_LD_AM(sb_) do { _Pragma("unroll") for (int ks = 0; ks < 8; ++ks) am[ks] = *(const LAS bf16x8*)(lds + O_BM + (32 * (sb_) + ql) * O_BM_PITCH + (16 * ks + 8 * hh) * 2); } while (0)
#define SSD_LD_XT(sb_) do { _Pragma("unroll") for (int s2 = 0; s2 < 2; ++s2) { const LAS unsigned char* xp = lds + O_X + (32 * (sb_) + 16 * s2 + 4 * hh + q4) * O_X_PITCH + (16 * blk + 4 * p4) * 2; \
            xt[4 * s2] = tr4(xp); xt[4 * s2 + 1] = tr4(xp + 8 * O_X_PITCH); xt[4 * s2 + 2] = tr4(xp + 64); xt[4 * s2 + 3] = tr4(xp + 8 * O_X_PITCH + 64); } } while (0)
    SSD_LD_AM(0); SSD_LD_XT(0);
#pragma unroll 1
    for (int sb = 0; sb < (abl == 3 ? 0 : 8); ++sb) {
        const int sn = sb < 7 ? sb + 1 : 7;
        __builtin_amdgcn_sched_barrier(0);
        f32x16 gt;
#pragma unroll
        for (int i = 0; i < 16; ++i) gt[i] = 0.f;
#pragma unroll
        for (int ks = 0; ks < 8; ++ks) gt = __builtin_amdgcn_mfma_f32_32x32x16_bf16(am[ks], cf[ks], gt, 0, 0, 0);
        __builtin_amdgcn_sched_barrier(0);
        SSD_LD_AM(sn);
        __builtin_amdgcn_sched_barrier(0);
        const int sbase = 32 * sb + 4 * hh;
        if (sb < wave) {
#pragma unroll
            for (int i = 0; i < 4; ++i) { const f32x4 t = *(const LAS f32x4*)(tF + sbase + 8 * i);
#pragma unroll
                for (int e = 0; e < 4; ++e) gt[4 * i + e] *= __builtin_amdgcn_exp2f(clf - t[e]); }
        } else if (sb > wave) {
#pragma unroll
            for (int i = 0; i < 4; ++i) { const f32x4 t = *(const LAS f32x4*)(tB + sbase + 8 * i);
#pragma unroll
                for (int e = 0; e < 4; ++e) gt[4 * i + e] *= __builtin_amdgcn_exp2f(clb - t[e]); }
        } else {
#pragma unroll
            for (int i = 0; i < 4; ++i) { const f32x4 a = *(const LAS f32x4*)(tF + sbase + 8 * i), bq = *(const LAS f32x4*)(tB + sbase + 8 * i), d = *(const LAS f32x4*)(tD + sbase + 8 * i);
#pragma unroll
                for (int e = 0; e < 4; ++e) { const int s = sbase + 8 * i + e; const float arg = s < lpos ? clf - a[e] : clb - bq[e];
                    const float w = __builtin_amdgcn_exp2f(arg); gt[4 * i + e] *= s == lpos ? d[e] : w; } }
        }
#pragma unroll
        for (int s2 = 0; s2 < 2; ++s2) {
            union { bf16x8 v; unsigned u[4]; } wfz; wfz.u[0] = cvtpk(gt[8 * s2 + 0], gt[8 * s2 + 1]); wfz.u[1] = cvtpk(gt[8 * s2 + 2], gt[8 * s2 + 3]); wfz.u[2] = cvtpk(gt[8 * s2 + 4], gt[8 * s2 + 5]); wfz.u[3] = cvtpk(gt[8 * s2 + 6], gt[8 * s2 + 7]);
            const bf16x8 x0 = cat4(xt[4 * s2], xt[4 * s2 + 1]), x1 = cat4(xt[4 * s2 + 2], xt[4 * s2 + 3]);
            yf0 = __builtin_amdgcn_mfma_f32_32x32x16_bf16(x0, wfz.v, yf0, 0, 0, 0); yf1 = __builtin_amdgcn_mfma_f32_32x32x16_bf16(x1, wfz.v, yf1, 0, 0, 0);
        }
        __builtin_amdgcn_sched_barrier(0);
        SSD_LD_XT(sn);
    }
#undef SSD_LD_AM
#undef SSD_LD_XT
    {
        const float Dh = ain(I_SSDD)[L * 8 + h]; const size_t m = m0 + lpos; const bf16* z = (const bf16*)(ws + WS_Z) + m * 512 + h * 64 + 4 * hh;
        bf16* y = (bf16*)(ws + WS_Y) + m * 1024 + h * 64 + 4 * hh; float sq = 0.f;
        uint2 zall[8];
#pragma unroll
        for (int i = 0; i < 8; ++i) zall[i] = *(const uint2*)(z + 8 * i);
#pragma unroll
        for (int pb = 0; pb < 2; ++pb)
#pragma unroll
            for (int g4 = 0; g4 < 4; ++g4) {
                const int pp = 32 * pb + 8 * g4 + 4 * hh; const v2u xw = *(const LAS v2u*)(lds + O_X + lpos * O_X_PITCH + pp * 2); const uint2 zw = zall[4 * pb + g4];
                const float xv[4] = {bflo(xw.x), bfhi(xw.x), bflo(xw.y), bfhi(xw.y)}, zv[4] = {bflo(zw.x), bfhi(zw.x), bflo(zw.y), bfhi(zw.y)}; float o[4];
#pragma unroll
                for (int e = 0; e < 4; ++e) { const float yv = (pb == 0 ? yf0[4 * g4 + e] : yf1[4 * g4 + e]) + Dh * xv[e]; o[e] = yv * silu_f(zv[e]); sq += o[e] * o[e]; }
                uint2 w; w.x = cvtpk(o[0], o[1]); w.y = cvtpk(o[2], o[3]); *(uint2*)(y + 32 * pb + 8 * g4) = w;
            }
        sq += __shfl_xor(sq, 32);
        if (hh == 0 && abl == 0) ((float*)(ws + WS_SSQ))[m * 16 + h] = sq;
    }
    __syncthreads();
}
__device__ __forceinline__ void build_out_tab(LAS unsigned char* lds, int pm, int tid) {
    if (tid < 256) { const float* q = (const float*)(aws() + WS_SSQ) + ((size_t)pm * 256 + tid) * 16; float rs[4];
#pragma unroll
        for (int g = 0; g < 4; ++g) { const f32x4 v = *(const f32x4*)(q + 4 * g); rs[g] = rsqrtf(((v[0] + v[1]) + (v[2] + v[3])) * (1.0f / 256.0f) + EPS); }
        ((LAS f32x4*)(lds + TAB_OFF))[tid] = (f32x4){rs[0] / rs[1], rs[1] / rs[2], rs[2] / rs[3], rs[3]}; }
    __syncthreads();
}

constexpr int NPHASES = 1 + 9 * DEPTH;

#define PHASE_IDS \
    int zero = 0; asm volatile("" : "+s"(zero)); \
    const int wave = __builtin_amdgcn_readfirstlane((int)threadIdx.x >> 6) + zero; \
    const int G = (int)gridDim.x + zero, bx = (int)blockIdx.x + zero; \
    const int vcu = (G % 8 == 0) ? (bx % 8) * (G / 8) + bx / 8 : bx; \
    const int gw = vcu * NWAVES + wave, NGW = G * NWAVES, NT = G * NWAVES * 64; \
    int tid = threadIdx.x; asm volatile("" : "+v"(tid)); const int lane = tid & 63, gtid = bx * (NWAVES * 64) + tid; \
    unsigned char* ws = aws(); (void)lane; (void)gtid; (void)gw; (void)NGW; (void)NT; (void)wave; (void)ws; (void)vcu;
#define GRID_BAR() do { XcdBarrier bar; bar.bar = (unsigned*)(aws() + WS_CTL) + CW_BAR; bar.x = xb_xcc_id(); bar.st = (volatile LAS unsigned*)(lds + MISC_OFF) + 8; xcd_barrier(bar); } while (0)
#define IN(k) (lo <= (k) && (k) < hi)
#define SEAM(k) do { if ((k) + 1 < hi) { int nb_ = REPB(14) ? 2 : 1; asm volatile("" : "+s"(nb_)); for (int r_ = 0; r_ < nb_; ++r_) GRID_BAR(); } } while (0)

template <int L, int PR = 0> __device__ __forceinline__ void layer_phases(LAS unsigned char* lds, int lo, int hi) {
    constexpr int P = 1 + 9 * L;
    if (IN(P + 0)) {
        PHASE_IDS
        pg8::Gemm g{(const bf16*)(ws + WS_XB), (const bf16*)(ws + WS_WGU1), M, 2 * FF, D}; pg8::StaticOrder S; S.init(M, 2 * FF, G, bx);
        PG8_LAS float* rt = (PG8_LAS float*)(lds + RTAB_OFF); const bool ut = fill_rstd_tab(rt, S, (const float*)(ws + WS_SS), tid);
        EpiGU E{(bf16*)(ws + WS_HB), (const float*)(ws + WS_SS), rt, ut};
        pg8::gemm_phase<EpiGU, pg8::StaticOrder, true, true>(lds, g, S, E);
        if (REPB(11)) { EpiDry Ed; pg8::gemm_phase<EpiDry, pg8::StaticOrder, true, true>(lds, g, S, Ed); }
        if (REPB(1)) pg8::gemm_phase<EpiGU, pg8::StaticOrder, true, true>(lds, g, S, E);
        { TAIL_WORKER(64 * 22) int ntr_ = REPB(15) ? 2 : 1; asm volatile("" : "+s"(ntr_)); for (int tr_ = 0; tr_ < ntr_; ++tr_) if (tail_) { convert_job<J_D1>(L, lds, tw_, tnw_, wave, lane, 0); convert_job<J_IN>(L, lds, tw_, tnw_, wave, lane, 704); if (L == 1) convert_job<J_UQKV>(1, lds, tw_, tnw_, wave, lane, 1408); } }
        SEAM(P + 0);
    }
    if (IN(P + 1)) {
        PHASE_IDS
        pg8::Gemm g{(const bf16*)(ws + WS_HB), (const bf16*)(ws + WS_WD1), M, D, FF}; pg8::StaticOrder S; S.init(M, D, G, bx);
        if (REPB(5)) { EpiDry Ed; pg8::gemm_phase<EpiDry, pg8::StaticOrder, false, true>(lds, g, S, Ed); }
        EpiDown<0, false> E{aout(), (bf16*)(ws + WS_XB), (float*)(ws + WS_SS), 0.5f, nullptr};
        pg8::gemm_phase<EpiDown<0, false>, pg8::StaticOrder, false, true>(lds, g, S, E);
        SEAM(P + 1);
    }
    if (IN(P + 2)) {
        PHASE_IDS
        pg8::Gemm g{(const bf16*)(ws + WS_XB), (const bf16*)(ws + WS_WIN), M, NPROJP, D}; pg8::StaticOrder S; S.init(M, NPROJP, G, bx);
        PG8_LAS float* rt = (PG8_LAS float*)(lds + RTAB_OFF); const bool ut = fill_rstd_tab(rt, S, (const float*)(ws + WS_SS), tid);
        EpiProj E{(bf16*)(ws + WS_PROJ), (float*)(ws + WS_DTRAW), (const float*)(ws + WS_SS), rt, ut};
        pg8::gemm_phase<EpiProj, pg8::StaticOrder, true, true>(lds, g, S, E);
        if (REPB(2)) pg8::gemm_phase<EpiProj, pg8::StaticOrder, true, true>(lds, g, S, E);
        { TAIL_WORKER(64 * 10) int ntr_ = REPB(15) ? 2 : 1; asm volatile("" : "+s"(ntr_)); for (int tr_ = 0; tr_ < ntr_; ++tr_) if (tail_) { convert_job<J_OUT>(L, lds, tw_, tnw_, wave, lane, 0); convert_job<J_GU2>(L, lds, tw_, tnw_, wave, lane, 256); } }
        SEAM(P + 2);
    }
    if (IN(P + 3)) {
        PHASE_IDS
        { int nrep = (REPB(3) || REPB(12)) ? REP_N : 1; asm volatile("" : "+s"(nrep));
          for (int r = 0; r < nrep; ++r) for (int u = vcu; u < 512; u += G) ssd_state_unit(lds, L, G == 256 ? 64 * (vcu >> 5) + (vcu & 31) + (u >= 256 ? 32 : 0) : u, tid, wave, lane); }
#if defined(T_STOP) && defined(PREFIX_K)
        if (PR) { if (T_STOP > 0) for (int u = vcu; u < 256; u += G) token_prep_unit<T_STOP>(lds, L, u, tid, wave, lane, true); }
        else
#endif
        for (int u = vcu; u < 256; u += G) token_prep_unit(lds, L, u, tid, wave, lane, true);
        if (REPB(3) || REPB(13)) { for (int u = vcu; u < 256; u += G) token_prep_unit(lds, L, u, tid, wave, lane, false); }
        SEAM(P + 3);
    }
    if (IN(P + 4)) {
        PHASE_IDS
        ssd_state_pass(gtid); sp_arrive((unsigned*)(ws + WS_CTL) + CW_SP + 64 * L, tid);
#if defined(MIX_STOP) && defined(PREFIX_K)
#define MIXGO(n) (hi != PREFIX_K || (n) <= MIX_STOP)
#else
#define MIXGO(n) true
#endif
        if (MIXGO(2))
        { int nrep = REPB(8) ? REP_N : 1; asm volatile("" : "+s"(nrep));
          for (int r = 0; r < nrep; ++r) for (int u = vcu; u < 256; u += G) attn_unit<96, false>(lds, L, u, tid, wave, lane); }
#ifdef ABL_N
        for (int u = vcu; u < 256; u += G) attn_unit<96, false, ABL_N>(lds, L, u, tid, wave, lane);
#endif
        if (MIXGO(3))
        { int nrep = REPB(9) ? REP_N : 1; asm volatile("" : "+s"(nrep));
          for (int r = 0; r < nrep; ++r) for (int u = vcu; u < 256; u += G) swa_unit(lds, L, u, tid, wave, lane); }
        if (MIXGO(4)) sp_wait((unsigned*)(ws + WS_CTL) + CW_SP + 64 * L, (unsigned)G, tid);
        if (MIXGO(5))
        { int nrep = REPB(10) ? REP_N : 1; asm volatile("" : "+s"(nrep));
#ifdef ABL_S
          for (int r = 0; r < nrep; ++r) { const int ab_ = __builtin_amdgcn_readfirstlane(r > 0 ? ABL_S : 0); for (int u = vcu; u < 512; u += G) ssd_out_unit(lds, L, G == 256 ? 64 * (vcu >> 5) + (vcu & 31) + (u >= 256 ? 32 : 0) : u, tid, wave, lane, ab_); } }
#else
          for (int r = 0; r < nrep; ++r) for (int u = vcu; u < 512; u += G) ssd_out_unit(lds, L, G == 256 ? 64 * (vcu >> 5) + (vcu & 31) + (u >= 256 ? 32 : 0) : u, tid, wave, lane); }
#endif
        SEAM(P + 5);
    }
    if (IN(P + 6)) {
        PHASE_IDS
        pg8::Gemm g{(const bf16*)(ws + WS_Y), (const bf16*)(ws + WS_WOUT), M, D, D}; pg8::StaticOrder S; S.init(M, D, G, bx);
        if (REPB(6)) { EpiDry Ed; pg8::gemm_phase<EpiDry, pg8::StaticOrder, false, true>(lds, g, S, Ed); }
        pg8::Unit u0; if (S.next(0, u0)) build_out_tab(lds, u0.pm, tid);
        EpiDown<1, false> E{aout(), (bf16*)(ws + WS_XB), (float*)(ws + WS_SS), 1.0f, (const PG8_LAS float*)(lds + TAB_OFF)};
        pg8::gemm_phase<EpiDown<1, false>, pg8::StaticOrder, false, true>(lds, g, S, E);
        SEAM(P + 6);
    }
    if (IN(P + 7)) {
        PHASE_IDS
        pg8::Gemm g{(const bf16*)(ws + WS_XB), (const bf16*)(ws + WS_WGU2), M, 2 * FF, D}; pg8::StaticOrder S; S.init(M, 2 * FF, G, bx);
        PG8_LAS float* rt = (PG8_LAS float*)(lds + RTAB_OFF); const bool ut = fill_rstd_tab(rt, S, (const float*)(ws + WS_SS), tid);
        EpiGU E{(bf16*)(ws + WS_HB), (const float*)(ws + WS_SS), rt, ut};
        pg8::gemm_phase<EpiGU, pg8::StaticOrder, true, true>(lds, g, S, E);
        if (REPB(11)) { EpiDry Ed; pg8::gemm_phase<EpiDry, pg8::StaticOrder, true, true>(lds, g, S, Ed); }
        if (REPB(1)) pg8::gemm_phase<EpiGU, pg8::StaticOrder, true, true>(lds, g, S, E);
        { TAIL_WORKER(64 * 22) int ntr_ = REPB(15) ? 2 : 1; asm volatile("" : "+s"(ntr_)); for (int tr_ = 0; tr_ < ntr_; ++tr_) if (tail_) { convert_job<J_D2>(L, lds, tw_, tnw_, wave, lane, 0); if (L == 0) convert_job<J_GU1>(1, lds, tw_, tnw_, wave, lane, 704); } }
        SEAM(P + 7);
    }
    if (IN(P + 8)) {
        PHASE_IDS
        pg8::Gemm g{(const bf16*)(ws + WS_HB), (const bf16*)(ws + WS_WD2), M, D, FF}; pg8::StaticOrder S; S.init(M, D, G, bx);
        if (REPB(5)) { EpiDry Ed; pg8::gemm_phase<EpiDry, pg8::StaticOrder, false, true>(lds, g, S, Ed); }
        constexpr bool FIN = (L == DEPTH - 1); typedef EpiDown<0, FIN> EpiLast;
        EpiLast E{aout(), (bf16*)(ws + WS_XB), (float*)(ws + WS_SS), 0.5f, nullptr};
        pg8::gemm_phase<EpiLast, pg8::StaticOrder, false, true>(lds, g, S, E);
        SEAM(P + 8);
    }
}

template <int PR> __device__ __forceinline__ void mk_body(LAS unsigned char* lds) {
    for (int u = threadIdx.x; u < (LDS_BYTES - LDSCTL_OFF) / 4; u += NWAVES * 64) ((LAS unsigned*)(lds + LDSCTL_OFF))[u] = 0u;
    __syncthreads();
    const int lo = ((const int*)__builtin_amdgcn_kernarg_segment_ptr())[2 * (N_IN + 2)], hi = ((const int*)__builtin_amdgcn_kernarg_segment_ptr())[2 * (N_IN + 2) + 1];
    if (hi - lo > 1) (void)xcd_barrier_post((unsigned*)(aws() + WS_CTL) + CW_BAR, (volatile LAS unsigned*)(lds + MISC_OFF) + 8);
    if (IN(0)) {
        PHASE_IDS
#ifndef NO_P0
        convert_job<J_GU1>(0, lds, gw, NGW, wave, lane); convert_job<J_UQKV>(0, lds, gw, NGW, wave, lane);
        p0_x_and_tables(gw, NGW, lane, gtid, NT);
        if (REPB(0)) { convert_job<J_GU1>(0, lds, gw, NGW, wave, lane); convert_job<J_UQKV>(0, lds, gw, NGW, wave, lane); p0_x_and_tables(gw, NGW, lane, gtid, NT); }
#endif
        SEAM(0);
    }
    layer_phases<0, PR>(lds, lo, hi);
    layer_phases<1, PR>(lds, lo, hi);
}
__global__ void __launch_bounds__(NWAVES * 64, 2) mk_fwd(Args args) {
    extern __shared__ __attribute__((aligned(16))) unsigned char lds_raw[];
    mk_body<0>((LAS unsigned char*)lds_raw);
}
#ifdef PREFIX_K
__global__ void __launch_bounds__(NWAVES * 64, 2) mk_probe(Args args) {
#ifdef __HIP_DEVICE_COMPILE__
    extern __shared__ __attribute__((aligned(16))) unsigned char lds_raw[];
    mk_body<1>((LAS unsigned char*)lds_raw);
#endif
}
#endif


extern "C" void kernel_launch(void* const* d_in, const int* in_sizes, int n_in, void* d_out, int out_size, void* d_ws, size_t ws_size, hipStream_t stream) {
    static int grid = 0;
    if (grid == 0) {
        if (n_in != N_IN || out_size != M * D || ws_size < WS_END) { fprintf(stderr, "kernel_launch: unexpected shapes (n_in %d out %d ws %zu)\n", n_in, out_size, ws_size); grid = -1; return; }
        int dev = 0, cus = 0, per_cu = 0;
        if (hipGetDevice(&dev) != hipSuccess || hipDeviceGetAttribute(&cus, hipDeviceAttributeMultiprocessorCount, dev) != hipSuccess) { grid = -1; return; }
#ifdef PREFIX_K
        (void)hipFuncSetAttribute((const void*)mk_probe, hipFuncAttributeMaxDynamicSharedMemorySize, LDS_BYTES);
#endif
        if (hipFuncSetAttribute((const void*)mk_fwd, hipFuncAttributeMaxDynamicSharedMemorySize, LDS_BYTES) != hipSuccess) { fprintf(stderr, "kernel_launch: hipFuncSetAttribute failed\n"); grid = -1; return; }
        if (hipOccupancyMaxActiveBlocksPerMultiprocessor(&per_cu, (const void*)mk_fwd, NWAVES * 64, LDS_BYTES) != hipSuccess || per_cu < 1) fprintf(stderr, "kernel_launch: occupancy query says %d\n", per_cu);
        (void)hipGetLastError();
        grid = cus;
    }
    if (grid < 0) return;
    (void)hipMemsetAsync((char*)d_ws + WS_CTL, 0, CTL_ZERO_BYTES, stream);
    Args a{};
    for (int i = 0; i < N_IN; ++i) a.in[i] = (const float*)d_in[i];
    a.out = (float*)d_out; a.ws = (unsigned char*)d_ws;
#ifdef PREFIX_K
#ifndef PREFIX_REP
#define PREFIX_REP 1
#endif
    a.ph_lo = 0; a.ph_hi = PREFIX_K;
    for (int pr_ = 0; pr_ < PREFIX_REP; ++pr_) {
        hipLaunchKernelGGL(mk_probe, dim3(grid), dim3(NWAVES * 64), LDS_BYTES, stream, a);
        (void)hipMemsetAsync((char*)d_ws + WS_CTL, 0, CTL_ZERO_BYTES, stream);
    }
#endif
    a.ph_lo = 0; a.ph_hi = NPHASES;
    hipLaunchKernelGGL(mk_fwd, dim3(grid), dim3(NWAVES * 64), LDS_BYTES, stream, a);
}
```

```cpp
#include <hip/hip_runtime.h>
#include <cstdio>
#include <cstdint>

namespace pg8 {
#define PG8_LAS __attribute__((address_space(3)))

typedef unsigned short bf16_t;
typedef short bf16x8 __attribute__((ext_vector_type(8)));
typedef float f32x4 __attribute__((ext_vector_type(4)));
typedef unsigned u32x4 __attribute__((ext_vector_type(4)));
constexpr int BM = 256, BK = 64, HALF = 128, HTB = HALF * BK * 2  , STAGE_BYTES = 8 * HTB, NXCD = 8, WGM = 8;

__host__ __device__ __forceinline__ int lds_byte(int r, int c) { const int st = (r >> 4) * 2 + (c >> 5), rr = r & 15, cc = c & 31, ob = rr * 64 + cc * 2; return st * 1024 + (ob ^ (((ob >> 9) & 1) << 5)); }
__host__ __device__ __forceinline__ void stage_rc(int b, int& R, int& C) { const int st = b / 1024, sb = b % 1024, swz = sb ^ (((sb >> 9) & 1) << 5); R = (st >> 1) * 16 + swz / 64; C = (st & 1) * 32 + (swz % 64) / 2; }
__host__ __device__ __forceinline__ int perm32(int rho) { const int n = rho >> 4, i = rho & 15; return 8 * (i >> 2) + 4 * n + (i & 3); }

struct Unit { int pm, pn; };
struct Gemm { const bf16_t* A; const bf16_t* Bt; int M, N, K; };

struct StaticOrder {
    int nM, nN, nwg, G, c;
    __host__ __device__ __forceinline__ void init(int M, int N, int G_, int c_) { nM = M / BM; nN = N / BM; nwg = nM * nN; G = G_; c = c_; }
    __host__ __device__ __forceinline__ bool next(int i, Unit& u) const {
        const long L = (long)i * G + c; if (L >= nwg) return false;
        int wgid = (int)L; { const int q = nwg / NXCD, r = nwg % NXCD, xcd = wgid % NXCD, off = wgid / NXCD; wgid = (xcd < r ? xcd * (q + 1) : r * (q + 1) + (xcd - r) * q) + off; }
        const int nig = WGM * nN, gid = wgid / nig, fm = gid * WGM, gsz = (nM - fm) < WGM ? (nM - fm) : WGM;
        u.pm = fm + ((wgid % nig) % gsz); u.pn = (wgid % nig) / gsz; return true;
    }
    __device__ __forceinline__ void a_ready(const Unit&) const {}
    __device__ __forceinline__ void done(const Unit&) const {}
};


__device__ __forceinline__ unsigned cvt_pk_bf16(float lo, float hi) { unsigned r; asm volatile("v_cvt_pk_bf16_f32 %0, %1, %2" : "=v"(r) : "v"(lo), "v"(hi)); return r; }

template <class Epi, class Sched, bool ALIGN_EPI = false, bool SP2 = false>
__device__ __forceinline__ void gemm_phase(PG8_LAS unsigned char* lds, const Gemm g, const Sched& S, const Epi& E) {
    int tid_ = threadIdx.x; asm volatile("" : "+v"(tid_)); const int tid = tid_, wid = __builtin_amdgcn_readfirstlane(tid >> 6), lane = tid & 63, wr = wid >> 2, wc = wid & 3, fr = lane & 15, fq = lane >> 4;
    const int K = g.K, nt = K / BK;
    unsigned voffA[2], voffB[2];
#pragma unroll
    for (int i = 0; i < 2; ++i) { int R, C; stage_rc(tid * 16 + i * 8192, R, C); const int Rb = Epi::PERM ? ((R & ~31) + perm32(R & 31)) : R;
        voffA[i] = (unsigned)(R * K + C) * 2u; voffB[i] = (unsigned)(Rb * K + C) * 2u; }
    const size_t kstep = (size_t)(BK * 2);
    const size_t hstep = (size_t)HALF * K * 2;
    const size_t tstep = 2 * hstep;
    const unsigned ldsw = (unsigned)wid * 1024u;
    const int aoff = lds_byte(wr * 64 + fr, fq * 8), boff = lds_byte(wc * 32 + fr, fq * 8);
#define PG8_SA(b, h) (((b) * 2 + (h)) * HTB)
#define PG8_SB(b, h) ((4 + (b) * 2 + (h)) * HTB)
#define PG8_STAGE(bufoff, gbase, voff) do { _Pragma("unroll") for (int _i = 0; _i < 2; ++_i) \
        __builtin_amdgcn_global_load_lds((const unsigned*)((const char*)(gbase) + (voff)[_i]), (PG8_LAS unsigned*)(lds + (bufoff) + ldsw + _i * 8192), 16, 0, 0); } while (0)
#define PG8_STAGE_A(bufoff, gbase, voff) do { _Pragma("unroll") for (int _i = 0; _i < 2; ++_i) \
        __builtin_amdgcn_global_load_lds((const unsigned*)((const char*)(gbase) + (voff)[_i]), (PG8_LAS unsigned*)(lds + (bufoff) + ldsw + _i * 8192), 16, 0, Epi::AUX_A); } while (0)
#define PG8_LDA(dst, b, h) do { _Pragma("unroll") for (int m = 0; m < 4; ++m) _Pragma("unroll") for (int k = 0; k < 2; ++k) dst[m][k] = *(const PG8_LAS bf16x8*)(lds + PG8_SA(b, h) + aoff + m * 2048 + k * 1024); } while (0)
#define PG8_LDB(dst, b, h) do { _Pragma("unroll") for (int n = 0; n < 2; ++n) _Pragma("unroll") for (int k = 0; k < 2; ++k) dst[n][k] = *(const PG8_LAS bf16x8*)(lds + PG8_SB(b, h) + boff + n * 2048 + k * 1024); } while (0)
#define PG8_MMA(ai, bj, At, Bt) do { __builtin_amdgcn_s_setprio(1); _Pragma("unroll") for (int m = 0; m < 4; ++m) _Pragma("unroll") for (int n = 0; n < 2; ++n) _Pragma("unroll") for (int k = 0; k < 2; ++k) \
        acc[ai][bj][m][n] = __builtin_amdgcn_mfma_f32_16x16x32_bf16(Bt[n][k], At[m][k], acc[ai][bj][m][n], 0, 0, 0); __builtin_amdgcn_s_setprio(0); } while (0)
#define PG8_WAIT_V(n) asm volatile("s_waitcnt vmcnt(" #n ")" ::: "memory")
#define PG8_WAIT_L(n) asm volatile("s_waitcnt lgkmcnt(" #n ")" ::: "memory")
#define PG8_BAR __builtin_amdgcn_s_barrier()
#define PG8_SCHED __builtin_amdgcn_sched_barrier(0)
    Unit cur, nxt; int ui = 0;
    if (!S.next(0, cur)) return;
    f32x4 acc[2][2][4][2];
#pragma unroll
    for (int a = 0; a < 2; ++a)
#pragma unroll
        for (int b = 0; b < 2; ++b)
#pragma unroll
            for (int m = 0; m < 4; ++m)
#pragma unroll
                for (int n = 0; n < 2; ++n) acc[a][b][m][n] = (f32x4){0.f, 0.f, 0.f, 0.f};
    bf16x8 At[4][2], B0[2][2], B1[2][2];
    const char* cA = (const char*)g.A + (size_t)cur.pm * tstep; const char* cB = (const char*)g.Bt + (size_t)cur.pn * tstep;
    S.a_ready(cur);
    if constexpr (SP2) {
        PG8_STAGE(PG8_SB(0, 0), cB, voffB); PG8_STAGE(PG8_SB(0, 1), cB + hstep, voffB); PG8_STAGE_A(PG8_SA(0, 0), cA, voffA); PG8_STAGE_A(PG8_SA(0, 1), cA + hstep, voffA);
        if constexpr (Epi::PROHOOK) E.prohook(S, tid);
        if (wr == 1) PG8_BAR;
        PG8_WAIT_V(2); PG8_BAR;
        PG8_STAGE(PG8_SB(1, 0), cB + kstep, voffB); PG8_STAGE_A(PG8_SA(1, 0), cA + kstep, voffA); PG8_STAGE(PG8_SB(1, 1), cB + hstep + kstep, voffB);
        PG8_WAIT_V(6); PG8_BAR;
    } else {
        PG8_STAGE(PG8_SB(0, 0), cB, voffB); PG8_STAGE_A(PG8_SA(0, 0), cA, voffA); PG8_STAGE(PG8_SB(0, 1), cB + hstep, voffB); PG8_STAGE_A(PG8_SA(0, 1), cA + hstep, voffA);
        if constexpr (Epi::PROHOOK) E.prohook(S, tid);
        if (wr == 1) PG8_BAR;
        PG8_WAIT_V(4); PG8_BAR;
        PG8_STAGE(PG8_SB(1, 0), cB + kstep, voffB); PG8_STAGE_A(PG8_SA(1, 0), cA + kstep, voffA); PG8_STAGE(PG8_SB(1, 1), cB + hstep + kstep, voffB);
        PG8_WAIT_V(6); PG8_BAR;
    }
    for (;;) {
        const bool has_next = S.next(ui + 1, nxt);
        const char* nA = has_next ? (const char*)g.A + (size_t)nxt.pm * tstep : cA; const char* nB = has_next ? (const char*)g.Bt + (size_t)nxt.pn * tstep : cB;
        for (int t = 0; t < nt; t += 2) {
            const bool last = (t == nt - 2);
            const char* a1 = cA + (size_t)(t + 1) * kstep;
            const char* a2 = last ? nA : cA + (size_t)(t + 2) * kstep; const char* b2 = last ? nB : cB + (size_t)(t + 2) * kstep;
            const char* a3 = a2 + kstep; const char* b3 = b2 + kstep;
            if (last && has_next) S.a_ready(nxt);
            if constexpr (SP2) {
            PG8_LDB(B0, 0, 0); PG8_LDB(B1, 0, 1); PG8_SCHED; PG8_LDA(At, 0, 0); PG8_STAGE_A(PG8_SA(1, 1), a1 + hstep, voffA);
            PG8_WAIT_V(8); PG8_WAIT_L(0); PG8_BAR; PG8_MMA(0, 0, At, B0); PG8_MMA(0, 1, At, B1); PG8_BAR; PG8_SCHED;
            PG8_LDA(At, 0, 1); PG8_STAGE(PG8_SB(0, 0), b2, voffB); PG8_STAGE(PG8_SB(0, 1), b2 + hstep, voffB); PG8_STAGE_A(PG8_SA(0, 0), a2, voffA);
            PG8_WAIT_V(8); PG8_WAIT_L(0); PG8_BAR; PG8_MMA(1, 0, At, B0); PG8_MMA(1, 1, At, B1); PG8_BAR; PG8_SCHED;
            PG8_LDB(B0, 1, 0); PG8_LDB(B1, 1, 1); PG8_SCHED; PG8_LDA(At, 1, 0); PG8_STAGE_A(PG8_SA(0, 1), a2 + hstep, voffA);
            PG8_WAIT_V(8); PG8_WAIT_L(0); PG8_BAR; PG8_MMA(0, 0, At, B0); PG8_MMA(0, 1, At, B1); PG8_BAR; PG8_SCHED;
            PG8_LDA(At, 1, 1); PG8_STAGE(PG8_SB(1, 0), b3, voffB); PG8_STAGE(PG8_SB(1, 1), b3 + hstep, voffB); PG8_STAGE_A(PG8_SA(1, 0), a3, voffA);
            PG8_WAIT_V(8); PG8_WAIT_L(0); PG8_BAR; PG8_MMA(1, 0, At, B0); PG8_MMA(1, 1, At, B1); PG8_BAR; PG8_SCHED;
            } else {
            PG8_LDB(B0, 0, 0); PG8_SCHED; PG8_LDA(At, 0, 0); PG8_STAGE_A(PG8_SA(1, 1), a1 + hstep, voffA);
            PG8_WAIT_L(8); PG8_BAR; PG8_WAIT_L(0); PG8_MMA(0, 0, At, B0); PG8_BAR; PG8_SCHED;
            PG8_LDB(B1, 0, 1); PG8_STAGE(PG8_SB(0, 0), b2, voffB);
            PG8_BAR; PG8_WAIT_L(0); PG8_MMA(0, 1, At, B1); PG8_BAR;
            PG8_LDA(At, 0, 1); PG8_STAGE_A(PG8_SA(0, 0), a2, voffA);
            PG8_BAR; PG8_WAIT_L(0); PG8_MMA(1, 0, At, B0); PG8_BAR; PG8_SCHED;
            PG8_STAGE(PG8_SB(0, 1), b2 + hstep, voffB);
            PG8_WAIT_V(6); PG8_BAR; PG8_MMA(1, 1, At, B1); PG8_BAR;
            PG8_LDB(B0, 1, 0); PG8_SCHED; PG8_LDA(At, 1, 0); PG8_STAGE_A(PG8_SA(0, 1), a2 + hstep, voffA);
            PG8_WAIT_L(8); PG8_BAR; PG8_WAIT_L(0); PG8_MMA(0, 0, At, B0); PG8_BAR; PG8_SCHED;
            PG8_LDB(B1, 1, 1); PG8_STAGE(PG8_SB(1, 0), b3, voffB);
            PG8_BAR; PG8_WAIT_L(0); PG8_MMA(0, 1, At, B1); PG8_BAR;
            PG8_LDA(At, 1, 1); PG8_STAGE_A(PG8_SA(1, 0), a3, voffA);
            PG8_BAR; PG8_WAIT_L(0); PG8_MMA(1, 0, At, B0); PG8_BAR; PG8_SCHED;
            PG8_STAGE(PG8_SB(1, 1), b3 + hstep, voffB);
            PG8_WAIT_V(6); PG8_BAR; PG8_MMA(1, 1, At, B1); PG8_BAR;
            }
            if constexpr (Epi::KHOOK) { if ((((t + 2) & 3) == 0) && !last) E.khook(acc, (t + 2) / 4 - 1, wr, fr); }
        }
        if constexpr (ALIGN_EPI) { if (wr == 0) PG8_BAR; }
        if constexpr (!Epi::AFTER_DRAIN) { E(acc, cur, wr, wc, fr, fq); S.done(cur); }
        if (!has_next) break;
#pragma unroll
        for (int a = 0; a < 2; ++a)
#pragma unroll
            for (int b = 0; b < 2; ++b)
#pragma unroll
                for (int m = 0; m < 4; ++m)
#pragma unroll
                    for (int n = 0; n < 2; ++n) acc[a][b][m][n] = (f32x4){0.f, 0.f, 0.f, 0.f};
        cur = nxt; cA = nA; cB = nB; ++ui;
        if constexpr (ALIGN_EPI) { if (wr == 1) PG8_BAR; }
    }
    PG8_WAIT_V(0);
    if constexpr (!ALIGN_EPI) { if (wr == 0) PG8_BAR; }
    PG8_BAR;
    if constexpr (Epi::AFTER_DRAIN) { E.fused(acc, cur, wr, wc, fr, fq, lds, wid, lane); S.done(cur); }
#undef PG8_SA
#undef PG8_SB
#undef PG8_STAGE
#undef PG8_STAGE_A
#undef PG8_LDA
#undef PG8_LDB
#undef PG8_MMA
#undef PG8_WAIT_V
#undef PG8_WAIT_L
#undef PG8_BAR
#undef PG8_SCHED
}
}

#define GAS __attribute__((address_space(1)))
#define LAS __attribute__((address_space(3)))
typedef unsigned short bf16;
typedef unsigned v4u __attribute__((ext_vector_type(4)));
typedef float f32x4 __attribute__((ext_vector_type(4)));
typedef short bf16x8 __attribute__((ext_vector_type(8)));
typedef GAS unsigned gu32;
typedef GAS unsigned long long gu64;
#define RLX_AGENT __ATOMIC_RELAXED, __HIP_MEMORY_SCOPE_AGENT
#define LDS_WAIT() asm volatile("s_waitcnt lgkmcnt(0)" ::: "memory")
#define VM_WAIT() asm volatile("s_waitcnt vmcnt(0)" ::: "memory")
__device__ __forceinline__ unsigned long long rt() { return __builtin_amdgcn_s_memrealtime(); }
__device__ __forceinline__ unsigned f2bf(float f) { unsigned u = __builtin_bit_cast(unsigned, f); return (u + 0x7fffu + ((u >> 16) & 1u)) >> 16; }
__device__ __forceinline__ unsigned pk2(float lo, float hi) { return f2bf(lo) | (f2bf(hi) << 16); }

#define XB_TMO      128
#define XB_XCNT(j)  (256  + 64 * (j))
#define XB_XSUB(j)  (1280 + 64 * (j))
#define XB_XGEN(j)  (2304 + 64 * (j))
#define XB_TOP      3328
#define XB_TOPGEN   3392
#define XCD_BAR_WORDS 3456
#define XB_SPIN_CAP (1u << 18)

__device__ __forceinline__ unsigned xb_ld(unsigned* p)              { return __hip_atomic_load(p, __ATOMIC_RELAXED, __HIP_MEMORY_SCOPE_AGENT); }
__device__ __forceinline__ unsigned xb_add(unsigned* p, unsigned v) { return __hip_atomic_fetch_add(p, v, __ATOMIC_RELAXED, __HIP_MEMORY_SCOPE_AGENT); }
__device__ __forceinline__ unsigned xb_xcc_id() { return (unsigned)__builtin_amdgcn_s_getreg((3 << 11) | 20) & 0xFu; }
#define XB_SPIN(cond, bar) do { unsigned _sp = 0; while (cond) { __builtin_amdgcn_s_sleep(1); \
    if ((++_sp & 255u) == 0u) { if (xb_ld(&(bar)[XB_TMO])) break; if (_sp > XB_SPIN_CAP) { atomicAdd(&(bar)[XB_TMO], 1u); break; } } } } while (0)

struct XcdBarrier {
    unsigned* bar; unsigned x;
    volatile LAS unsigned* st;
};

__device__ __forceinline__ XcdBarrier xcd_barrier_post(unsigned* bar, volatile LAS unsigned* st) {
    XcdBarrier b; b.bar = bar; b.x = xb_xcc_id(); b.st = st;
    if (threadIdx.x == 0) (void)xb_add(&bar[XB_XCNT(b.x)], 1u);
    return b;
}
__device__ __forceinline__ void xcd_barrier_complete(unsigned* bar, unsigned x, unsigned& nloc, unsigned& nx) {
    const unsigned G = gridDim.x * gridDim.y * gridDim.z;
    unsigned sum, cnt, mine, sp = 0u;
    for (;;) {
        sum = 0u; cnt = 0u; mine = 0u;
#pragma unroll
        for (unsigned j = 0; j < 16; ++j) { const unsigned c = xb_ld(&bar[XB_XCNT(j)]); sum += c; cnt += (c > 0u) ? 1u : 0u; mine = (j == x) ? c : mine; }
        if (sum == G) break;
        __builtin_amdgcn_s_sleep(1);
        if ((++sp & 255u) == 0u) { if (xb_ld(&bar[XB_TMO])) break; if (sp > XB_SPIN_CAP) { atomicAdd(&bar[XB_TMO], 1u); break; } }
    }
    nloc = mine > 0u ? mine : 1u; nx = cnt > 0u ? cnt : 1u;
}

__device__ __forceinline__ void xcd_barrier(const XcdBarrier& b) {
    asm volatile("s_waitcnt vmcnt(0)" ::: "memory");
    __syncthreads();
    if (threadIdx.x == 0) {
        unsigned* bar = b.bar;
        __builtin_amdgcn_s_waitcnt(0);
        unsigned nloc = b.st[0], nx = b.st[1];
        if (nloc == 0u) { xcd_barrier_complete(bar, b.x, nloc, nx); b.st[0] = nloc; b.st[1] = nx; }
        const unsigned old = xb_add(&bar[XB_XSUB(b.x)], 1u);
        const unsigned gen = old / nloc;
        if (old + 1u == (gen + 1u) * nloc) {
            __builtin_amdgcn_fence(__ATOMIC_RELEASE, "agent");
            asm volatile("s_waitcnt vmcnt(0)" ::: "memory");
            const unsigned og = xb_add(&bar[XB_TOP], 1u);
            const unsigned tg = og / nx;
            if (og + 1u == (tg + 1u) * nx) xb_add(&bar[XB_TOPGEN], 1u);
            else XB_SPIN(xb_ld(&bar[XB_TOPGEN]) == tg, bar);
            __builtin_amdgcn_fence(__ATOMIC_ACQUIRE, "agent");
            xb_add(&bar[XB_XGEN(b.x)], 1u);
            asm volatile("s_waitcnt vmcnt(0)" ::: "memory");
        } else {
            XB_SPIN(xb_ld(&bar[XB_XGEN(b.x)]) == gen, bar);
            __builtin_amdgcn_fence(__ATOMIC_ACQUIRE, "agent");
            asm volatile("s_waitcnt vmcnt(0)" ::: "memory");
        }
    }
    __syncthreads();
}


#ifndef REP_MASK
#define REP_MASK 0
#endif
#define REPB(bit) (((REP_MASK) >> (bit)) & 1)
#ifndef REP_N
#define REP_N 2
#endif
constexpr int NWAVES = 8;
constexpr int NB = 4, SEQ = 4096, M = NB * SEQ, D = 1024, FF = 2816, NPROJ = 2480, NPROJP = 2560, DEPTH = 2;
constexpr float EPS = 1e-6f;
constexpr float LOG2_10000 = 13.287712379549449f;

enum { I_X = 0, I_F1N, I_F1G, I_F1U, I_F1D, I_MIXN, I_WIN, I_CONVW, I_CONVB, I_DTB, I_ALOG, I_SSDD, I_SSDN, I_SWAQN, I_SWAKN, I_SINK, I_SWAON,
       I_MQLN, I_WUQ, I_MKVN, I_WUKV, I_MQN, I_MKN, I_MON, I_WOUT, I_F2N, I_F2G, I_F2U, I_F2D, N_IN };

constexpr size_t MiB = 1u << 20;
constexpr size_t WS_CTL = 0, CTL_ZERO_BYTES = 64 * 1024;
constexpr size_t WS_CSSWA = 1 * MiB;
constexpr size_t WS_CSMLA = 2 * MiB;
constexpr size_t WS_SS = 3 * MiB;
constexpr size_t WS_WGU1 = 4 * MiB, WS_WD1 = 15 * MiB, WS_WIN = WS_WD1 + 5 * MiB + MiB / 2, WS_WOUT = WS_WIN + 5 * MiB, WS_WGU2 = WS_WOUT + 2 * MiB, WS_WD2 = WS_WGU2 + 11 * MiB,
                 WS_WUQ = 44 * MiB, WS_WUKV = 44 * MiB + MiB / 4;
static_assert(WS_WD2 + 5 * MiB + MiB / 2 == 44 * MiB, "weights map");
constexpr size_t WS_XB = 45 * MiB;
constexpr size_t WS_OV = 77 * MiB;
constexpr size_t WS_HB = WS_OV;
constexpr size_t WS_PROJ = WS_OV;
constexpr size_t WS_Z = WS_PROJ, WS_XBCR = WS_PROJ + 16 * MiB, WS_SWAQ = WS_PROJ + 48 * MiB, WS_SWAKV = WS_PROJ + 56 * MiB, WS_MLAQR = WS_PROJ + 64 * MiB, WS_MLAM = WS_PROJ + 72 * MiB;
constexpr size_t WS_Y = WS_XBCR;
constexpr size_t WS_DTRAW = WS_OV + 80 * MiB;
constexpr size_t WS_XBCC = WS_OV + 81 * MiB;
constexpr size_t WS_DTC = WS_OV + 113 * MiB;
constexpr size_t WS_SWAVT = WS_OV + 115 * MiB;
constexpr size_t WS_MLAQ = WS_OV + 119 * MiB;
constexpr size_t WS_MLAK = WS_OV + 131 * MiB;
constexpr size_t WS_MLAVT = WS_OV + 143 * MiB;
constexpr size_t WS_SSQ = WS_OV + 151 * MiB;
constexpr size_t WS_SIN = WS_OV + 152 * MiB;
constexpr size_t WS_END = WS_OV + 168 * MiB;
constexpr size_t WS_YTMP = WS_XB;
static_assert(WS_END <= 256 * MiB, "ws map");

constexpr int CW_BAR = 4096, CW_SP = 8192  ;
constexpr int RING_BYTES = 131072, LDS_BYTES = 163840, LDSCTL_OFF = LDS_BYTES - 1024, MISC_OFF = LDSCTL_OFF + 64, WTAB_OFF = LDSCTL_OFF - 256  ,
              TAB_OFF = WTAB_OFF - 4096  , RTAB_OFF = TAB_OFF - 8192  ;
static_assert(RTAB_OFF >= RING_BYTES, "LDS map");

struct Args { const float* in[N_IN]; float* out; unsigned char* ws; int ph_lo, ph_hi; };
static_assert(sizeof(Args) == N_IN * 8 + 8 + 8 + 8, "Args has no padding");
__device__ __forceinline__ const float* ain(int i) { asm volatile("" : "+s"(i)); return ((const float* const*)__builtin_amdgcn_kernarg_segment_ptr())[i]; }
__device__ __forceinline__ float* aout() { int i = N_IN; asm volatile("" : "+s"(i)); return ((float* const*)__builtin_amdgcn_kernarg_segment_ptr())[i]; }
__device__ __forceinline__ unsigned char* aws() { int i = N_IN + 1; asm volatile("" : "+s"(i)); return ((unsigned char* const*)__builtin_amdgcn_kernarg_segment_ptr())[i]; }

__device__ __forceinline__ float bf2f(unsigned short b) { return __uint_as_float((unsigned)b << 16); }
__device__ __forceinline__ float bflo(unsigned w) { return __uint_as_float(w << 16); }
__device__ __forceinline__ float bfhi(unsigned w) { return __uint_as_float(w & 0xffff0000u); }
__device__ __forceinline__ float wave_sum(float v) {
#pragma unroll
    for (int o = 1; o < 64; o <<= 1) v += __shfl_xor(v, o);
    return v;
}
__device__ __forceinline__ float silu_f(float g) { return g * __builtin_amdgcn_rcpf(1.0f + __expf(-g)); }
__device__ __forceinline__ float softplus_f(float x) { return fmaxf(x, 0.f) + log1pf(expf(-fabsf(x))); }

typedef pg8::f32x4 f4;
typedef pg8::u32x4 u4;
typedef short v4i16 __attribute__((ext_vector_type(4)));
typedef unsigned v2u __attribute__((ext_vector_type(2)));
typedef __amdgpu_buffer_rsrc_t rsrc_t;
__device__ __forceinline__ rsrc_t mk_rsrc(const void* base, unsigned bytes) { return __builtin_amdgcn_make_buffer_rsrc(const_cast<void*>(base), 0, (int)bytes, 0x00020000); }
__device__ __forceinline__ void st16_wt(rsrc_t r, size_t byte_off, v4u v) { __builtin_amdgcn_raw_buffer_store_b128(v, r, (int)byte_off, 0, 16); }
__device__ __forceinline__ void st8_wt(rsrc_t r, size_t byte_off, v2u v) { __builtin_amdgcn_raw_buffer_store_b64(v, r, (int)byte_off, 0, 16); }
__device__ __forceinline__ void load_rstd(const float* ss, int row0, int fq, float (&rs)[2][4]) {
#pragma unroll
    for (int ai = 0; ai < 2; ++ai)
#pragma unroll
        for (int m = 0; m < 4; ++m) {
            const f4 v = *(const f4*)(ss + (size_t)(row0 + ai * 128 + m * 16) * 16 + 4 * fq);
            float s = (v[0] + v[1]) + (v[2] + v[3]); s += __shfl_xor(s, 16); s += __shfl_xor(s, 32);
            rs[ai][m] = rsqrtf(s * (1.0f / D) + EPS);
        }
}
template <int MAXU, class Sched> __device__ __forceinline__ bool rstd_tab_ok(const Sched& S) {
    pg8::Unit u; bool ok = true; const int pm0 = S.next(0, u) ? u.pm : 0;
#pragma unroll
    for (int i = 0; i < MAXU; ++i) { const int pm = S.next(i, u) ? u.pm : pm0; ok = ok && ((pm >> 3) == (pm0 >> 3)); }
    return ok && !S.next(MAXU, u);
}
template <int MAXU, class Sched> __device__ __forceinline__ void rstd_tab_fill(PG8_LAS float* rt, const Sched& S, const float* ss, int tid) {
    pg8::Unit u; int pm[MAXU]; const int pm0 = S.next(0, u) ? u.pm : 0;
#pragma unroll
    for (int i = 0; i < MAXU; ++i) pm[i] = S.next(i, u) ? u.pm : pm0;
    if (tid < 256) {
        f4 v[MAXU][4];
#pragma unroll
        for (int i = 0; i < MAXU; ++i) { const float* p = ss + ((size_t)pm[i] * 256 + tid) * 16;
#pragma unroll
            for (int j = 0; j < 4; ++j) v[i][j] = *(const f4*)(p + 4 * j); }
#pragma unroll
        for (int i = 0; i < MAXU; ++i) { const f4 a = v[i][0], b = v[i][1], c = v[i][2], d = v[i][3];
            const float s = ((a[0] + a[1]) + (a[2] + a[3])) + ((b[0] + b[1]) + (b[2] + b[3])) + ((c[0] + c[1]) + (c[2] + c[3])) + ((d[0] + d[1]) + (d[2] + d[3]));
            rt[(pm[i] & 7) * 256 + tid] = rsqrtf(s * (1.0f / D) + EPS); }
    }
}
__device__ __forceinline__ void get_rstd(const PG8_LAS float* rt, bool use_tab, const float* ss, const pg8::Unit& u, int wr, int fr, int fq, float (&rs)[2][4]) {
    if (use_tab) {
#pragma unroll
        for (int ai = 0; ai < 2; ++ai)
#pragma unroll
            for (int m = 0; m < 4; ++m) rs[ai][m] = rt[(u.pm & 7) * 256 + ai * 128 + wr * 64 + m * 16 + fr];
    } else load_rstd(ss, u.pm * 256 + wr * 64 + fr, fq, rs);
}
struct EpiGU {
    static constexpr bool PERM = false, AFTER_DRAIN = false, KHOOK = false; static constexpr bool PROHOOK = true; static constexpr int AUX_A = 0;
    pg8::bf16_t* H; const float* ss; const PG8_LAS float* rt; bool use_tab;
    template <class Sched> __device__ __forceinline__ void prohook(const Sched& S, int tid) const { if (use_tab) rstd_tab_fill<6>((PG8_LAS float*)rt, S, ss, tid); }
    __device__ __forceinline__ void operator()(const f4 (&acc)[2][2][4][2], const pg8::Unit& u, int wr, int wc, int fr, int fq) const {
        const int row0 = u.pm * 256 + wr * 64 + fr; float rs[2][4]; get_rstd(rt, use_tab, ss, u, wr, fr, fq, rs);
        const int col = u.pn * 128 + wc * 32 + fq * 8; const rsrc_t rH = mk_rsrc(H, (unsigned)((size_t)M * FF * 2));
#pragma unroll
        for (int ai = 0; ai < 2; ++ai)
#pragma unroll
            for (int m = 0; m < 4; ++m) {
                const float r = rs[ai][m], rl = r * -1.4426950408889634f, ir2 = __builtin_amdgcn_rcpf(r * r); float h[8];
#pragma unroll
                for (int bj = 0; bj < 2; ++bj) {
                    const f4 g = acc[ai][bj][m][0], gu = g * acc[ai][bj][m][1], ex = g * rl;
                    f4 t; t[0] = __builtin_amdgcn_exp2f(ex[0]); t[1] = __builtin_amdgcn_exp2f(ex[1]); t[2] = __builtin_amdgcn_exp2f(ex[2]); t[3] = __builtin_amdgcn_exp2f(ex[3]);
                    t = t * ir2 + ir2;
                    f4 d; d[0] = __builtin_amdgcn_rcpf(t[0]); d[1] = __builtin_amdgcn_rcpf(t[1]); d[2] = __builtin_amdgcn_rcpf(t[2]); d[3] = __builtin_amdgcn_rcpf(t[3]);
                    const f4 hv = gu * d;
                    h[bj * 4 + 0] = hv[0]; h[bj * 4 + 1] = hv[1]; h[bj * 4 + 2] = hv[2]; h[bj * 4 + 3] = hv[3];
                }
                u4 w; w.x = pg8::cvt_pk_bf16(h[0], h[1]); w.y = pg8::cvt_pk_bf16(h[2], h[3]); w.z = pg8::cvt_pk_bf16(h[4], h[5]); w.w = pg8::cvt_pk_bf16(h[6], h[7]);
                st16_wt(rH, ((size_t)(row0 + ai * 128 + m * 16) * FF + col) * 2, (v4u){w.x, w.y, w.z, w.w});
            }
    }
    __device__ __forceinline__ void khook(f4 (&)[2][2][4][2], int, int, int) const {}
};
#ifndef XB_WT
#define XB_WT 0
#endif
#ifndef DOWN_AUX_A
#define DOWN_AUX_A 0
#endif
template <int MODE, bool FINAL> struct EpiDown {
    static constexpr bool PERM = true, AFTER_DRAIN = false, KHOOK = (MODE == 1); static constexpr bool PROHOOK = (MODE == 1); static constexpr int AUX_A = DOWN_AUX_A;
    float* xout; pg8::bf16_t* xb; float* ss; float scale; const PG8_LAS float* tab;
    __device__ __forceinline__ void operator()(const f4 (&acc)[2][2][4][2], const pg8::Unit& u, int wr, int wc, int fr, int fq) const {
#if XB_WT
        const rsrc_t rB = mk_rsrc(xb, (unsigned)((size_t)M * D * 2));
#endif
        v4u xa[2][4][2];
#pragma unroll
        for (int ai = 0; ai < 2; ++ai)
#pragma unroll
            for (int m = 0; m < 4; ++m)
#pragma unroll
                for (int bj = 0; bj < 2; ++bj) xa[ai][m][bj] = *(const v4u*)(xb + (size_t)(u.pm * 256 + ai * 128 + wr * 64 + m * 16 + fr) * D + u.pn * 256 + bj * 128 + wc * 32 + fq * 8);
#pragma unroll
        for (int ai = 0; ai < 2; ++ai) {
            const v4u (&xi)[4][2] = xa[ai];
#pragma unroll
            for (int m = 0; m < 4; ++m) {
                const int lr = ai * 128 + wr * 64 + m * 16 + fr; const size_t row = (size_t)(u.pm * 256 + lr);
                const float sc = MODE == 1 ? tab[lr * 4 + 3] : scale; float sq = 0.f;
#pragma unroll
                for (int bj = 0; bj < 2; ++bj) {
                    const int col = u.pn * 256 + bj * 128 + wc * 32 + fq * 8; const v4u r = xi[m][bj];
                    const f4 r0 = (f4){bflo(r[0]), bfhi(r[0]), bflo(r[1]), bfhi(r[1])}, r1 = (f4){bflo(r[2]), bfhi(r[2]), bflo(r[3]), bfhi(r[3])};
                    const f4 o0 = r0 + acc[ai][bj][m][0] * sc, o1 = r1 + acc[ai][bj][m][1] * sc;
                    if (FINAL) { *(f4*)(xout + row * D + col) = o0; *(f4*)(xout + row * D + col + 4) = o1; }
                    else {
                        const v4u w = (v4u){pg8::cvt_pk_bf16(o0[0], o0[1]), pg8::cvt_pk_bf16(o0[2], o0[3]), pg8::cvt_pk_bf16(o1[0], o1[1]), pg8::cvt_pk_bf16(o1[2], o1[3])};
#if XB_WT
                        st16_wt(rB, (row * D + col) * 2, w);
#else
                        *(v4u*)(xb + row * D + col) = w;
#endif
                        const f4 q0 = (f4){bflo(w[0]), bfhi(w[0]), bflo(w[1]), bfhi(w[1])}, q1 = (f4){bflo(w[2]), bfhi(w[2]), bflo(w[3]), bfhi(w[3])};
                        sq += ((q0[0] * q0[0] + q0[1] * q0[1]) + (q0[2] * q0[2] + q0[3] * q0[3])) + ((q1[0] * q1[0] + q1[1] * q1[1]) + (q1[2] * q1[2] + q1[3] * q1[3]));
                    }
                }
                if (!FINAL) { sq += __shfl_xor(sq, 16); sq += __shfl_xor(sq, 32);
                    if (fq == 0) ss[row * 16 + u.pn * 4 + wc] = sq; }
            }
        }
    }
    template <class Sched> __device__ __forceinline__ void prohook(const Sched& S, int tid) const {
        pg8::Unit u; if (S.next(0, u) && tid < 256) { const float* q = (const float*)(aws() + WS_SSQ) + ((size_t)u.pm * 256 + tid) * 16; float rs[4];
#pragma unroll
            for (int g = 0; g < 4; ++g) { const f4 v = *(const f4*)(q + 4 * g); rs[g] = rsqrtf(((v[0] + v[1]) + (v[2] + v[3])) * (1.0f / 256.0f) + EPS); }
            ((PG8_LAS f4*)tab)[tid] = (f4){rs[0] / rs[1], rs[1] / rs[2], rs[2] / rs[3], rs[3]}; }
    }
    __device__ __forceinline__ void khook(f4 (&acc)[2][2][4][2], int g, int wr, int fr) const {
#pragma unroll
        for (int ai = 0; ai < 2; ++ai)
#pragma unroll
            for (int m = 0; m < 4; ++m) { const float r = tab[(ai * 128 + wr * 64 + m * 16 + fr) * 4 + g];
#pragma unroll
                for (int bj = 0; bj < 2; ++bj)
#pragma unroll
                    for (int n = 0; n < 2; ++n) acc[ai][bj][m][n] = acc[ai][bj][m][n] * r; }
    }
};
struct EpiDry {
    static constexpr bool PERM = false, AFTER_DRAIN = false, KHOOK = false; static constexpr bool PROHOOK = false; static constexpr int AUX_A = 0;
    __device__ __forceinline__ void operator()(const f4 (&acc)[2][2][4][2], const pg8::Unit&, int, int, int, int) const {
#pragma unroll
        for (int ai = 0; ai < 2; ++ai)
#pragma unroll
            for (int bj = 0; bj < 2; ++bj)
#pragma unroll
                for (int m = 0; m < 4; ++m)
#pragma unroll
                    for (int n = 0; n < 2; ++n) asm volatile("" :: "v"(acc[ai][bj][m][n]));
    }
    __device__ __forceinline__ void khook(f4 (&)[2][2][4][2], int, int, int) const {}
};
struct EpiProj {
    static constexpr bool PERM = true, AFTER_DRAIN = false, KHOOK = false; static constexpr bool PROHOOK = true; static constexpr int AUX_A = 0;
    pg8::bf16_t* proj; float* dtraw; const float* ss; const PG8_LAS float* rt; bool use_tab;
    template <class Sched> __device__ __forceinline__ void prohook(const Sched& S, int tid) const { if (use_tab) rstd_tab_fill<3>((PG8_LAS float*)rt, S, ss, tid); }
    __device__ __forceinline__ void operator()(const f4 (&acc)[2][2][4][2], const pg8::Unit& u, int wr, int wc, int fr, int fq) const {
        const int row0 = u.pm * 256 + wr * 64 + fr; float rs[2][4]; get_rstd(rt, use_tab, ss, u, wr, fr, fq, rs);
        size_t off; int pitch, c0;
        if (u.pn < 2) { off = 0; pitch = 512; c0 = u.pn * 256; } else if (u.pn < 6) { off = (size_t)M * 512; pitch = 1024; c0 = (u.pn - 2) * 256; } else { off = (size_t)M * 1536 + (size_t)(u.pn - 6) * M * 256; pitch = 256; c0 = 0; }
        pg8::bf16_t* base = proj + off + c0 + wc * 32 + fq * 8;
        const bool dtw = (u.pn == 9) && (wc == 1) && (fq < 2);
#pragma unroll
        for (int ai = 0; ai < 2; ++ai)
#pragma unroll
            for (int m = 0; m < 4; ++m) {
                const float r = rs[ai][m]; const size_t row = (size_t)(row0 + ai * 128 + m * 16);
#pragma unroll
                for (int bj = 0; bj < 2; ++bj) {
                    const f4 v0 = acc[ai][bj][m][0] * r, v1 = acc[ai][bj][m][1] * r;
                    u4 w; w.x = pg8::cvt_pk_bf16(v0[0], v0[1]); w.y = pg8::cvt_pk_bf16(v0[2], v0[3]); w.z = pg8::cvt_pk_bf16(v1[0], v1[1]); w.w = pg8::cvt_pk_bf16(v1[2], v1[3]);
                    *(u4*)(base + row * pitch + bj * 128) = w;
                    if (bj == 1 && dtw) { *(f4*)(dtraw + row * 16 + fq * 8) = v0; *(f4*)(dtraw + row * 16 + fq * 8 + 4) = v1; }
                }
            }
    }
    __device__ __forceinline__ void khook(f4 (&)[2][2][4][2], int, int, int) const {}
};

__device__ __forceinline__ int gu_row(int j, int n01) { const int pn = j >> 7, jj = j & 127; return 256 * pn + 128 * ((jj >> 2) & 1) + 32 * (jj >> 5) + 16 * n01 + 4 * ((jj >> 3) & 3) + (jj & 3); }
__device__ __forceinline__ int win_row(int o) { return o < 1536 ? o : (o < 1552 ? 2464 + (o - 1536) : o - 16); }
__device__ __forceinline__ int map_row(int mode, int n) { return mode == 0 ? n : (mode == 1 ? gu_row(n, 0) : (mode == 2 ? gu_row(n, 1) : win_row(n))); }
struct TrItem { const float* W; bf16* WT; const float* ks; int K, N, mode, k0, n0; };
__device__ __forceinline__ TrItem tr_desc(const float* W, int K, int N, bf16* WT, int mode, const float* ks, int item) {
    const int nblk = (N + 63) / 64; TrItem d; d.W = W; d.WT = WT; d.ks = ks; d.K = K; d.N = N; d.mode = mode; d.k0 = 64 * (item / nblk); d.n0 = 64 * (item % nblk); return d;
}
__device__ __forceinline__ void tr_load(const TrItem& d, f32x4 (&v)[16], f32x4 (&sc)[4], int lane) {
    const int r4 = lane >> 4, c4 = lane & 15; const bool nok = d.n0 + 4 * c4 < d.N; const int ncol = nok ? d.n0 + 4 * c4 : 0;
    const float* p = d.W + (size_t)(d.k0 + 16 * r4) * d.N + ncol;
#pragma unroll
    for (int i = 0; i < 16; ++i) { v[i] = __builtin_nontemporal_load((const f32x4*)p); p += d.N; asm volatile("" : "+v"(p)); }
    if (d.ks) {
#pragma unroll
        for (int j = 0; j < 4; ++j) sc[j] = *(const f32x4*)(d.ks + d.k0 + 16 * r4 + 4 * j);
    } else {
#pragma unroll
        for (int j = 0; j < 4; ++j) sc[j] = (f32x4){1.f, 1.f, 1.f, 1.f};
    }
}
__device__ __forceinline__ void tr_finish(const TrItem& d, f32x4 (&v)[16], f32x4 (&sc)[4], LAS unsigned char* scr, int lane) {
    const int r4 = lane >> 4, c4 = lane & 15; const bool nok = d.n0 + 4 * c4 < d.N;
#pragma unroll
    for (int i = 0; i < 16; ++i) { const int k = 16 * r4 + i; f32x4 x = v[i] * sc[i >> 2][i & 3]; if (!nok) x = (f32x4){0.f, 0.f, 0.f, 0.f};
        *(LAS v2u*)(scr + k * 192 + 8 * c4) = (v2u){pg8::cvt_pk_bf16(x.x, x.y), pg8::cvt_pk_bf16(x.z, x.w)}; }
    LDS_WAIT(); asm volatile("" ::: "memory");
    const int hh = lane >> 5, blk = (lane >> 4) & 1, q = (lane & 15) >> 2, p = lane & 3;
#pragma unroll
    for (int c = 0; c < 2; ++c)
#pragma unroll
        for (int k2 = 0; k2 < 4; ++k2) {
            const LAS unsigned char* ad = scr + (16 * k2 + 8 * hh + q) * 192 + (32 * c + 16 * blk + 4 * p) * 2;
            const v4i16 v0 = __builtin_amdgcn_ds_read_tr16_b64_v4i16((LAS v4i16*)ad), v1 = __builtin_amdgcn_ds_read_tr16_b64_v4i16((LAS v4i16*)(ad + 4 * 192));
            const int n = d.n0 + 32 * c + (lane & 31);
            union { v4i16 h[2]; v4u u; } o; o.h[0] = v0; o.h[1] = v1;
            if (n < d.N) *(GAS v4u*)(d.WT + (size_t)map_row(d.mode, n) * d.K + d.k0 + 16 * k2 + 8 * hh) = o.u;
        }
    LDS_WAIT(); asm volatile("" ::: "memory");
}
enum { J_GU1 = 0, J_D1, J_IN, J_UQKV, J_OUT, J_GU2, J_D2 };
#define CONV_LOOP(NITEMS, DESC) do { int it_ = w; if (it_ < (NITEMS)) { TrItem d_ = DESC(it_); f32x4 v_[16], s_[4]; tr_load(d_, v_, s_, lane); \
        for (;;) { const int nx_ = it_ + nw; const bool more_ = nx_ < (NITEMS); TrItem dn_ = d_; f32x4 vn_[16], sn_[4]; if (more_) { dn_ = DESC(nx_); tr_load(dn_, vn_, sn_, lane); } \
            tr_finish(d_, v_, s_, scr, lane); if (!more_) break; d_ = dn_; _Pragma("unroll") for (int i_ = 0; i_ < 16; ++i_) v_[i_] = vn_[i_]; _Pragma("unroll") for (int i_ = 0; i_ < 4; ++i_) s_[i_] = sn_[i_]; it_ = nx_; } } } while (0)
template <int JOB> __device__ __forceinline__ void convert_job(int l, LAS unsigned char* lds, int w_, int nw, int wave, int lane, int off = 0) {
    unsigned char* ws = aws(); LAS unsigned char* scr = lds + wave * 16384; const int w = ((w_ - off) % nw + nw) % nw;
    constexpr int I_GU = 16 * 44, I_DN = 44 * 16, I_IN = 16 * 39, I_OUT = 16 * 16, I_UQ = 4 * 6, I_UKV = 2 * 8;
    if (JOB == J_GU1 || JOB == J_GU2) {
        const float* g = ain(JOB == J_GU1 ? I_F1G : I_F2G) + (size_t)l * D * FF; const float* u = ain(JOB == J_GU1 ? I_F1U : I_F2U) + (size_t)l * D * FF; const float* nrm = ain(JOB == J_GU1 ? I_F1N : I_F2N) + l * D;
        bf16* dst = (bf16*)(ws + (JOB == J_GU1 ? WS_WGU1 : WS_WGU2));
#define DESC_GU(it) ((it) < I_GU ? tr_desc(g, D, FF, dst, 1, nrm, (it)) : tr_desc(u, D, FF, dst, 2, nrm, (it) - I_GU))
        CONV_LOOP(2 * I_GU, DESC_GU);
#undef DESC_GU
    } else if (JOB == J_D1 || JOB == J_D2) {
        const float* d = ain(JOB == J_D1 ? I_F1D : I_F2D) + (size_t)l * FF * D; bf16* dst = (bf16*)(ws + (JOB == J_D1 ? WS_WD1 : WS_WD2));
#define DESC_D(it) tr_desc(d, FF, D, dst, 0, nullptr, (it))
        CONV_LOOP(I_DN, DESC_D);
#undef DESC_D
    } else if (JOB == J_IN) {
        const float* win = ain(I_WIN) + (size_t)l * D * NPROJ; const float* mw = ain(I_MIXN) + l * D;
#define DESC_IN(it) tr_desc(win, D, NPROJ, (bf16*)(ws + WS_WIN), 3, mw, (it))
        CONV_LOOP(I_IN, DESC_IN);
#undef DESC_IN
        for (int it = w; it < 80; it += nw) { GAS v4u* p = (GAS v4u*)((bf16*)(ws + WS_WIN) + (size_t)(NPROJ + it) * D) + lane * 2; p[0] = (v4u){0u, 0u, 0u, 0u}; p[1] = (v4u){0u, 0u, 0u, 0u}; }
    } else if (JOB == J_UQKV) {
        const float* wuq = ain(I_WUQ) + (size_t)l * 256 * 384; const float* wukv = ain(I_WUKV) + (size_t)l * 128 * 512; const float* n1 = ain(I_MQLN) + l * 256; const float* n2 = ain(I_MKVN) + l * 128;
#define DESC_U(it) ((it) < I_UQ ? tr_desc(wuq, 256, 384, (bf16*)(ws + WS_WUQ), 0, n1, (it)) : tr_desc(wukv, 128, 512, (bf16*)(ws + WS_WUKV), 0, n2, (it) - I_UQ))
        CONV_LOOP(I_UQ + I_UKV, DESC_U);
#undef DESC_U
    } else {
        const float* wo = ain(I_WOUT) + (size_t)l * D * D; const float* k0p = ain(I_SSDN) + l * 512; const float* k1p = ain(I_SWAON) + l * 256 - 512; const float* k2p = ain(I_MON) + l * 256 - 768;
#define DESC_O(it) tr_desc(wo, D, D, (bf16*)(ws + WS_WOUT), 0, (64 * ((it) / 16) < 512 ? k0p : (64 * ((it) / 16) < 768 ? k1p : k2p)), (it))
        CONV_LOOP(I_OUT, DESC_O);
#undef DESC_O
    }
}
#define TAIL_WORKER(nwg) const int rem_ = (nwg) % G; const bool tail_ = bx >= rem_; const int tw_ = (bx - rem_) * NWAVES + wave, tnw_ = (G - rem_) * NWAVES;
__device__ __forceinline__ void p0_x_and_tables(int gw, int NGW, int lane, int gtid, int NT) {
    unsigned char* ws = aws(); const float* x = ain(I_X); bf16* xb = (bf16*)(ws + WS_XB); float* ss = (float*)(ws + WS_SS);
    for (int m0 = 4 * gw; m0 < M; m0 += 4 * NGW) {
        f32x4 v[4][4];
#pragma unroll
        for (int r = 0; r < 4; ++r)
#pragma unroll
            for (int j = 0; j < 4; ++j) v[r][j] = ((const GAS f32x4*)(x + (size_t)(m0 + r) * D) + lane)[64 * j];
#pragma unroll
        for (int r = 0; r < 4; ++r) {
            float s = 0.f;
#pragma unroll
            for (int j = 0; j < 4; ++j) s += (v[r][j].x * v[r][j].x + v[r][j].y * v[r][j].y) + (v[r][j].z * v[r][j].z + v[r][j].w * v[r][j].w);
            s = wave_sum(s);
            GAS unsigned long long* o8 = (GAS unsigned long long*)(xb + (size_t)(m0 + r) * D) + lane;
#pragma unroll
            for (int j = 0; j < 4; ++j) o8[64 * j] = (unsigned long long)pk2(v[r][j].x, v[r][j].y) | ((unsigned long long)pk2(v[r][j].z, v[r][j].w) << 32);
            if (lane < 16) ss[(size_t)(m0 + r) * 16 + lane] = lane == 0 ? s : 0.f;
        }
    }
    float* cs1 = (float*)(ws + WS_CSSWA); float* cs2 = (float*)(ws + WS_CSMLA);
    for (int idx = gtid; idx < SEQ * 48; idx += NT) {
        const int t = idx / 48, i = idx % 48; float inv; float* dst;
        if (i < 32) { inv = exp2f(-(float)i * (LOG2_10000 / 32.0f)); dst = cs1 + ((size_t)t * 32 + i) * 2; } else { inv = exp2f(-(float)(i - 32) * (LOG2_10000 / 16.0f)); dst = cs2 + ((size_t)t * 16 + (i - 32)) * 2; }
        const float ang = (float)t * inv; const double rev = (double)ang * 0.15915494309189535; const float fr = (float)(rev - rint(rev));
        dst[0] = __builtin_amdgcn_cosf(fr); dst[1] = __builtin_amdgcn_sinf(fr);
    }
}

__device__ __forceinline__ void ld8(const bf16* p, float* x) { const uint4 w = *(const uint4*)p; x[0] = bflo(w.x); x[1] = bfhi(w.x); x[2] = bflo(w.y); x[3] = bfhi(w.y); x[4] = bflo(w.z); x[5] = bfhi(w.z); x[6] = bflo(w.w); x[7] = bfhi(w.w); }
__device__ __forceinline__ void st8(bf16* p, const float* x) { uint4 w; w.x = pk2(x[0], x[1]); w.y = pk2(x[2], x[3]); w.z = pk2(x[4], x[5]); w.w = pk2(x[6], x[7]); *(uint4*)p = w; }


typedef float f32x16 __attribute__((ext_vector_type(16)));
__device__ __forceinline__ v4i16 tr4(LAS const unsigned char* p) { return __builtin_amdgcn_ds_read_tr16_b64_v4i16((LAS v4i16*)p); }
__device__ __forceinline__ bf16x8 cat4(v4i16 a, v4i16 b) { bf16x8 r; r[0] = a[0]; r[1] = a[1]; r[2] = a[2]; r[3] = a[3]; r[4] = b[0]; r[5] = b[1]; r[6] = b[2]; r[7] = b[3]; return r; }
typedef __bf16 bf16x2_t __attribute__((ext_vector_type(2)));
typedef float f32x2_t __attribute__((ext_vector_type(2)));
__device__ __forceinline__ unsigned cvtpk(float lo, float hi) { f32x2_t v = {lo, hi}; bf16x2_t b = __builtin_convertvector(v, bf16x2_t); return __builtin_bit_cast(unsigned, b); }
__device__ __forceinline__ void lds_st16(LAS unsigned char* p, uint4 v) { *(LAS v4u*)p = (v4u){v.x, v.y, v.z, v.w}; }

constexpr int SX_PITCH = 192, SB_PITCH = 320, S_XS = 0, S_BM = 256 * SX_PITCH;
static_assert(S_BM + 256 * SB_PITCH <= RING_BYTES, "S unit LDS");

__device__ __forceinline__ void ssd_state_unit(LAS unsigned char* lds, int L, int unit, int tid, int wave, int lane) {
    const int h = unit & 7, c = (unit >> 3) & 15, b = unit >> 7, g = h >> 2, hl = h & 3; const size_t m0 = (size_t)b * SEQ + (size_t)c * 256;
    unsigned char* ws = aws();
    LAS float* fsc = (LAS float*)(lds + TAB_OFF);
    if (wave == 0) {
        const float* dtraw = (const float*)(ws + WS_DTRAW); float* dtc = (float*)(ws + WS_DTC);
        float raw[2][4], alog[2], dtb[2];
#pragma unroll
        for (int dir = 0; dir < 2; ++dir) { alog[dir] = ain(I_ALOG)[L * 16 + dir * 8 + h]; dtb[dir] = ain(I_DTB)[L * 16 + dir * 8 + h]; }
#pragma unroll
        for (int dir = 0; dir < 2; ++dir)
#pragma unroll
            for (int j = 0; j < 4; ++j) raw[dir][j] = dtraw[(m0 + 4 * lane + j) * 16 + dir * 8 + h];
#pragma unroll
        for (int dir = 0; dir < 2; ++dir) {
            const float A = -expf(alog[dir]); const float bias = dtb[dir];
            float dt[4], cu[4];
#pragma unroll
            for (int j = 0; j < 4; ++j) dt[j] = softplus_f(raw[dir][j] + bias);
            float tot, v;
            if (dir == 0) {
                cu[0] = dt[0] * A; cu[1] = cu[0] + dt[1] * A; cu[2] = cu[1] + dt[2] * A; cu[3] = cu[2] + dt[3] * A; tot = cu[3]; v = tot;
#pragma unroll
                for (int o = 1; o < 64; o <<= 1) { const float n = __shfl_up(v, o); if (lane >= o) v += n; }
            } else {
                cu[3] = dt[3] * A; cu[2] = cu[3] + dt[2] * A; cu[1] = cu[2] + dt[1] * A; cu[0] = cu[1] + dt[0] * A; tot = cu[0]; v = tot;
#pragma unroll
                for (int o = 1; o < 64; o <<= 1) { const float n = __shfl_down(v, o); if (lane + o < 64) v += n; }
            }
            const float excl = v - tot; const float total = wave_sum(tot);
#pragma unroll
            for (int j = 0; j < 4; ++j) { const float cum = cu[j] + excl; const size_t m = m0 + 4 * lane + j;
                fsc[dir * 256 + 4 * lane + j] = dt[j] * __expf(total - cum); dtc[(m * 8 + h) * 4 + dir] = dt[j]; dtc[(m * 8 + h) * 4 + 2 + dir] = cum; }
        }
    }
    {
        const bf16* xr = (const bf16*)(ws + WS_XBCR); bf16* xc = (bf16*)(ws + WS_XBCC);
        const float* cw = ain(I_CONVW) + L * 5 * 1024; const float* cb = ain(I_CONVB) + L * 1024;
        constexpr int ncg = 28;
        for (int item = tid - 64; item >= 0 && item < ncg * 16; item += NWAVES * 64) {
            const int cg = item % ncg, tr = item / ncg;
            const int col = cg < 8 ? h * 64 + 8 * cg : (cg < 24 ? 512 + g * 128 + 8 * (cg - 8) : 768 + g * 128 + 8 * (4 * hl + cg - 24));
            float w[5][8], bb[8];
#pragma unroll
            for (int k = 0; k < 5; ++k) { const f32x4 w0 = *(const f32x4*)(cw + k * 1024 + col), w1 = *(const f32x4*)(cw + k * 1024 + col + 4);
                w[k][0] = w0.x; w[k][1] = w0.y; w[k][2] = w0.z; w[k][3] = w0.w; w[k][4] = w1.x; w[k][5] = w1.y; w[k][6] = w1.z; w[k][7] = w1.w; }
            { const f32x4 b0 = *(const f32x4*)(cb + col), b1 = *(const f32x4*)(cb + col + 4); bb[0] = b0.x; bb[1] = b0.y; bb[2] = b0.z; bb[3] = b0.w; bb[4] = b1.x; bb[5] = b1.y; bb[6] = b1.z; bb[7] = b1.w; }
            const int t0 = 16 * tr, sq0 = c * 256 + t0;
            uint4 rows[20];
#pragma unroll
            for (int i = 0; i < 20; ++i) { const int sq_ = sq0 + i - 2; const int di = (i < 2 || i >= 18) ? (sq_ < 0 ? -sq0 : (sq_ >= SEQ ? SEQ - 1 - sq0 : i - 2)) : i - 2;
                rows[i] = *(const uint4*)(xr + (m0 + t0 + di) * 1024 + col); }
            const float e0 = sq0 - 2 >= 0 ? 1.f : 0.f, e1 = sq0 - 1 >= 0 ? 1.f : 0.f, e18 = sq0 + 16 < SEQ ? 1.f : 0.f, e19 = sq0 + 17 < SEQ ? 1.f : 0.f;
            float win[5][8];
#define UNPK(dst, rw) do { dst[0] = bflo(rw.x); dst[1] = bfhi(rw.x); dst[2] = bflo(rw.y); dst[3] = bfhi(rw.y); dst[4] = bflo(rw.z); dst[5] = bfhi(rw.z); dst[6] = bflo(rw.w); dst[7] = bfhi(rw.w); } while (0)
            UNPK(win[0], rows[0]); UNPK(win[1], rows[1]); UNPK(win[2], rows[2]); UNPK(win[3], rows[3]);
#pragma unroll
            for (int e = 0; e < 8; ++e) { win[0][e] *= e0; win[1][e] *= e1; }
#pragma unroll
            for (int tt = 0; tt < 16; ++tt) {
                UNPK(win[(tt + 4) % 5], rows[tt + 4]);
                if (tt == 14) {
#pragma unroll
                    for (int e = 0; e < 8; ++e) win[(tt + 4) % 5][e] *= e18; }
                if (tt == 15) {
#pragma unroll
                    for (int e = 0; e < 8; ++e) win[(tt + 4) % 5][e] *= e19; }
                float o[8];
#pragma unroll
                for (int e = 0; e < 8; ++e) { o[e] = bb[e];
#pragma unroll
                    for (int k = 0; k < 5; ++k) o[e] += win[(tt + k) % 5][e] * w[k][e]; }
#pragma unroll
                for (int e = 0; e < 8; ++e) o[e] = silu_f(o[e]);
                uint4 pk; pk.x = cvtpk(o[0], o[1]); pk.y = cvtpk(o[2], o[3]); pk.z = cvtpk(o[4], o[5]); pk.w = cvtpk(o[6], o[7]);
                const int t = t0 + tt;
                if (cg < 8) lds_st16(lds + S_XS + t * SX_PITCH + 16 * cg, pk);
                else if (cg < 24) lds_st16(lds + S_BM + t * SB_PITCH + 16 * (cg - 8), pk);
                if (cg < 8 || cg >= 24 || hl == 0) *(uint4*)(xc + (m0 + t) * 1024 + col) = pk;
            }
#undef UNPK
        }
    }
    __syncthreads();
    {
        const int nb = wave & 3, pb = wave >> 2, hh = lane >> 5, blk = (lane >> 4) & 1, q = (lane & 15) >> 2, p = lane & 3;
        f32x16 accf, accb;
#pragma unroll
        for (int i = 0; i < 16; ++i) { accf[i] = 0.f; accb[i] = 0.f; }
        const LAS unsigned char* xa = lds + S_XS + (8 * hh + q) * SX_PITCH + (32 * pb + 16 * blk + 4 * p) * 2;
        const LAS unsigned char* ba = lds + S_BM + (8 * hh + q) * SB_PITCH + (32 * nb + 16 * blk + 4 * p) * 2;
#pragma unroll 2
        for (int ks = 0; ks < 16; ++ks) {
            const v4i16 x0 = tr4(xa + (16 * ks) * SX_PITCH), x1 = tr4(xa + (16 * ks + 4) * SX_PITCH);
            const v4i16 b0 = tr4(ba + (16 * ks) * SB_PITCH), b1 = tr4(ba + (16 * ks + 4) * SB_PITCH);
            const f32x4 ff0 = *(const LAS f32x4*)(fsc + 16 * ks + 8 * hh), ff1 = *(const LAS f32x4*)(fsc + 16 * ks + 8 * hh + 4);
            const f32x4 fb0 = *(const LAS f32x4*)(fsc + 256 + 16 * ks + 8 * hh), fb1 = *(const LAS f32x4*)(fsc + 256 + 16 * ks + 8 * hh + 4);
            float xv[8];
#pragma unroll
            for (int e = 0; e < 4; ++e) { xv[e] = bf2f((unsigned short)x0[e]); xv[4 + e] = bf2f((unsigned short)x1[e]); }
            union { bf16x8 v; unsigned u[4]; } af, ab;
            af.u[0] = cvtpk(xv[0] * ff0[0], xv[1] * ff0[1]); af.u[1] = cvtpk(xv[2] * ff0[2], xv[3] * ff0[3]); af.u[2] = cvtpk(xv[4] * ff1[0], xv[5] * ff1[1]); af.u[3] = cvtpk(xv[6] * ff1[2], xv[7] * ff1[3]);
            ab.u[0] = cvtpk(xv[0] * fb0[0], xv[1] * fb0[1]); ab.u[1] = cvtpk(xv[2] * fb0[2], xv[3] * fb0[3]); ab.u[2] = cvtpk(xv[4] * fb1[0], xv[5] * fb1[1]); ab.u[3] = cvtpk(xv[6] * fb1[2], xv[7] * fb1[3]);
            const bf16x8 bf = cat4(b0, b1);
            accf = __builtin_amdgcn_mfma_f32_32x32x16_bf16(af.v, bf, accf, 0, 0, 0);
            accb = __builtin_amdgcn_mfma_f32_32x32x16_bf16(ab.v, bf, accb, 0, 0, 0);
        }
        bf16* st = (bf16*)aout() + ((size_t)((b * 16 + c) * 8 + h) * 2) * 8192;
        const bool odd = lane & 1; const int n2 = 32 * nb + (lane & 30);
#pragma unroll
        for (int r = 0; r < 16; r += 2) {
            const float fo = __shfl_xor(odd ? accf[r] : accf[r + 1], 1), bo = __shfl_xor(odd ? accb[r] : accb[r + 1], 1);
            const int rr = odd ? r + 1 : r, pp = 32 * pb + (rr & 3) + 8 * (rr >> 2) + 4 * hh;
            const float fm = odd ? accf[r + 1] : accf[r], bm = odd ? accb[r + 1] : accb[r];
            *(unsigned*)(st + pp * 128 + n2) = odd ? cvtpk(fo, fm) : cvtpk(fm, fo);
            *(unsigned*)(st + 8192 + pp * 128 + n2) = odd ? cvtpk(bo, bm) : cvtpk(bm, bo);
        }
    }
    __syncthreads();
}

constexpr int T_QL = 0, T_QL_PITCH = 528, T_CKV = 64 * 528, T_CKV_PITCH = 272, T_VS = T_CKV + 64 * 272, T_VS_PITCH = 272;
__device__ __forceinline__ float red8(float s) { s += __shfl_xor(s, 1); s += __shfl_xor(s, 2); s += __shfl_xor(s, 4); return s; }

template <int TSTOP = 99>
__device__ __forceinline__ void token_prep_unit(LAS unsigned char* lds, int L, int unit, int tid, int wave, int lane, bool do_swa = true) {
    unsigned char* ws = aws();
    const size_t m0 = (size_t)unit * 64; const int b = unit >> 6, t0 = (unit & 63) * 64;
    uint4 sv[2], sq[4], sc[2];
    {
        const bf16* swakv = (const bf16*)(ws + WS_SWAKV); const bf16* qr = (const bf16*)(ws + WS_MLAQR); const bf16* mm = (const bf16*)(ws + WS_MLAM);
#pragma unroll
        for (int r = 0; r < 2; ++r) { const int id = tid + 512 * r, tok = id >> 4, c8 = id & 15; sv[r] = *(const uint4*)(swakv + (m0 + tok) * 256 + 128 + 8 * c8); }
#pragma unroll
        for (int r = 0; r < 4; ++r) { const int tok = (tid >> 5) + 16 * r, c8 = tid & 31; sq[r] = *(const uint4*)(qr + (m0 + tok) * 256 + 8 * c8); }
#pragma unroll
        for (int r = 0; r < 2; ++r) { const int tok = (tid >> 4) + 32 * r, c8 = tid & 15; sc[r] = *(const uint4*)(mm + (m0 + tok) * 256 + 8 * c8); }
    }
    if (do_swa) {
        bf16* swaq = (bf16*)(ws + WS_SWAQ); bf16* swakv = (bf16*)(ws + WS_SWAKV); const float* cs = (const float*)(ws + WS_CSSWA);
        const int tok = tid >> 3, sub = tid & 7; const size_t m = m0 + tok; const int t = t0 + tok;
        float cc[8], sn[8];
#pragma unroll
        for (int e2 = 0; e2 < 4; ++e2) { const f32x4 v = *(const f32x4*)(cs + ((size_t)t * 32 + 8 * (sub & 3) + 2 * e2) * 2); cc[2 * e2] = v.x; sn[2 * e2] = v.y; cc[2 * e2 + 1] = v.z; sn[2 * e2 + 1] = v.w; }
        uint4 raw[6];
#pragma unroll
        for (int hh = 0; hh < 6; ++hh) raw[hh] = *(const uint4*)((hh < 4 ? swaq + m * 256 + hh * 64 : swakv + m * 256 + (hh - 4) * 64) + 8 * sub);
        float wq8[8], wk8[8];
        { const f32x4 a0 = *(const f32x4*)(ain(I_SWAQN) + L * 64 + 8 * sub), a1 = *(const f32x4*)(ain(I_SWAQN) + L * 64 + 8 * sub + 4), b0 = *(const f32x4*)(ain(I_SWAKN) + L * 64 + 8 * sub), b1 = *(const f32x4*)(ain(I_SWAKN) + L * 64 + 8 * sub + 4);
          wq8[0] = a0.x; wq8[1] = a0.y; wq8[2] = a0.z; wq8[3] = a0.w; wq8[4] = a1.x; wq8[5] = a1.y; wq8[6] = a1.z; wq8[7] = a1.w; wk8[0] = b0.x; wk8[1] = b0.y; wk8[2] = b0.z; wk8[3] = b0.w; wk8[4] = b1.x; wk8[5] = b1.y; wk8[6] = b1.z; wk8[7] = b1.w; }
#pragma unroll
        for (int hh = 0; hh < 6; ++hh) {
            bf16* p = (hh < 4 ? swaq + m * 256 + hh * 64 : swakv + m * 256 + (hh - 4) * 64) + 8 * sub;
            const uint4 rw = raw[hh]; float x[8] = {bflo(rw.x), bfhi(rw.x), bflo(rw.y), bfhi(rw.y), bflo(rw.z), bfhi(rw.z), bflo(rw.w), bfhi(rw.w)}; float s = 0.f;
#pragma unroll
            for (int e = 0; e < 8; ++e) s += x[e] * x[e];
            s = red8(s); const float r = rsqrtf(s * (1.0f / 64.0f) + EPS);
#pragma unroll
            for (int e = 0; e < 8; ++e) { const float y = x[e] * r * (hh < 4 ? wq8[e] : wk8[e]); const float pe = __shfl_xor(y, 4); x[e] = sub < 4 ? y * cc[e] - pe * sn[e] : pe * sn[e] + y * cc[e]; }
            st8(p, x);
        }
    }
    {
#define UNP8(x, rw) float x[8] = {bflo(rw.x), bfhi(rw.x), bflo(rw.y), bfhi(rw.y), bflo(rw.z), bfhi(rw.z), bflo(rw.w), bfhi(rw.w)}
#pragma unroll
        for (int r = 0; r < 2; ++r) { const int id = tid + 512 * r, tok = id >> 4, c8 = id & 15; lds_st16(lds + T_VS + tok * T_VS_PITCH + 16 * c8, sv[r]); }
#pragma unroll
        for (int r = 0; r < 4; ++r) { const int tok = (tid >> 5) + 16 * r, c8 = tid & 31; UNP8(x, sq[r]); float s = 0.f;
#pragma unroll
            for (int e = 0; e < 8; ++e) s += x[e] * x[e];
            s = red8(s); s += __shfl_xor(s, 8); s += __shfl_xor(s, 16); const float rr = rsqrtf(s * (1.0f / 256.0f) + EPS);
            uint4 pk; pk.x = cvtpk(x[0] * rr, x[1] * rr); pk.y = cvtpk(x[2] * rr, x[3] * rr); pk.z = cvtpk(x[4] * rr, x[5] * rr); pk.w = cvtpk(x[6] * rr, x[7] * rr);
            lds_st16(lds + T_QL + tok * T_QL_PITCH + 16 * c8, pk); }
#pragma unroll
        for (int r = 0; r < 2; ++r) { const int tok = (tid >> 4) + 32 * r, c8 = tid & 15; UNP8(x, sc[r]); float s = 0.f;
#pragma unroll
            for (int e = 0; e < 8; ++e) s += x[e] * x[e];
            s = red8(s); s += __shfl_xor(s, 8); const float rr = rsqrtf(s * (1.0f / 128.0f) + EPS);
            uint4 pk; pk.x = cvtpk(x[0] * rr, x[1] * rr); pk.y = cvtpk(x[2] * rr, x[3] * rr); pk.z = cvtpk(x[4] * rr, x[5] * rr); pk.w = cvtpk(x[6] * rr, x[7] * rr);
            lds_st16(lds + T_CKV + tok * T_CKV_PITCH + 16 * c8, pk); }
#undef UNP8
    }
    __syncthreads();
    if (TSTOP < 2) return;
    if (TSTOP < 3) { __syncthreads(); return; }
    {
        const int head = wave >> 1, th = wave & 1, fr = lane & 15, fq = lane >> 4;
        const float* csm = (const float*)(ws + WS_CSMLA);
        {
            const bf16* wq_t = (const bf16*)(ws + WS_WUQ); f32x4 acc[2][6];
#pragma unroll
            for (int mt = 0; mt < 2; ++mt)
#pragma unroll
                for (int nt = 0; nt < 6; ++nt) acc[mt][nt] = (f32x4){0.f, 0.f, 0.f, 0.f};
            const bf16* wrow = wq_t + (size_t)(head * 96 + fr) * 256 + 8 * fq;
            bf16x8 bq[4][6];
#pragma unroll
            for (int k4 = 0; k4 < 4; ++k4)
#pragma unroll
                for (int nt = 0; nt < 6; ++nt) bq[k4][nt] = *(const bf16x8*)(wrow + (size_t)nt * 16 * 256 + 32 * k4);
            {
                bf16* vt = (bf16*)(ws + WS_SWAVT); const int ch = tid >> 2, tq = tid & 3; unsigned lo_[8], hi_[8], pk[8];
#pragma unroll
                for (int i = 0; i < 8; ++i) { lo_[i] = *(const LAS unsigned short*)(lds + T_VS + (16 * tq + 2 * i) * T_VS_PITCH + 2 * ch); hi_[i] = *(const LAS unsigned short*)(lds + T_VS + (16 * tq + 2 * i + 1) * T_VS_PITCH + 2 * ch); }
                __builtin_amdgcn_sched_barrier(0);
#pragma unroll
                for (int i = 0; i < 8; ++i) pk[i] = lo_[i] | (hi_[i] << 16);
                bf16* dst = vt + (size_t)(b * 2 + (ch >> 6)) * 64 * SEQ + (size_t)(t0 >> 6) * 4096 + (ch & 63) * 64 + 16 * tq;
                *(uint4*)dst = make_uint4(pk[0], pk[1], pk[2], pk[3]); *(uint4*)(dst + 8) = make_uint4(pk[4], pk[5], pk[6], pk[7]);
            }
#pragma unroll
            for (int ks = 0; ks < 8; ++ks) {
                bf16x8 a[2];
#pragma unroll
                for (int mt = 0; mt < 2; ++mt) a[mt] = *(const LAS bf16x8*)(lds + T_QL + (32 * th + 16 * mt + fr) * T_QL_PITCH + (32 * ks + 8 * fq) * 2);
#pragma unroll
                for (int nt = 0; nt < 6; ++nt) {
#pragma unroll
                    for (int mt = 0; mt < 2; ++mt) acc[mt][nt] = __builtin_amdgcn_mfma_f32_16x16x32_bf16(bq[ks & 3][nt], a[mt], acc[mt][nt], 0, 0, 0); }
                if (ks + 4 < 8) {
#pragma unroll
                    for (int nt = 0; nt < 6; ++nt) bq[ks & 3][nt] = *(const bf16x8*)(wrow + (size_t)nt * 16 * 256 + 32 * (ks + 4));
                }
            }
            const float* wn = ain(I_MQN) + L * 96; bf16* mq = (bf16*)(ws + WS_MLAQ);
            asm volatile("" ::: "memory");
            f32x4 wq4[6], csq[2][2];
#pragma unroll
            for (int nt = 0; nt < 6; ++nt) wq4[nt] = *(const f32x4*)(wn + 16 * nt + 4 * fq);
#pragma unroll
            for (int mt = 0; mt < 2; ++mt) { const int tok_ = 32 * th + 16 * mt + fr; csq[mt][0] = *(const f32x4*)(csm + ((size_t)(t0 + tok_) * 16 + 4 * fq) * 2); csq[mt][1] = *(const f32x4*)(csm + ((size_t)(t0 + tok_) * 16 + 4 * fq + 2) * 2); }
#pragma unroll
            for (int mt = 0; mt < 2; ++mt) {
                const int tok = 32 * th + 16 * mt + fr; float s = 0.f;
#pragma unroll
                for (int nt = 0; nt < 6; ++nt) s += (acc[mt][nt][0] * acc[mt][nt][0] + acc[mt][nt][1] * acc[mt][nt][1]) + (acc[mt][nt][2] * acc[mt][nt][2] + acc[mt][nt][3] * acc[mt][nt][3]);
                s += __shfl_xor(s, 16); s += __shfl_xor(s, 32); const float r2 = rsqrtf(s * (1.0f / 96.0f) + EPS);
#pragma unroll
                for (int nt = 0; nt < 6; ++nt) acc[mt][nt] = acc[mt][nt] * r2 * wq4[nt];
                const f32x4 cs0 = csq[mt][0], cs1 = csq[mt][1];
                const float cc[4] = {cs0.x, cs0.z, cs1.x, cs1.z}, sn[4] = {cs0.y, cs0.w, cs1.y, cs1.w};
#pragma unroll
                for (int e = 0; e < 4; ++e) { const float x1 = acc[mt][4][e], x2 = acc[mt][5][e]; acc[mt][4][e] = x1 * cc[e] - x2 * sn[e]; acc[mt][5][e] = x1 * sn[e] + x2 * cc[e]; }
#pragma unroll
                for (int nt = 0; nt < 6; ++nt) { uint2 w; w.x = cvtpk(acc[mt][nt][0], acc[mt][nt][1]); w.y = cvtpk(acc[mt][nt][2], acc[mt][nt][3]); *(uint2*)(mq + (m0 + tok) * 384 + head * 96 + 16 * nt + 4 * fq) = w; }
            }
        }
        if (TSTOP < 4) { __syncthreads(); return; }
        {
            const bf16* wkv_t = (const bf16*)(ws + WS_WUKV); f32x4 ak[2][4], av[2][4];
#pragma unroll
            for (int mt = 0; mt < 2; ++mt)
#pragma unroll
                for (int nt = 0; nt < 4; ++nt) { ak[mt][nt] = (f32x4){0.f, 0.f, 0.f, 0.f}; av[mt][nt] = (f32x4){0.f, 0.f, 0.f, 0.f}; }
            const bf16* wrk = wkv_t + (size_t)(head * 128 + fr) * 128 + 8 * fq; const bf16* wrv = wrk + (size_t)64 * 128;
            bf16x8 bk[4][4], bv[4][4];
#pragma unroll
            for (int ks = 0; ks < 4; ++ks)
#pragma unroll
                for (int nt = 0; nt < 4; ++nt) { bk[ks][nt] = *(const bf16x8*)(wrk + (size_t)nt * 16 * 128 + 32 * ks); bv[ks][nt] = *(const bf16x8*)(wrv + (size_t)nt * 16 * 128 + 32 * ks); }
#pragma unroll
            for (int ks = 0; ks < 4; ++ks) {
                bf16x8 a[2];
#pragma unroll
                for (int mt = 0; mt < 2; ++mt) a[mt] = *(const LAS bf16x8*)(lds + T_CKV + (32 * th + 16 * mt + fr) * T_CKV_PITCH + (32 * ks + 8 * fq) * 2);
#pragma unroll
                for (int nt = 0; nt < 4; ++nt) {
#pragma unroll
                    for (int mt = 0; mt < 2; ++mt) { ak[mt][nt] = __builtin_amdgcn_mfma_f32_16x16x32_bf16(bk[ks][nt], a[mt], ak[mt][nt], 0, 0, 0); av[mt][nt] = __builtin_amdgcn_mfma_f32_16x16x32_bf16(a[mt], bv[ks][nt], av[mt][nt], 0, 0, 0); } }
            }
            const float* wn = ain(I_MKN) + L * 96; bf16* mk = (bf16*)(ws + WS_MLAK); bf16* mvt = (bf16*)(ws + WS_MLAVT); const bf16* mm = (const bf16*)(ws + WS_MLAM);
            asm volatile("" ::: "memory");
            f32x4 wk4[4], wkr[2], csk[2][4]; uint4 krw[2];
#pragma unroll
            for (int nt = 0; nt < 4; ++nt) wk4[nt] = *(const f32x4*)(wn + 16 * nt + 4 * fq);
            wkr[0] = *(const f32x4*)(wn + 64 + 8 * fq); wkr[1] = *(const f32x4*)(wn + 64 + 8 * fq + 4);
#pragma unroll
            for (int mt = 0; mt < 2; ++mt) { const int tok_ = 32 * th + 16 * mt + fr; krw[mt] = *(const uint4*)(mm + (m0 + tok_) * 256 + 128 + 8 * fq);
#pragma unroll
                for (int e2 = 0; e2 < 4; ++e2) csk[mt][e2] = *(const f32x4*)(csm + ((size_t)(t0 + tok_) * 16 + 8 * (fq & 1) + 2 * e2) * 2); }
#pragma unroll
            for (int mt = 0; mt < 2; ++mt) {
                const int tok = 32 * th + 16 * mt + fr; const uint4 kw_ = krw[mt]; float kr[8] = {bflo(kw_.x), bfhi(kw_.x), bflo(kw_.y), bfhi(kw_.y), bflo(kw_.z), bfhi(kw_.z), bflo(kw_.w), bfhi(kw_.w)}; float s = 0.f;
#pragma unroll
                for (int nt = 0; nt < 4; ++nt) s += (ak[mt][nt][0] * ak[mt][nt][0] + ak[mt][nt][1] * ak[mt][nt][1]) + (ak[mt][nt][2] * ak[mt][nt][2] + ak[mt][nt][3] * ak[mt][nt][3]);
#pragma unroll
                for (int e = 0; e < 8; ++e) s += kr[e] * kr[e];
                s += __shfl_xor(s, 16); s += __shfl_xor(s, 32); const float r2 = rsqrtf(s * (1.0f / 96.0f) + EPS);
#pragma unroll
                for (int nt = 0; nt < 4; ++nt) { const f32x4 kk = ak[mt][nt] * r2 * wk4[nt]; uint2 w; w.x = cvtpk(kk[0], kk[1]); w.y = cvtpk(kk[2], kk[3]); *(uint2*)(mk + (m0 + tok) * 384 + head * 96 + 16 * nt + 4 * fq) = w; }
                float cc[8], sn[8];
#pragma unroll
                for (int e2 = 0; e2 < 4; ++e2) { const f32x4 v = csk[mt][e2]; cc[2 * e2] = v.x; sn[2 * e2] = v.y; cc[2 * e2 + 1] = v.z; sn[2 * e2 + 1] = v.w; }
#pragma unroll
                for (int e = 0; e < 8; ++e) { const float y = kr[e] * r2 * wkr[e >> 2][e & 3]; const float pe = __shfl_xor(y, 32); kr[e] = fq < 2 ? y * cc[e] - pe * sn[e] : pe * sn[e] + y * cc[e]; }
                st8(mk + (m0 + tok) * 384 + head * 96 + 64 + 8 * fq, kr);
#pragma unroll
                for (int nt = 0; nt < 4; ++nt) { uint2 w; w.x = cvtpk(av[mt][nt][0], av[mt][nt][1]); w.y = cvtpk(av[mt][nt][2], av[mt][nt][3]);
                    *(uint2*)(mvt + (size_t)(b * 4 + head) * 64 * SEQ + (size_t)(t0 >> 6) * 4096 + (16 * nt + fr) * 64 + 32 * th + 16 * mt + 4 * fq) = w; }
            }
        }
    }
    __syncthreads();
}


__device__ __forceinline__ float max3f(float a, float b, float c) { float r; asm("v_max3_f32 %0, %1, %2, %3" : "=v"(r) : "v"(a), "v"(b), "v"(c)); return r; }
__device__ __forceinline__ float max2f(float a, float b) { float r; asm("v_max_f32_e32 %0, %1, %2" : "=v"(r) : "v"(a), "v"(b)); return r; }
__device__ __forceinline__ float xhalf_max(float x) { const unsigned u = __float_as_uint(x); const auto r = __builtin_amdgcn_permlane32_swap(u, u, false, false); return max2f(__uint_as_float(r[0]), __uint_as_float(r[1])); }
#define OPQ(x) asm("" : "+v"(x))
template <int DQK> struct AttnCfg { static constexpr int KP = DQK * 2 + 16, VP = 144, KB = 64 * KP, VB = 64 * VP, BUF = KB + VB, NKS = DQK / 16, KCH = 64 * DQK / 8; };

template <int DQK, bool SWA>
__device__ __forceinline__ void attn_unit(LAS unsigned char* lds, int L, int unit, int tid, int wave, int lane) {
    typedef AttnCfg<DQK> C;
    static_assert(3 * C::BUF <= RING_BYTES, "attention LDS ring");
    unsigned char* ws = aws();
    const int hh = lane >> 5, ql = lane & 31, b = unit >> 6;
    const int qb = SWA ? (unit & 31) : (unit & 15), h = SWA ? 2 * ((unit >> 5) & 1) + (wave >> 2) : (unit >> 4) & 3;
    const int q0 = SWA ? 128 * qb + 32 * (wave & 3) : 256 * qb + 32 * wave;
    const bool late = wave < 4;
    const bf16* Kg; const bf16* Vt; const bf16* Qg; int kpitch, qpitch, ycol, slot; float c2, m_init, l_init;
    if (SWA) { const int kvh = h >> 1; Kg = (const bf16*)(ws + WS_SWAKV) + (size_t)b * SEQ * 256 + kvh * 64; kpitch = 256; Vt = (const bf16*)(ws + WS_SWAVT) + (size_t)(b * 2 + kvh) * 64 * SEQ;
        Qg = (const bf16*)(ws + WS_SWAQ) + (size_t)b * SEQ * 256 + h * 64; qpitch = 256; ycol = 512 + h * 64; slot = 8 + h; c2 = 0.125f * 1.4426950408889634f;
        m_init = ain(I_SINK)[L * 4 + h] * 1.4426950408889634f; l_init = hh == 0 ? 1.0f : 0.0f; }
    else { Kg = (const bf16*)(ws + WS_MLAK) + (size_t)b * SEQ * 384 + h * 96; kpitch = 384; Vt = (const bf16*)(ws + WS_MLAVT) + (size_t)(b * 4 + h) * 64 * SEQ;
        Qg = (const bf16*)(ws + WS_MLAQ) + (size_t)b * SEQ * 384 + h * 96; qpitch = 384; ycol = 768 + h * 64; slot = 12 + h; c2 = 0.10206207261596577f * 1.4426950408889634f; m_init = 0.f; l_init = 0.f; }
    bf16x8 qf[C::NKS];
#pragma unroll
    for (int ks = 0; ks < C::NKS; ++ks) { float x[8]; ld8(Qg + (size_t)(q0 + ql) * qpitch + 16 * ks + 8 * hh, x);
        union { bf16x8 v; unsigned u[4]; } t; t.u[0] = cvtpk(x[0] * c2, x[1] * c2); t.u[1] = cvtpk(x[2] * c2, x[3] * c2); t.u[2] = cvtpk(x[4] * c2, x[5] * c2); t.u[3] = cvtpk(x[6] * c2, x[7] * c2); qf[ks] = t.v; }
    int j0 = 0, j1 = SEQ / 64;
    if (SWA) { j0 = 2 * qb - 2 < 0 ? 0 : 2 * qb - 2; j1 = 2 * qb + 4 > SEQ / 64 ? SEQ / 64 : 2 * qb + 4; }
    f32x16 o0, o1;
#pragma unroll
    for (int i = 0; i < 16; ++i) { o0[i] = 0.f; o1[i] = 0.f; }
    float mrun = m_init, lrun = l_init;
    uint4 kr0A, kr1A = make_uint4(0u, 0u, 0u, 0u), vrA, kr0B, kr1B = make_uint4(0u, 0u, 0u, 0u), vrB;
    constexpr int CPR = DQK / 8;
    const int kc0 = tid, kc1 = tid + 512; const bool has1 = (C::KCH > 512) && (kc1 < C::KCH);
    const int vrow = tid >> 3, vc = tid & 7, vo0 = 32 * (vc >> 1) + ((vc & 1) ? 8 : 0), vo1 = 32 * (vc >> 1) + ((vc & 1) ? 24 : 16);
#define ATT_LOAD(j, R) do { const size_t key0_ = (size_t)(j) * 64; \
        kr0##R = *(const uint4*)(Kg + (key0_ + kc0 / CPR) * kpitch + 8 * (kc0 % CPR)); \
        if (has1) kr1##R = *(const uint4*)(Kg + (key0_ + kc1 / CPR) * kpitch + 8 * (kc1 % CPR)); \
        vr##R = *(const uint4*)(Vt + (size_t)(j) * 4096 + vrow * 64 + 8 * vc); } while (0)
#define ATT_STORE(bufp, R) do { LAS unsigned char* kb_ = (bufp); LAS unsigned char* vb_ = kb_ + C::KB; \
        lds_st16(kb_ + (kc0 / CPR) * C::KP + 16 * (kc0 % CPR), kr0##R); \
        if (has1) lds_st16(kb_ + (kc1 / CPR) * C::KP + 16 * (kc1 % CPR), kr1##R); \
        *(LAS v2u*)(vb_ + vrow * C::VP + vo0) = (v2u){vr##R.x, vr##R.y}; *(LAS v2u*)(vb_ + vrow * C::VP + vo1) = (v2u){vr##R.z, vr##R.w}; } while (0)
#define ATT_VLD(vbp) do { const LAS unsigned char* v0_ = (vbp) + ql * C::VP + 16 * hh; const LAS unsigned char* v1_ = v0_ + 32 * C::VP; \
        _Pragma("unroll") for (int i_ = 0; i_ < 4; ++i_) { vf[2 * i_] = *(const LAS bf16x8*)(v0_ + 32 * i_); vf[2 * i_ + 1] = *(const LAS bf16x8*)(v1_ + 32 * i_); } } while (0)
#define ATT_PV(P0, P1, P2, P3) do { \
        o0 = __builtin_amdgcn_mfma_f32_32x32x16_bf16(vf[0], P0, o0, 0, 0, 0); o1 = __builtin_amdgcn_mfma_f32_32x32x16_bf16(vf[1], P0, o1, 0, 0, 0); \
        o0 = __builtin_amdgcn_mfma_f32_32x32x16_bf16(vf[2], P1, o0, 0, 0, 0); o1 = __builtin_amdgcn_mfma_f32_32x32x16_bf16(vf[3], P1, o1, 0, 0, 0); \
        o0 = __builtin_amdgcn_mfma_f32_32x32x16_bf16(vf[4], P2, o0, 0, 0, 0); o1 = __builtin_amdgcn_mfma_f32_32x32x16_bf16(vf[5], P2, o1, 0, 0, 0); \
        o0 = __builtin_amdgcn_mfma_f32_32x32x16_bf16(vf[6], P3, o0, 0, 0, 0); o1 = __builtin_amdgcn_mfma_f32_32x32x16_bf16(vf[7], P3, o1, 0, 0, 0); } while (0)
    ATT_LOAD(j0, A); ATT_STORE(lds, A);
    if (j0 + 1 < j1) ATT_LOAD(j0 + 1, B);
    __syncthreads();
#define ATT_ITER(LATE_, LD_, ST_) { \
        const int bn = bi == 2 ? 0 : bi + 1, bp = bi == 0 ? 2 : bi - 1; \
        LAS unsigned char* kb = lds + bi * C::BUF; LAS unsigned char* vb = kb + C::KB; \
        const bool more = j + 1 < j1; \
        if (more) ATT_STORE(lds + bn * C::BUF, ST_); \
        if (j + 2 < j1) ATT_LOAD(j + 2, LD_); \
        bool active = true; \
        if (SWA) active = !(64 * j + 63 < q0 - 128 || 64 * j > q0 + 31 + 128); \
 \
        bf16x8 vf[8], kf[2 * C::NKS]; \
        if (LATE_ && pend) { ATT_VLD(lds + bp * C::BUF + C::KB); ATT_PV(pp0, pp1, pp2, pp3); } \
        if (active) { \
_Pragma("unroll") \
            for (int ks = 0; ks < C::NKS; ++ks) { kf[2 * ks] = *(const LAS bf16x8*)(kb + ql * C::KP + (16 * ks + 8 * hh) * 2); kf[2 * ks + 1] = *(const LAS bf16x8*)(kb + (32 + ql) * C::KP + (16 * ks + 8 * hh) * 2); } \
            f32x16 s0, s1; { const float nm_ = -mrun; _Pragma("unroll") for (int i = 0; i < 16; ++i) { s0[i] = nm_; s1[i] = nm_; } } \
_Pragma("unroll") \
            for (int ks = 0; ks < C::NKS; ++ks) { \
                s0 = __builtin_amdgcn_mfma_f32_32x32x16_bf16(kf[2 * ks], qf[ks], s0, 0, 0, 0); \
                s1 = __builtin_amdgcn_mfma_f32_32x32x16_bf16(kf[2 * ks + 1], qf[ks], s1, 0, 0, 0); \
            } \
            asm volatile("s_nop 7\n\ts_nop 7" : "+v"(s0), "+v"(s1)); \
            if (!LATE_) ATT_VLD(vb); \
            if (SWA) { \
                const int qpos = q0 + ql, kbase = 64 * j + 4 * hh; \
_Pragma("unroll") \
                for (int r = 0; r < 16; ++r) { const int kp = kbase + (r & 3) + 8 * (r >> 2); const int d0 = kp - qpos, d1 = d0 + 32; \
                    if (d0 > 128 || d0 < -128) s0[r] = -INFINITY; if (d1 > 128 || d1 < -128) s1[r] = -INFINITY; } \
            } \
            float mxa = max2f(s0[0], s1[0]), mxb = max2f(s0[1], s1[1]), mxc = max2f(s0[2], s1[2]), mxd = max2f(s0[3], s1[3]); \
_Pragma("unroll") \
            for (int r = 4; r < 16; r += 4) { mxa = max3f(mxa, s0[r], s1[r]); mxb = max3f(mxb, s0[r + 1], s1[r + 1]); mxc = max3f(mxc, s0[r + 2], s1[r + 2]); mxd = max3f(mxd, s0[r + 3], s1[r + 3]); } \
            float mx = max2f(mxa, mxb); mx = max3f(mx, mxc, mxd); mx = xhalf_max(mx); \
            if (!__all(mx <= 8.0f)) { \
                const float dlt = max2f(mx, 0.f), alpha = __builtin_amdgcn_exp2f(-dlt); mrun += dlt; lrun *= alpha; \
_Pragma("unroll") \
                for (int i = 0; i < 16; ++i) { o0[i] *= alpha; o1[i] *= alpha; s0[i] -= dlt; s1[i] -= dlt; } \
            } \
            float la, lb, lc, ld; \
_Pragma("unroll") \
            for (int r = 0; r < 16; ++r) { s0[r] = __builtin_amdgcn_exp2f(s0[r]); s1[r] = __builtin_amdgcn_exp2f(s1[r]); \
                if (r == 0) { la = s0[r]; lb = s1[r]; } else if (r == 1) { lc = s0[r]; ld = s1[r]; } \
                else if ((r & 1) == 0) { la += s0[r]; OPQ(la); lb += s1[r]; OPQ(lb); } else { lc += s0[r]; OPQ(lc); ld += s1[r]; OPQ(ld); } } \
            la += lb; OPQ(la); lc += ld; OPQ(lc); lrun += la; OPQ(lrun); lrun += lc; \
            union { bf16x8 v; unsigned u[4]; } f0, f1, f2, f3; \
_Pragma("unroll") \
            for (int e = 0; e < 4; ++e) { f0.u[e] = cvtpk(s0[2 * e], s0[2 * e + 1]); f1.u[e] = cvtpk(s0[8 + 2 * e], s0[8 + 2 * e + 1]); f2.u[e] = cvtpk(s1[2 * e], s1[2 * e + 1]); f3.u[e] = cvtpk(s1[8 + 2 * e], s1[8 + 2 * e + 1]); } \
            if (LATE_) { pp0 = f0.v; pp1 = f1.v; pp2 = f2.v; pp3 = f3.v; pend = true; } \
            else ATT_PV(f0.v, f1.v, f2.v, f3.v); \
        } else if (LATE_) pend = false; \
        __syncthreads(); \
        bi = bn; \
    }
#define ATT_LOOP(LATE_) { \
    bf16x8 pp0 = qf[0], pp1 = qf[0], pp2 = qf[0], pp3 = qf[0]; bool pend = false; \
    int bi = 0; \
    for (int j = j0; j < j1; ++j) { \
        ATT_ITER(LATE_, A, B) \
        if (++j >= j1) break; \
        ATT_ITER(LATE_, B, A) \
    } \
    if (LATE_ && pend) { const int bp = bi == 0 ? 2 : bi - 1; bf16x8 vf[8]; ATT_VLD(lds + bp * C::BUF + C::KB); ATT_PV(pp0, pp1, pp2, pp3); } \
    }
    if (late) ATT_LOOP(true) else ATT_LOOP(false)
#undef ATT_LOOP
#undef ATT_ITER
#undef ATT_LOAD
#undef ATT_STORE
#undef ATT_PV
#undef ATT_VLD
    lrun += __shfl_xor(lrun, 32); const float inv = 1.0f / lrun; float sq = 0.f;
#pragma unroll
    for (int i = 0; i < 16; ++i) { o0[i] *= inv; o1[i] *= inv; sq += o0[i] * o0[i] + o1[i] * o1[i]; }
    sq += __shfl_xor(sq, 32);
    const size_t m = (size_t)b * SEQ + q0 + ql;
    if (hh == 0) ((float*)(ws + WS_SSQ))[m * 16 + slot] = sq;
    bf16* y = (bf16*)(ws + WS_Y) + m * 1024 + ycol + 4 * hh;
#pragma unroll
    for (int g4 = 0; g4 < 4; ++g4) { uint2 w0, w1; w0.x = cvtpk(o0[4 * g4], o0[4 * g4 + 1]); w0.y = cvtpk(o0[4 * g4 + 2], o0[4 * g4 + 3]); w1.x = cvtpk(o1[4 * g4], o1[4 * g4 + 1]); w1.y = cvtpk(o1[4 * g4 + 2], o1[4 * g4 + 3]);
        *(uint2*)(y + 8 * g4) = w0; *(uint2*)(y + 32 + 8 * g4) = w1; }
    __syncthreads();
}

__device__ __forceinline__ void swa_unit(LAS unsigned char* lds, int L, int unit, int tid, int wave, int lane) {
    typedef AttnCfg<64> C;
    static_assert(6 * C::BUF <= RING_BYTES, "SWA window in LDS");
    unsigned char* ws = aws();
    const int hh = lane >> 5, ql = lane & 31, b = unit >> 6, qb = unit & 31, kvh = (unit >> 5) & 1, h = 2 * kvh + (wave >> 2);
    const int q0 = 128 * qb + 32 * (wave & 3);
    const bf16* Kg = (const bf16*)(ws + WS_SWAKV) + (size_t)b * SEQ * 256 + kvh * 64; const bf16* Vt = (const bf16*)(ws + WS_SWAVT) + (size_t)(b * 2 + kvh) * 64 * SEQ;
    const bf16* Qg = (const bf16*)(ws + WS_SWAQ) + (size_t)b * SEQ * 256 + h * 64;
    const float c2 = 0.125f * 1.4426950408889634f;
    const int j0 = 2 * qb - 2 < 0 ? 0 : 2 * qb - 2, j1 = 2 * qb + 4 > SEQ / 64 ? SEQ / 64 : 2 * qb + 4, nt = j1 - j0;
    const int krow = tid >> 3, kc = tid & 7, vrow = tid >> 3, vc = tid & 7, vo0 = 32 * (vc >> 1) + ((vc & 1) ? 8 : 0), vo1 = 32 * (vc >> 1) + ((vc & 1) ? 24 : 16);
    uint4 kr[6], vr[6];
#pragma unroll
    for (int t = 0; t < 6; ++t) { const size_t key0 = (size_t)(j0 + t < j1 ? j0 + t : j1 - 1) * 64;
        kr[t] = *(const uint4*)(Kg + (key0 + krow) * 256 + 8 * kc); vr[t] = *(const uint4*)(Vt + (key0 >> 6) * 4096 + vrow * 64 + 8 * vc); }
    uint4 qraw[4];
#pragma unroll
    for (int ks = 0; ks < 4; ++ks) qraw[ks] = *(const uint4*)(Qg + (size_t)(q0 + ql) * 256 + 16 * ks + 8 * hh);
    float mrun = ain(I_SINK)[L * 4 + h] * 1.4426950408889634f, lrun = hh == 0 ? 1.0f : 0.0f;
#pragma unroll
    for (int t = 0; t < 6; ++t) { LAS unsigned char* kb_ = lds + t * C::BUF; LAS unsigned char* vb_ = kb_ + C::KB;
        lds_st16(kb_ + krow * C::KP + 16 * kc, kr[t]);
        *(LAS v2u*)(vb_ + vrow * C::VP + vo0) = (v2u){vr[t].x, vr[t].y}; *(LAS v2u*)(vb_ + vrow * C::VP + vo1) = (v2u){vr[t].z, vr[t].w}; }
    bf16x8 qf[4];
#pragma unroll
    for (int ks = 0; ks < 4; ++ks) { const unsigned w4[4] = {qraw[ks].x, qraw[ks].y, qraw[ks].z, qraw[ks].w}; union { bf16x8 v; unsigned u[4]; } t;
#pragma unroll
        for (int e = 0; e < 4; ++e) t.u[e] = cvtpk(bflo(w4[e]) * c2, bfhi(w4[e]) * c2);
        qf[ks] = t.v; }
    f32x16 o0, o1;
#pragma unroll
    for (int i = 0; i < 16; ++i) { o0[i] = 0.f; o1[i] = 0.f; }
    __syncthreads();
#pragma unroll 1
    for (int t = 0; t < nt; ++t) {
        const int j = j0 + t;
        if (64 * j + 63 < q0 - 128 || 64 * j > q0 + 31 + 128) continue;
        const LAS unsigned char* kb = lds + t * C::BUF; const LAS unsigned char* vb = kb + C::KB;
        bf16x8 kf[8], vf[8];
#pragma unroll
        for (int ks = 0; ks < 4; ++ks) { kf[2 * ks] = *(const LAS bf16x8*)(kb + ql * C::KP + (16 * ks + 8 * hh) * 2); kf[2 * ks + 1] = *(const LAS bf16x8*)(kb + (32 + ql) * C::KP + (16 * ks + 8 * hh) * 2); }
        { const LAS unsigned char* v0_ = vb + ql * C::VP + 16 * hh; const LAS unsigned char* v1_ = v0_ + 32 * C::VP;
#pragma unroll
          for (int i_ = 0; i_ < 4; ++i_) { vf[2 * i_] = *(const LAS bf16x8*)(v0_ + 32 * i_); vf[2 * i_ + 1] = *(const LAS bf16x8*)(v1_ + 32 * i_); } }
        f32x16 s0, s1; { const float nm_ = -mrun;
#pragma unroll
            for (int i = 0; i < 16; ++i) { s0[i] = nm_; s1[i] = nm_; } }
#pragma unroll
        for (int ks = 0; ks < 4; ++ks) { s0 = __builtin_amdgcn_mfma_f32_32x32x16_bf16(kf[2 * ks], qf[ks], s0, 0, 0, 0); s1 = __builtin_amdgcn_mfma_f32_32x32x16_bf16(kf[2 * ks + 1], qf[ks], s1, 0, 0, 0); }
        asm volatile("s_nop 7\n\ts_nop 7" : "+v"(s0), "+v"(s1));
        { const int qpos = q0 + ql, kbase = 64 * j + 4 * hh;
#pragma unroll
          for (int r = 0; r < 16; ++r) { const int kp = kbase + (r & 3) + 8 * (r >> 2); const int d0 = kp - qpos, d1 = d0 + 32;
              if (d0 > 128 || d0 < -128) s0[r] = -INFINITY; if (d1 > 128 || d1 < -128) s1[r] = -INFINITY; } }
        float mxa = max2f(s0[0], s1[0]), mxb = max2f(s0[1], s1[1]), mxc = max2f(s0[2], s1[2]), mxd = max2f(s0[3], s1[3]);
#pragma unroll
        for (int r = 4; r < 16; r += 4) { mxa = max3f(mxa, s0[r], s1[r]); mxb = max3f(mxb, s0[r + 1], s1[r + 1]); mxc = max3f(mxc, s0[r + 2], s1[r + 2]); mxd = max3f(mxd, s0[r + 3], s1[r + 3]); }
        float mx = max2f(mxa, mxb); mx = max3f(mx, mxc, mxd); mx = xhalf_max(mx);
        if (!__all(mx <= 8.0f)) {
            const float dlt = max2f(mx, 0.f), alpha = __builtin_amdgcn_exp2f(-dlt); mrun += dlt; lrun *= alpha;
#pragma unroll
            for (int i = 0; i < 16; ++i) { o0[i] *= alpha; o1[i] *= alpha; s0[i] -= dlt; s1[i] -= dlt; }
        }
        float la, lb, lc, ld;
#pragma unroll
        for (int r = 0; r < 16; ++r) { s0[r] = __builtin_amdgcn_exp2f(s0[r]); s1[r] = __builtin_amdgcn_exp2f(s1[r]);
            if (r == 0) { la = s0[r]; lb = s1[r]; } else if (r == 1) { lc = s0[r]; ld = s1[r]; }
            else if ((r & 1) == 0) { la += s0[r]; OPQ(la); lb += s1[r]; OPQ(lb); } else { lc += s0[r]; OPQ(lc); ld += s1[r]; OPQ(ld); } }
        la += lb; OPQ(la); lc += ld; OPQ(lc); lrun += la; OPQ(lrun); lrun += lc;
        union { bf16x8 v; unsigned u[4]; } f0, f1, f2, f3;
#pragma unroll
        for (int e = 0; e < 4; ++e) { f0.u[e] = cvtpk(s0[2 * e], s0[2 * e + 1]); f1.u[e] = cvtpk(s0[8 + 2 * e], s0[8 + 2 * e + 1]); f2.u[e] = cvtpk(s1[2 * e], s1[2 * e + 1]); f3.u[e] = cvtpk(s1[8 + 2 * e], s1[8 + 2 * e + 1]); }
        o0 = __builtin_amdgcn_mfma_f32_32x32x16_bf16(vf[0], f0.v, o0, 0, 0, 0); o1 = __builtin_amdgcn_mfma_f32_32x32x16_bf16(vf[1], f0.v, o1, 0, 0, 0);
        o0 = __builtin_amdgcn_mfma_f32_32x32x16_bf16(vf[2], f1.v, o0, 0, 0, 0); o1 = __builtin_amdgcn_mfma_f32_32x32x16_bf16(vf[3], f1.v, o1, 0, 0, 0);
        o0 = __builtin_amdgcn_mfma_f32_32x32x16_bf16(vf[4], f2.v, o0, 0, 0, 0); o1 = __builtin_amdgcn_mfma_f32_32x32x16_bf16(vf[5], f2.v, o1, 0, 0, 0);
        o0 = __builtin_amdgcn_mfma_f32_32x32x16_bf16(vf[6], f3.v, o0, 0, 0, 0); o1 = __builtin_amdgcn_mfma_f32_32x32x16_bf16(vf[7], f3.v, o1, 0, 0, 0);
    }
    lrun += __shfl_xor(lrun, 32); const float inv = 1.0f / lrun; float sq = 0.f;
#pragma unroll
    for (int i = 0; i < 16; ++i) { o0[i] *= inv; o1[i] *= inv; sq += o0[i] * o0[i] + o1[i] * o1[i]; }
    sq += __shfl_xor(sq, 32);
    const size_t m = (size_t)b * SEQ + q0 + ql;
    if (hh == 0) ((float*)(ws + WS_SSQ))[m * 16 + 8 + h] = sq;
    bf16* y = (bf16*)(ws + WS_Y) + m * 1024 + 512 + h * 64 + 4 * hh;
#pragma unroll
    for (int g4 = 0; g4 < 4; ++g4) { uint2 w0, w1; w0.x = cvtpk(o0[4 * g4], o0[4 * g4 + 1]); w0.y = cvtpk(o0[4 * g4 + 2], o0[4 * g4 + 3]); w1.x = cvtpk(o1[4 * g4], o1[4 * g4 + 1]); w1.y = cvtpk(o1[4 * g4 + 2], o1[4 * g4 + 3]);
        *(uint2*)(y + 8 * g4) = w0; *(uint2*)(y + 32 + 8 * g4) = w1; }
    __syncthreads();
}

__device__ __forceinline__ void ssd_state_pass(int gtid) {
    unsigned char* ws = aws();
    if (gtid < 64 * 2048) {
        const int bhd = gtid >> 11, e = (gtid & 2047) * 4, dir = bhd & 1, h = (bhd >> 1) & 7, b = bhd >> 4;
        const float* dtc = (const float*)(ws + WS_DTC); const bf16* st = (const bf16*)aout(); bf16* sin = (bf16*)(ws + WS_SIN);
        f32x4 v[16]; float d[16]; uint2 vw[16];
#pragma unroll
        for (int k = 0; k < 16; ++k) vw[k] = *(const uint2*)(st + ((size_t)((b * 16 + k) * 8 + h) * 2 + dir) * 8192 + e);
#pragma unroll
        for (int k = 0; k < 16; ++k) { v[k] = (f32x4){bflo(vw[k].x), bfhi(vw[k].x), bflo(vw[k].y), bfhi(vw[k].y)};
            const size_t mt = (size_t)b * SEQ + (size_t)k * 256 + (dir == 0 ? 255 : 0); d[k] = __expf(dtc[(mt * 8 + h) * 4 + 2 + dir]); }
        f32x4 S = (f32x4){0.f, 0.f, 0.f, 0.f};
        bf16* o = sin + ((size_t)((b * 16) * 8 + h) * 2 + dir) * 8192 + e; constexpr size_t CS = (size_t)8 * 2 * 8192;
        if (dir == 0) {
#pragma unroll
            for (int k = 0; k < 16; ++k) { *(uint2*)(o + k * CS) = make_uint2(cvtpk(S[0], S[1]), cvtpk(S[2], S[3])); S = S * d[k] + v[k]; }
        } else {
#pragma unroll
            for (int k = 15; k >= 0; --k) { *(uint2*)(o + k * CS) = make_uint2(cvtpk(S[0], S[1]), cvtpk(S[2], S[3])); S = S * d[k] + v[k]; }
        }
    }
}
__device__ __forceinline__ void sp_arrive(unsigned* cnt, int tid) {
    asm volatile("s_waitcnt vmcnt(0)" ::: "memory"); __syncthreads();
    if (tid == 0) { __builtin_amdgcn_fence(__ATOMIC_RELEASE, "agent"); asm volatile("s_waitcnt vmcnt(0)" ::: "memory"); (void)xb_add(cnt, 1u); }
}
__device__ __forceinline__ void sp_wait(unsigned* cnt, unsigned G, int tid) {
    if (tid == 0) { unsigned sp = 0; while (xb_ld(cnt) < G) { __builtin_amdgcn_s_sleep(2); if (++sp > (1u << 22)) break; }
        __builtin_amdgcn_fence(__ATOMIC_ACQUIRE, "agent"); asm volatile("s_waitcnt vmcnt(0)" ::: "memory"); }
    __syncthreads();
}

constexpr int O_BM = 0, O_BM_PITCH = 272, O_S = 256 * 272, O_S_PITCH = 272, O_X = O_S + 2 * 64 * O_S_PITCH, O_X_PITCH = 192;
static_assert(O_X + 256 * O_X_PITCH <= TAB_OFF, "SSD out unit LDS (RTAB is dead in this phase)");

__device__ __forceinline__ void ssd_out_unit(LAS unsigned char* lds, int L, int unit, int tid, int wave, int lane, int abl = 0) {
    unsigned char* ws = aws();
    const int h = unit & 7, c = (unit >> 3) & 15, b = unit >> 7, g = h >> 2, hh = lane >> 5, ql = lane & 31;
    const size_t m0 = (size_t)b * SEQ + (size_t)c * 256;
    const bf16* xc = (const bf16*)(ws + WS_XBCC); const float* dtc = (const float*)(ws + WS_DTC);
    LAS float* tF = (LAS float*)(lds + TAB_OFF); LAS float* tB = tF + 256; LAS float* tD = tF + 512;
    int nst_ = __builtin_amdgcn_readfirstlane(REPB(16) ? 2 : (abl == 1 ? 0 : 1));
    for (int st_ = 0; st_ < nst_; ++st_) {
    if (st_ > 0) __syncthreads();
    { const int ti = tid & 255; const f32x4 v = *(const f32x4*)(dtc + ((m0 + ti) * 8 + h) * 4);
        tF[ti] = v[2] * 1.4426950408889634f - __builtin_amdgcn_logf(v[0]); tB[ti] = v[3] * 1.4426950408889634f - __builtin_amdgcn_logf(v[1]); tD[ti] = v[0] + v[1]; }
#pragma unroll
    for (int r = 0; r < 8; ++r) { const int id = tid + 512 * r, s = id >> 4, c8 = id & 15; lds_st16(lds + O_BM + s * O_BM_PITCH + 16 * c8, *(const uint4*)(xc + (m0 + s) * 1024 + 512 + g * 128 + 8 * c8)); }
#pragma unroll
    for (int r = 0; r < 4; ++r) { const int id = tid + 512 * r, s = id >> 3, c8 = id & 7; lds_st16(lds + O_X + s * O_X_PITCH + 16 * c8, *(const uint4*)(xc + (m0 + s) * 1024 + h * 64 + 8 * c8)); }
    {
        const bf16* sin = (const bf16*)(ws + WS_SIN) + ((size_t)((b * 16 + c) * 8 + h) * 2) * 8192;
#pragma unroll
        for (int i = 0; i < 4; ++i) { const int id = tid + 512 * i, dir = id >> 10, e = (id & 1023) * 8, p = e >> 7, nn = e & 127;
            lds_st16(lds + O_S + dir * 64 * O_S_PITCH + p * O_S_PITCH + nn * 2, *(const uint4*)(sin + (size_t)dir * 8192 + e)); }
    }
    }
    asm volatile("" ::: "memory");
    bf16x8 cf[8];
#pragma unroll
    for (int ks = 0; ks < 8; ++ks) cf[ks] = *(const bf16x8*)(xc + (m0 + 32 * wave + ql) * 1024 + 768 + g * 128 + 16 * ks + 8 * hh);
    const f32x4 mine = *(const f32x4*)(dtc + ((m0 + 32 * wave + ql) * 8 + h) * 4);
    __syncthreads();
    const float clf = mine[2] * 1.4426950408889634f, clb = mine[3] * 1.4426950408889634f;
    f32x16 yf0, yf1, yb0, yb1;
#pragma unroll
    for (int i = 0; i < 16; ++i) { yf0[i] = 0.f; yf1[i] = 0.f; yb0[i] = 0.f; yb1[i] = 0.f; }
    if (abl != 2)
#pragma unroll
    for (int kh = 0; kh < 2; ++kh) {
        bf16x8 as[4][4];
#pragma unroll
        for (int k4 = 0; k4 < 4; ++k4) { const LAS unsigned char* sp = lds + O_S + (16 * (4 * kh + k4) + 8 * hh) * 2;
#pragma unroll
            for (int i = 0; i < 4; ++i) as[k4][i] = *(const LAS bf16x8*)(sp + (32 * i + ql) * O_S_PITCH); }
        __builtin_amdgcn_sched_barrier(0);
#pragma unroll
        for (int k4 = 0; k4 < 4; ++k4) { const int ks = 4 * kh + k4;
            yf0 = __builtin_amdgcn_mfma_f32_32x32x16_bf16(as[k4][0], cf[ks], yf0, 0, 0, 0); yf1 = __builtin_amdgcn_mfma_f32_32x32x16_bf16(as[k4][1], cf[ks], yf1, 0, 0, 0);
            yb0 = __builtin_amdgcn_mfma_f32_32x32x16_bf16(as[k4][2], cf[ks], yb0, 0, 0, 0); yb1 = __builtin_amdgcn_mfma_f32_32x32x16_bf16(as[k4][3], cf[ks], yb1, 0, 0, 0); }
    }
    { const float ef = __builtin_amdgcn_exp2f(clf), eb = __builtin_amdgcn_exp2f(clb);
#pragma unroll
      for (int i = 0; i < 16; ++i) { yf0[i] = yf0[i] * ef + yb0[i] * eb; yf1[i] = yf1[i] * ef + yb1[i] * eb; } }
    const int lpos = 32 * wave + ql, blk = (lane >> 4) & 1, q4 = (lane & 15) >> 2, p4 = lane & 3;
    bf16x8 am[8]; v4i16 xt[8];
#define SSD_LD_AM(sb_) do { _Pragma("unroll") for (int ks = 0; ks < 8; ++ks) am[ks] = *(const LAS bf16x8*)(lds + O_BM + (32 * (sb_) + ql) * O_BM_PITCH + (16 * ks + 8 * hh) * 2); } while (0)
#define SSD_LD_XT(sb_) do { _Pragma("unroll") for (int s2 = 0; s2 < 2; ++s2) { const LAS unsigned char* xp = lds + O_X + (32 * (sb_) + 16 * s2 + 4 * hh + q4) * O_X_PITCH + (16 * blk + 4 * p4) * 2; \
            xt[4 * s2] = tr4(xp); xt[4 * s2 + 1] = tr4(xp + 8 * O_X_PITCH); xt[4 * s2 + 2] = tr4(xp + 64); xt[4 * s2 + 3] = tr4(xp + 8 * O_X_PITCH + 64); } } while (0)
    SSD_LD_AM(0); SSD_LD_XT(0);
#pragma unroll 1
    for (int sb = 0; sb < (abl == 3 ? 0 : 8); ++sb) {
        const int sn = sb < 7 ? sb + 1 : 7;
        __builtin_amdgcn_sched_barrier(0);
        f32x16 gt;
#pragma unroll
        for (int i = 0; i < 16; ++i) gt[i] = 0.f;
#pragma unroll
        for (int ks = 0; ks < 8; ++ks) gt = __builtin_amdgcn_mfma_f32_32x32x16_bf16(am[ks], cf[ks], gt, 0, 0, 0);
        __builtin_amdgcn_sched_barrier(0);
        SSD_LD_AM(sn);
        __builtin_amdgcn_sched_barrier(0);
        const int sbase = 32 * sb + 4 * hh;
        if (sb < wave) {
#pragma unroll
            for (int i = 0; i < 4; ++i) { const f32x4 t = *(const LAS f32x4*)(tF + sbase + 8 * i);
#pragma unroll
                for (int e = 0; e < 4; ++e) gt[4 * i + e] *= __builtin_amdgcn_exp2f(clf - t[e]); }
        } else if (sb > wave) {
#pragma unroll
            for (int i = 0; i < 4; ++i) { const f32x4 t = *(const LAS f32x4*)(tB + sbase + 8 * i);
#pragma unroll
                for (int e = 0; e < 4; ++e) gt[4 * i + e] *= __builtin_amdgcn_exp2f(clb - t[e]); }
        } else {
#pragma unroll
            for (int i = 0; i < 4; ++i) { const f32x4 a = *(const LAS f32x4*)(tF + sbase + 8 * i), bq = *(const LAS f32x4*)(tB + sbase + 8 * i), d = *(const LAS f32x4*)(tD + sbase + 8 * i);
#pragma unroll
                for (int e = 0; e < 4; ++e) { const int s = sbase + 8 * i + e; const float arg = s < lpos ? clf - a[e] : clb - bq[e];
                    const float w = __builtin_amdgcn_exp2f(arg); gt[4 * i + e] *= s == lpos ? d[e] : w; } }
        }
#pragma unroll
        for (int s2 = 0; s2 < 2; ++s2) {
            union { bf16x8 v; unsigned u[4]; } wfz; wfz.u[0] = cvtpk(gt[8 * s2 + 0], gt[8 * s2 + 1]); wfz.u[1] = cvtpk(gt[8 * s2 + 2], gt[8 * s2 + 3]); wfz.u[2] = cvtpk(gt[8 * s2 + 4], gt[8 * s2 + 5]); wfz.u[3] = cvtpk(gt[8 * s2 + 6], gt[8 * s2 + 7]);
            const bf16x8 x0 = cat4(xt[4 * s2], xt[4 * s2 + 1]), x1 = cat4(xt[4 * s2 + 2], xt[4 * s2 + 3]);
            yf0 = __builtin_amdgcn_mfma_f32_32x32x16_bf16(x0, wfz.v, yf0, 0, 0, 0); yf1 = __builtin_amdgcn_mfma_f32_32x32x16_bf16(x1, wfz.v, yf1, 0, 0, 0);
        }
        __builtin_amdgcn_sched_barrier(0);
        SSD_LD_XT(sn);
    }
#undef SSD_LD_AM
#undef SSD_LD_XT
    {
        const float Dh = ain(I_SSDD)[L * 8 + h]; const size_t m = m0 + lpos; const bf16* z = (const bf16*)(ws + WS_Z) + m * 512 + h * 64 + 4 * hh;
        bf16* y = (bf16*)(ws + WS_Y) + m * 1024 + h * 64 + 4 * hh; float sq = 0.f;
        uint2 zall[8];
#pragma unroll
        for (int i = 0; i < 8; ++i) zall[i] = *(const uint2*)(z + 8 * i);
#pragma unroll
        for (int pb = 0; pb < 2; ++pb)
#pragma unroll
            for (int g4 = 0; g4 < 4; ++g4) {
                const int pp = 32 * pb + 8 * g4 + 4 * hh; const v2u xw = *(const LAS v2u*)(lds + O_X + lpos * O_X_PITCH + pp * 2); const uint2 zw = zall[4 * pb + g4];
                const float xv[4] = {bflo(xw.x), bfhi(xw.x), bflo(xw.y), bfhi(xw.y)}, zv[4] = {bflo(zw.x), bfhi(zw.x), bflo(zw.y), bfhi(zw.y)}; float o[4];
#pragma unroll
                for (int e = 0; e < 4; ++e) { const float yv = (pb == 0 ? yf0[4 * g4 + e] : yf1[4 * g4 + e]) + Dh * xv[e]; o[e] = yv * silu_f(zv[e]); sq += o[e] * o[e]; }
                uint2 w; w.x = cvtpk(o[0], o[1]); w.y = cvtpk(o[2], o[3]); *(uint2*)(y + 32 * pb + 8 * g4) = w;
            }
        sq += __shfl_xor(sq, 32);
        if (hh == 0 && abl == 0) ((float*)(ws + WS_SSQ))[m * 16 + h] = sq;
    }
    __syncthreads();
}
__device__ __forceinline__ void build_out_tab(LAS unsigned char* lds, int pm, int tid) {
    if (tid < 256) { const float* q = (const float*)(aws() + WS_SSQ) + ((size_t)pm * 256 + tid) * 16; float rs[4];
#pragma unroll
        for (int g = 0; g < 4; ++g) { const f32x4 v = *(const f32x4*)(q + 4 * g); rs[g] = rsqrtf(((v[0] + v[1]) + (v[2] + v[3])) * (1.0f / 256.0f) + EPS); }
        ((LAS f32x4*)(lds + TAB_OFF))[tid] = (f32x4){rs[0] / rs[1], rs[1] / rs[2], rs[2] / rs[3], rs[3]}; }
    __syncthreads();
}

constexpr int NPHASES = 1 + 9 * DEPTH;

#define PHASE_IDS \
    int zero = 0; asm volatile("" : "+s"(zero)); \
    const int wave = __builtin_amdgcn_readfirstlane((int)threadIdx.x >> 6) + zero; \
    const int G = (int)gridDim.x + zero, bx = (int)blockIdx.x + zero; \
    const int vcu = (G % 8 == 0) ? (bx % 8) * (G / 8) + bx / 8 : bx; \
    const int gw = vcu * NWAVES + wave, NGW = G * NWAVES, NT = G * NWAVES * 64; \
    int tid = threadIdx.x; asm volatile("" : "+v"(tid)); const int lane = tid & 63, gtid = bx * (NWAVES * 64) + tid; \
    unsigned char* ws = aws(); (void)lane; (void)gtid; (void)gw; (void)NGW; (void)NT; (void)wave; (void)ws; (void)vcu;
#define GRID_BAR() do { XcdBarrier bar; bar.bar = (unsigned*)(aws() + WS_CTL) + CW_BAR; bar.x = xb_xcc_id(); bar.st = (volatile LAS unsigned*)(lds + MISC_OFF) + 8; xcd_barrier(bar); } while (0)
#define IN(k) (lo <= (k) && (k) < hi)
#define SEAM(k) do { if ((k) + 1 < hi) { int nb_ = REPB(14) ? 2 : 1; asm volatile("" : "+s"(nb_)); for (int r_ = 0; r_ < nb_; ++r_) GRID_BAR(); } } while (0)

template <int L, int PR = 0> __device__ __forceinline__ void layer_phases(LAS unsigned char* lds, int lo, int hi) {
    constexpr int P = 1 + 9 * L;
    if (IN(P + 0)) {
        PHASE_IDS
        pg8::Gemm g{(const bf16*)(ws + WS_XB), (const bf16*)(ws + WS_WGU1), M, 2 * FF, D}; pg8::StaticOrder S; S.init(M, 2 * FF, G, bx);
        PG8_LAS float* rt = (PG8_LAS float*)(lds + RTAB_OFF); const bool ut = rstd_tab_ok<6>(S);
        EpiGU E{(bf16*)(ws + WS_HB), (const float*)(ws + WS_SS), rt, ut};
        pg8::gemm_phase<EpiGU, pg8::StaticOrder, true, true>(lds, g, S, E);
        if (REPB(11)) { EpiDry Ed; pg8::gemm_phase<EpiDry, pg8::StaticOrder, true, true>(lds, g, S, Ed); }
        if (REPB(1)) pg8::gemm_phase<EpiGU, pg8::StaticOrder, true, true>(lds, g, S, E);
        { TAIL_WORKER(64 * 22) int ntr_ = REPB(15) ? 2 : 1; asm volatile("" : "+s"(ntr_)); for (int tr_ = 0; tr_ < ntr_; ++tr_) if (tail_) { convert_job<J_D1>(L, lds, tw_, tnw_, wave, lane, 0); convert_job<J_IN>(L, lds, tw_, tnw_, wave, lane, 704); if (L == 1) convert_job<J_UQKV>(1, lds, tw_, tnw_, wave, lane, 1408); } }
        SEAM(P + 0);
    }
    if (IN(P + 1)) {
        PHASE_IDS
        pg8::Gemm g{(const bf16*)(ws + WS_HB), (const bf16*)(ws + WS_WD1), M, D, FF}; pg8::StaticOrder S; S.init(M, D, G, bx);
        if (REPB(5)) { EpiDry Ed; pg8::gemm_phase<EpiDry, pg8::StaticOrder, false, true>(lds, g, S, Ed); }
        EpiDown<0, false> E{aout(), (bf16*)(ws + WS_XB), (float*)(ws + WS_SS), 0.5f, nullptr};
        pg8::gemm_phase<EpiDown<0, false>, pg8::StaticOrder, true, true>(lds, g, S, E);
        SEAM(P + 1);
    }
    if (IN(P + 2)) {
        PHASE_IDS
        pg8::Gemm g{(const bf16*)(ws + WS_XB), (const bf16*)(ws + WS_WIN), M, NPROJP, D}; pg8::StaticOrder S; S.init(M, NPROJP, G, bx);
        PG8_LAS float* rt = (PG8_LAS float*)(lds + RTAB_OFF); const bool ut = rstd_tab_ok<3>(S);
        EpiProj E{(bf16*)(ws + WS_PROJ), (float*)(ws + WS_DTRAW), (const float*)(ws + WS_SS), rt, ut};
        pg8::gemm_phase<EpiProj, pg8::StaticOrder, true, true>(lds, g, S, E);
        if (REPB(2)) pg8::gemm_phase<EpiProj, pg8::StaticOrder, true, true>(lds, g, S, E);
        { TAIL_WORKER(64 * 10) int ntr_ = REPB(15) ? 2 : 1; asm volatile("" : "+s"(ntr_)); for (int tr_ = 0; tr_ < ntr_; ++tr_) if (tail_) { convert_job<J_OUT>(L, lds, tw_, tnw_, wave, lane, 0); convert_job<J_GU2>(L, lds, tw_, tnw_, wave, lane, 256); } }
        SEAM(P + 2);
    }
    if (IN(P + 3)) {
        PHASE_IDS
        { int nrep = (REPB(3) || REPB(12)) ? REP_N : 1; asm volatile("" : "+s"(nrep));
          for (int r = 0; r < nrep; ++r) for (int u = vcu; u < 512; u += G) ssd_state_unit(lds, L, G == 256 ? 64 * (vcu >> 5) + (vcu & 31) + (u >= 256 ? 32 : 0) : u, tid, wave, lane); }
#if defined(T_STOP) && defined(PREFIX_K)
        if (PR) { if (T_STOP > 0) for (int u = vcu; u < 256; u += G) token_prep_unit<T_STOP>(lds, L, u, tid, wave, lane, true); }
        else
#endif
        for (int u = vcu; u < 256; u += G) token_prep_unit(lds, L, u, tid, wave, lane, true);
        if (REPB(3) || REPB(13)) { for (int u = vcu; u < 256; u += G) token_prep_unit(lds, L, u, tid, wave, lane, false); }
        SEAM(P + 3);
    }
    if (IN(P + 4)) {
        PHASE_IDS
        ssd_state_pass(gtid); sp_arrive((unsigned*)(ws + WS_CTL) + CW_SP + 64 * L, tid);
#if defined(MIX_STOP) && defined(PREFIX_K)
#define MIXGO(n) (hi != PREFIX_K || (n) <= MIX_STOP)
#else
#define MIXGO(n) true
#endif
        if (MIXGO(2))
        { int nrep = REPB(8) ? REP_N : 1; asm volatile("" : "+s"(nrep));
          for (int r = 0; r < nrep; ++r) for (int u = vcu; u < 256; u += G) attn_unit<96, false>(lds, L, u, tid, wave, lane); }
#ifdef ABL_N
        for (int u = vcu; u < 256; u += G) attn_unit<96, false, ABL_N>(lds, L, u, tid, wave, lane);
#endif
        if (MIXGO(3))
        { int nrep = REPB(9) ? REP_N : 1; asm volatile("" : "+s"(nrep));
          for (int r = 0; r < nrep; ++r) for (int u = vcu; u < 256; u += G) swa_unit(lds, L, u, tid, wave, lane); }
        if (MIXGO(4)) sp_wait((unsigned*)(ws + WS_CTL) + CW_SP + 64 * L, (unsigned)G, tid);
        if (MIXGO(5))
        { int nrep = REPB(10) ? REP_N : 1; asm volatile("" : "+s"(nrep));
#ifdef ABL_S
          for (int r = 0; r < nrep; ++r) { const int ab_ = __builtin_amdgcn_readfirstlane(r > 0 ? ABL_S : 0); for (int u = vcu; u < 512; u += G) ssd_out_unit(lds, L, G == 256 ? 64 * (vcu >> 5) + (vcu & 31) + (u >= 256 ? 32 : 0) : u, tid, wave, lane, ab_); } }
#else
          for (int r = 0; r < nrep; ++r) for (int u = vcu; u < 512; u += G) ssd_out_unit(lds, L, G == 256 ? 64 * (vcu >> 5) + (vcu & 31) + (u >= 256 ? 32 : 0) : u, tid, wave, lane); }
#endif
        SEAM(P + 5);
    }
    if (IN(P + 6)) {
        PHASE_IDS
        pg8::Gemm g{(const bf16*)(ws + WS_Y), (const bf16*)(ws + WS_WOUT), M, D, D}; pg8::StaticOrder S; S.init(M, D, G, bx);
        if (REPB(6)) { EpiDry Ed; pg8::gemm_phase<EpiDry, pg8::StaticOrder, false, true>(lds, g, S, Ed); }
        EpiDown<1, false> E{aout(), (bf16*)(ws + WS_XB), (float*)(ws + WS_SS), 1.0f, (const PG8_LAS float*)(lds + TAB_OFF)};
        pg8::gemm_phase<EpiDown<1, false>, pg8::StaticOrder, true, true>(lds, g, S, E);
        SEAM(P + 6);
    }
    if (IN(P + 7)) {
        PHASE_IDS
        pg8::Gemm g{(const bf16*)(ws + WS_XB), (const bf16*)(ws + WS_WGU2), M, 2 * FF, D}; pg8::StaticOrder S; S.init(M, 2 * FF, G, bx);
        PG8_LAS float* rt = (PG8_LAS float*)(lds + RTAB_OFF); const bool ut = rstd_tab_ok<6>(S);
        EpiGU E{(bf16*)(ws + WS_HB), (const float*)(ws + WS_SS), rt, ut};
        pg8::gemm_phase<EpiGU, pg8::StaticOrder, true, true>(lds, g, S, E);
        if (REPB(11)) { EpiDry Ed; pg8::gemm_phase<EpiDry, pg8::StaticOrder, true, true>(lds, g, S, Ed); }
        if (REPB(1)) pg8::gemm_phase<EpiGU, pg8::StaticOrder, true, true>(lds, g, S, E);
        { TAIL_WORKER(64 * 22) int ntr_ = REPB(15) ? 2 : 1; asm volatile("" : "+s"(ntr_)); for (int tr_ = 0; tr_ < ntr_; ++tr_) if (tail_) { convert_job<J_D2>(L, lds, tw_, tnw_, wave, lane, 0); if (L == 0) convert_job<J_GU1>(1, lds, tw_, tnw_, wave, lane, 704); } }
        SEAM(P + 7);
    }
    if (IN(P + 8)) {
        PHASE_IDS
        pg8::Gemm g{(const bf16*)(ws + WS_HB), (const bf16*)(ws + WS_WD2), M, D, FF}; pg8::StaticOrder S; S.init(M, D, G, bx);
        if (REPB(5)) { EpiDry Ed; pg8::gemm_phase<EpiDry, pg8::StaticOrder, false, true>(lds, g, S, Ed); }
        constexpr bool FIN = (L == DEPTH - 1); typedef EpiDown<0, FIN> EpiLast;
        EpiLast E{aout(), (bf16*)(ws + WS_XB), (float*)(ws + WS_SS), 0.5f, nullptr};
        pg8::gemm_phase<EpiLast, pg8::StaticOrder, true, true>(lds, g, S, E);
        SEAM(P + 8);
    }
}

template <int PR> __device__ __forceinline__ void mk_body(LAS unsigned char* lds) {
    for (int u = threadIdx.x; u < (LDS_BYTES - LDSCTL_OFF) / 4; u += NWAVES * 64) ((LAS unsigned*)(lds + LDSCTL_OFF))[u] = 0u;
    __syncthreads();
    const int lo = ((const int*)__builtin_amdgcn_kernarg_segment_ptr())[2 * (N_IN + 2)], hi = ((const int*)__builtin_amdgcn_kernarg_segment_ptr())[2 * (N_IN + 2) + 1];
    if (hi - lo > 1) (void)xcd_barrier_post((unsigned*)(aws() + WS_CTL) + CW_BAR, (volatile LAS unsigned*)(lds + MISC_OFF) + 8);
    if (IN(0)) {
        PHASE_IDS
#ifndef NO_P0
        convert_job<J_GU1>(0, lds, gw, NGW, wave, lane); convert_job<J_UQKV>(0, lds, gw, NGW, wave, lane);
        p0_x_and_tables(gw, NGW, lane, gtid, NT);
        if (REPB(0)) { convert_job<J_GU1>(0, lds, gw, NGW, wave, lane); convert_job<J_UQKV>(0, lds, gw, NGW, wave, lane); p0_x_and_tables(gw, NGW, lane, gtid, NT); }
#endif
        SEAM(0);
    }
    layer_phases<0, PR>(lds, lo, hi);
    layer_phases<1, PR>(lds, lo, hi);
}
__global__ void __launch_bounds__(NWAVES * 64, 2) mk_fwd(Args args) {
    extern __shared__ __attribute__((aligned(16))) unsigned char lds_raw[];
    mk_body<0>((LAS unsigned char*)lds_raw);
}
#ifdef PREFIX_K
__global__ void __launch_bounds__(NWAVES * 64, 2) mk_probe(Args args) {
#ifdef __HIP_DEVICE_COMPILE__
    extern __shared__ __attribute__((aligned(16))) unsigned char lds_raw[];
    mk_body<1>((LAS unsigned char*)lds_raw);
#endif
}
#endif


extern "C" void kernel_launch(void* const* d_in, const int* in_sizes, int n_in, void* d_out, int out_size, void* d_ws, size_t ws_size, hipStream_t stream) {
    static int grid = 0;
    if (grid == 0) {
        if (n_in != N_IN || out_size != M * D || ws_size < WS_END) { fprintf(stderr, "kernel_launch: unexpected shapes (n_in %d out %d ws %zu)\n", n_in, out_size, ws_size); grid = -1; return; }
        int dev = 0, cus = 0, per_cu = 0;
        if (hipGetDevice(&dev) != hipSuccess || hipDeviceGetAttribute(&cus, hipDeviceAttributeMultiprocessorCount, dev) != hipSuccess) { grid = -1; return; }
#ifdef PREFIX_K
        (void)hipFuncSetAttribute((const void*)mk_probe, hipFuncAttributeMaxDynamicSharedMemorySize, LDS_BYTES);
#endif
        if (hipFuncSetAttribute((const void*)mk_fwd, hipFuncAttributeMaxDynamicSharedMemorySize, LDS_BYTES) != hipSuccess) { fprintf(stderr, "kernel_launch: hipFuncSetAttribute failed\n"); grid = -1; return; }
        if (hipOccupancyMaxActiveBlocksPerMultiprocessor(&per_cu, (const void*)mk_fwd, NWAVES * 64, LDS_BYTES) != hipSuccess || per_cu < 1) fprintf(stderr, "kernel_launch: occupancy query says %d\n", per_cu);
        (void)hipGetLastError();
        grid = cus;
    }
    if (grid < 0) return;
    (void)hipMemsetAsync((char*)d_ws + WS_CTL, 0, CTL_ZERO_BYTES, stream);
    Args a{};
    for (int i = 0; i < N_IN; ++i) a.in[i] = (const float*)d_in[i];
    a.out = (float*)d_out; a.ws = (unsigned char*)d_ws;
#ifdef PREFIX_K
#ifndef PREFIX_REP
#define PREFIX_REP 1
#endif
    a.ph_lo = 0; a.ph_hi = PREFIX_K;
    for (int pr_ = 0; pr_ < PREFIX_REP; ++pr_) {
        hipLaunchKernelGGL(mk_probe, dim3(grid), dim3(NWAVES * 64), LDS_BYTES, stream, a);
        (void)hipMemsetAsync((char*)d_ws + WS_CTL, 0, CTL_ZERO_BYTES, stream);
    }
#endif
    a.ph_lo = 0; a.ph_hi = NPHASES;
    hipLaunchKernelGGL(mk_fwd, dim3(grid), dim3(NWAVES * 64), LDS_BYTES, stream, a);
}
```
